# Optimizing an MI355X kernel written in HIP

```python
import math
import jax, jax.numpy as jnp
from jax import lax
import numpy as np

D_MODEL = 1024
BATCH = 4
SEQ = 8192
DEPTH = 4

N_MIXERS = 3
MEM_LEN = 256
EPS = 1e-6
DA_HEADS = 8
DA_QK_DIM = 64
DA_V_DIM = 2 * DA_QK_DIM
Q_BLOCK = 128
REL_BUCKETS = 32
REL_MAX_DIST = 128
HG_EXPAND = 128
HG_HEADS = D_MODEL // HG_EXPAND
HG_V_DIM = D_MODEL // HG_HEADS
HG_CHUNK = 64
SG_CHUNK = 128
SG_GROUPS = 8
SG_WIDTH = D_MODEL
SG_GROUP_DIM = SG_WIDTH // SG_GROUPS
CA_HEADS = 4
CA_HEAD_DIM = D_MODEL // CA_HEADS
D_FF = int(math.ceil(8 * D_MODEL / 3 / 256)) * 256
N_A = (DEPTH + 2) // 3
N_B = (DEPTH + 1) // 3
N_C = DEPTH // 3

kernel_name = "hybrid_diffattn_hgrn2_gmlp_trunk"


def rmsnorm(x, g):
    xf = x.astype(jnp.float32)
    y = xf * lax.rsqrt(jnp.mean(xf * xf, axis=-1, keepdims=True) + EPS)
    return (y * g.astype(jnp.float32)).astype(x.dtype)


def rel_bucket(dist):
    n = jnp.maximum(dist, 0)
    exact = REL_BUCKETS // 2
    nf = jnp.maximum(n, exact).astype(jnp.float32)
    large = exact + (jnp.log(nf / exact) / math.log(REL_MAX_DIST / exact)
                     * (REL_BUCKETS - exact)).astype(jnp.int32)
    large = jnp.minimum(large, REL_BUCKETS - 1)
    return jnp.where(n < exact, n, large)


def diff_attention(h, w_in, w_out, lq1, lk1, lq2, lk2, subln_g, rel_bias, layer_idx):
    B, S, _ = h.shape
    q, k, v = jnp.split(h @ w_in, 3, axis=-1)
    q = q.reshape(B, S, DA_HEADS, 2, DA_QK_DIM)
    k = k.reshape(B, S, DA_HEADS, 2, DA_QK_DIM)
    v = v.reshape(B, S, DA_HEADS, DA_V_DIM)
    lam_init = 0.8 - 0.6 * math.exp(-0.3 * layer_idx)
    lam = (jnp.exp(jnp.sum(lq1.astype(jnp.float32) * lk1.astype(jnp.float32)))
           - jnp.exp(jnp.sum(lq2.astype(jnp.float32) * lk2.astype(jnp.float32))) + lam_init)
    n_blk = S // Q_BLOCK
    qb = q.reshape(B, n_blk, Q_BLOCK, DA_HEADS, 2, DA_QK_DIM).transpose(1, 0, 2, 3, 4, 5)
    starts = jnp.arange(n_blk, dtype=jnp.int32) * Q_BLOCK
    k_pos = jnp.arange(S, dtype=jnp.int32)
    scale = DA_QK_DIM ** -0.5

    def block(args):
        q_blk, start = args
        dist = (start + jnp.arange(Q_BLOCK, dtype=jnp.int32))[:, None] - k_pos[None, :]
        bias = rel_bias.astype(jnp.float32)[:, rel_bucket(dist)]
        logits = jnp.einsum('bqhcd,bkhcd->bhcqk', q_blk, k).astype(jnp.float32) * scale
        logits = logits + bias[None, :, None]
        logits = jnp.where(dist >= 0, logits, -jnp.inf)
        p = jax.nn.softmax(logits, axis=-1)
        attn = p[:, :, 0] - lam * p[:, :, 1]
        return jnp.einsum('bhqk,bkhd->bqhd', attn.astype(v.dtype), v)

    o = lax.map(block, (qb, starts))
    o = o.transpose(1, 0, 2, 3, 4).reshape(B, S, DA_HEADS, DA_V_DIM)
    o = rmsnorm(o, subln_g) * (1.0 - lam_init)
    return o.reshape(B, S, D_MODEL).astype(h.dtype) @ w_out


def hgrn2(h, w_in, w_out, lower_bound, onorm_g):
    B, S, _ = h.shape
    q, f, i, g = jnp.split(h @ w_in, 4, axis=-1)
    lb = lower_bound.astype(jnp.float32)
    ff = f.astype(jnp.float32)
    log_f = jnp.logaddexp(jnp.log(lb), jnp.log1p(-lb) + jax.nn.log_sigmoid(ff))
    key = 1.0 - jnp.exp(log_f)
    qf = jax.nn.silu(q.astype(jnp.float32))
    vf = i.astype(jnp.float32)
    n_ch = S // HG_CHUNK

    def to_chunks(t, d):
        return t.reshape(B, n_ch, HG_CHUNK, HG_HEADS, d).transpose(1, 0, 3, 2, 4)

    qc, kc, gc = (to_chunks(t, HG_EXPAND) for t in (qf, key, log_f))
    vc = to_chunks(vf, HG_V_DIM)
    causal = jnp.tril(jnp.ones((HG_CHUNK, HG_CHUNK), dtype=bool))

    def step(state, xs):
        qt, kt, vt, gt = xs
        G = jnp.cumsum(gt, axis=2)
        o_inter = jnp.einsum('bhtk,bhkv->bhtv', qt * jnp.exp(G), state)
        diff = G[:, :, :, None, :] - G[:, :, None, :, :]
        decay = jnp.exp(jnp.where(causal[:, :, None], diff, -jnp.inf))
        A = jnp.einsum('bhtk,bhsk,bhtsk->bhts', qt, kt, decay)
        o_intra = jnp.einsum('bhts,bhsv->bhtv', A, vt)
        G_last = G[:, :, -1]
        k_dec = kt * jnp.exp(G_last[:, :, None] - G)
        new_state = jnp.exp(G_last)[..., None] * state + jnp.einsum('bhsk,bhsv->bhkv', k_dec, vt)
        return new_state, o_inter + o_intra

    s0 = jnp.zeros((B, HG_HEADS, HG_EXPAND, HG_V_DIM), jnp.float32)
    _, o = lax.scan(step, s0, (qc, kc, vc, gc))
    o = o.transpose(1, 0, 3, 2, 4).reshape(B, S, HG_HEADS, HG_V_DIM).astype(h.dtype)
    o = rmsnorm(o, onorm_g).reshape(B, S, D_MODEL) * jax.nn.silu(g)
    return o @ w_out


def chunked_sgu(h, w_in, w_out, vnorm_g, w_s, b_s):
    B, S, _ = h.shape
    u, v = jnp.split(jax.nn.gelu(h @ w_in, approximate=False), 2, axis=-1)
    v = rmsnorm(v, vnorm_g)
    n = S // SG_CHUNK
    v = v.reshape(B, n, SG_CHUNK, SG_GROUPS, SG_GROUP_DIM)
    w = w_s * jnp.tril(jnp.ones((SG_CHUNK, SG_CHUNK), w_s.dtype))
    mixed = jnp.einsum('gts,bnsgc->bntgc', w, v) + b_s.T[None, None, :, :, None]
    return (u * mixed.reshape(B, S, SG_WIDTH)) @ w_out


def mem_cross_attention(h, mem_n, w_q, w_kv, w_o):
    B, S, _ = h.shape
    q = (h @ w_q).reshape(B, S, CA_HEADS, CA_HEAD_DIM)
    k, v = jnp.split(mem_n @ w_kv, 2, axis=-1)
    k = k.reshape(B, -1, CA_HEADS, CA_HEAD_DIM)
    v = v.reshape(B, -1, CA_HEADS, CA_HEAD_DIM)
    logits = jnp.einsum('bshd,bmhd->bhsm', q, k).astype(jnp.float32) * (CA_HEAD_DIM ** -0.5)
    p = jax.nn.softmax(logits, axis=-1)
    o = jnp.einsum('bhsm,bmhd->bshd', p.astype(v.dtype), v).reshape(B, S, D_MODEL)
    return o @ w_o


def swiglu(h, w_gu, w_down):
    gate, up = jnp.split(h @ w_gu, 2, axis=-1)
    return (jax.nn.silu(gate) * up) @ w_down


def setup_inputs(seed: int = 0) -> dict:
    key = jax.random.key(seed)
    k = jax.random.split(key, 32)
    f32 = jnp.float32

    def nrm(kk, shape, scale):
        return jax.random.normal(kk, shape, f32) * scale

    def gain(kk, shape):
        return 1.0 + nrm(kk, shape, 0.02)

    D = D_MODEL
    return {
        "x": nrm(k[0], (BATCH, SEQ, D), 1.0),
        "mem": nrm(k[1], (BATCH, MEM_LEN, D), 1.0),
        "rel_bias": nrm(k[2], (DA_HEADS, REL_BUCKETS), 0.5),
        "norm_mix": gain(k[3], (DEPTH, D)),
        "norm_cross": gain(k[4], (DEPTH, D)),
        "norm_ffn": gain(k[5], (DEPTH, D)),
        "norm_mem": gain(k[6], (D,)),
        "norm_final": gain(k[7], (D,)),
        "da_w_in": nrm(k[8], (N_A, D, 3 * D), D ** -0.5),
        "da_w_out": nrm(k[9], (N_A, D, D), D ** -0.5),
        "da_lq1": nrm(k[10], (N_A, DA_QK_DIM), 0.1),
        "da_lk1": nrm(k[11], (N_A, DA_QK_DIM), 0.1),
        "da_lq2": nrm(k[12], (N_A, DA_QK_DIM), 0.1),
        "da_lk2": nrm(k[13], (N_A, DA_QK_DIM), 0.1),
        "da_subln": gain(k[14], (N_A, DA_V_DIM)),
        "hg_w_in": nrm(k[15], (N_B, D, 4 * D), D ** -0.5),
        "hg_w_out": nrm(k[16], (N_B, D, D), D ** -0.5),
        "hg_lower_bounds": nrm(k[17], (DEPTH, HG_HEADS * HG_EXPAND), 0.5),
        "hg_onorm": gain(k[18], (N_B, HG_V_DIM)),
        "sg_w_in": nrm(k[19], (N_C, D, 2 * SG_WIDTH), D ** -0.5),
        "sg_w_out": nrm(k[20], (N_C, SG_WIDTH, D), SG_WIDTH ** -0.5),
        "sg_vnorm": gain(k[21], (N_C, SG_WIDTH)),
        "sg_w_s": nrm(k[22], (N_C, SG_GROUPS, SG_CHUNK, SG_CHUNK), SG_CHUNK ** -0.5),
        "sg_b_s": 1.0 + nrm(k[23], (N_C, SG_GROUPS, SG_CHUNK), 0.1),
        "ca_w_q": nrm(k[24], (DEPTH, D, D), D ** -0.5),
        "ca_w_kv": nrm(k[25], (DEPTH, D, 2 * D), D ** -0.5),
        "ca_w_o": nrm(k[26], (DEPTH, D, D), D ** -0.5),
        "ffn_w_gu": nrm(k[27], (DEPTH, D, 2 * D_FF), D ** -0.5),
        "ffn_w_down": nrm(k[28], (DEPTH, D_FF, D), D_FF ** -0.5),
    }


def reference(x, mem, rel_bias, norm_mix, norm_cross, norm_ffn, norm_mem, norm_final,
              da_w_in, da_w_out, da_lq1, da_lk1, da_lq2, da_lk2, da_subln,
              hg_w_in, hg_w_out, hg_lower_bounds, hg_onorm,
              sg_w_in, sg_w_out, sg_vnorm, sg_w_s, sg_b_s,
              ca_w_q, ca_w_kv, ca_w_o, ffn_w_gu, ffn_w_down):
    mem_n = rmsnorm(mem, norm_mem)
    lb = jax.nn.softmax(hg_lower_bounds.astype(jnp.float32), axis=0)
    lb = jnp.cumsum(lb, axis=0) - lb[0]
    for i in range(DEPTH):
        kind = i % N_MIXERS
        j = i // N_MIXERS
        hn = rmsnorm(x, norm_mix[i])
        if kind == 0:
            mix = diff_attention(hn, da_w_in[j], da_w_out[j], da_lq1[j], da_lk1[j],
                                 da_lq2[j], da_lk2[j], da_subln[j], rel_bias, i)
        elif kind == 1:
            mix = hgrn2(hn, hg_w_in[j], hg_w_out[j], lb[i], hg_onorm[j])
        else:
            mix = chunked_sgu(hn, sg_w_in[j], sg_w_out[j], sg_vnorm[j], sg_w_s[j], sg_b_s[j])
        x = x + mix
        x = x + mem_cross_attention(rmsnorm(x, norm_cross[i]), mem_n, ca_w_q[i], ca_w_kv[i], ca_w_o[i])
        x = x + swiglu(rmsnorm(x, norm_ffn[i]), ffn_w_gu[i], ffn_w_down[i])
    return rmsnorm(x, norm_final)
```

```cpp
#include <hip/hip_runtime.h>
#include <hip/hip_cooperative_groups.h>
#include <cstdio>
#include <cmath>
#include <cstring>
namespace cg = cooperative_groups;

typedef unsigned short u16;
using bf16x8 = __attribute__((ext_vector_type(8))) short;
using bf16x4 = __attribute__((ext_vector_type(4))) short;
using f32x4 = __attribute__((ext_vector_type(4))) float;
using u32x4 = __attribute__((ext_vector_type(4))) unsigned;

#ifndef MULTI_LAUNCH
#define MULTI_LAUNCH 0
#endif

constexpr int T_TOK = 32768, DM = 1024, SEQ = 8192, NB = 4, DFF = 2816, MEML = 256;
constexpr float EPS = 1e-6f;
constexpr int LDS_BYTES = 147456;
constexpr float LOG2E = 1.4426950408889634f;

typedef __attribute__((ext_vector_type(2))) float f32x2;
typedef __attribute__((ext_vector_type(2))) __bf16 bf16x2_t;
__device__ __forceinline__ unsigned pk2(float a, float b) { f32x2 v = {a, b}; bf16x2_t r = __builtin_convertvector(v, bf16x2_t); return *(unsigned*)&r; }
__device__ __forceinline__ u16 f2bf(float f) { return (u16)(pk2(f, 0.f) & 0xffffu); }
__device__ __forceinline__ float bf2f(u16 h) { return __uint_as_float(((unsigned)h) << 16); }
__device__ __forceinline__ float sigmoid_f(float x) { return __builtin_amdgcn_rcpf(1.f + __builtin_amdgcn_exp2f(-x * LOG2E)); }
__device__ __forceinline__ float silu_f(float x) { return x * sigmoid_f(x); }

__device__ __forceinline__ int opaque_tid(int wv) { unsigned ones = ~0u; asm volatile("" : "+s"(ones)); int lane = __builtin_amdgcn_mbcnt_hi(ones, __builtin_amdgcn_mbcnt_lo(ones, 0u)); int t = (wv << 6) | lane; asm volatile("" : "+v"(t)); return t; }

template <int M> __device__ __forceinline__ float sx(float v, int lane) {
  if (M < 32) return __int_as_float(__builtin_amdgcn_ds_swizzle(__float_as_int(v), (M << 10) | 0x1f));
  else return __int_as_float(__builtin_amdgcn_ds_bpermute((lane ^ M) << 2, __float_as_int(v)));
}
__device__ __forceinline__ float wave_sum(float v, int lane) {
  v += sx<1>(v, lane); v += sx<2>(v, lane); v += sx<4>(v, lane); v += sx<8>(v, lane); v += sx<16>(v, lane); v += sx<32>(v, lane); return v;
}

struct WDesc { const float* src; u16* dst; const float* gain; int K; int N; int perm; int tile0; };

struct KArgs {
  const float *x, *mem, *rel_bias, *norm_mem, *norm_final;
  const float *da_lq1, *da_lk1, *da_lq2, *da_lk2, *da_subln;
  const float *hg_lb, *hg_onorm;
  const float *sg_vnorm, *sg_w_s, *sg_b_s;
  float* out; char* ws;
  WDesc wd[28];
  int nwd; int total_wtiles;
  int phase_lo, phase_hi;
};

constexpr size_t MIB = 1u << 20;
constexpr size_t OFF_XB = 0, OFF_RPART = OFF_XB + 64 * MIB, OFF_VPART = OFF_RPART + 2 * MIB, OFF_MEMN = OFF_VPART + 2 * MIB,
                 OFF_MEMK = OFF_MEMN + 2 * MIB, OFF_MEMVT = OFF_MEMK + 8 * MIB, OFF_LBV = OFF_MEMVT + 8 * MIB, OFF_BIAS = OFF_LBV + 4096,
                 OFF_B0 = OFF_BIAS + 4096, OFF_B1 = OFF_B0 + 64 * MIB, OFF_B2 = OFF_B1 + 64 * MIB, OFF_B3 = OFF_B2 + 64 * MIB,
                 OFF_B4 = OFF_B3 + 64 * MIB, OFF_DBUF = OFF_B4 + 32 * MIB, OFF_W = OFF_DBUF + 2 * MIB, OFF_BAR = OFF_W + 130 * MIB, WS_END = OFF_BAR + 16384;
__host__ __device__ __forceinline__ long layer_woff(int i) { return i == 0 ? 0L : (i == 1 ? 17039360L : (i == 2 ? 35127296L : 51118080L)); }
__host__ __device__ __forceinline__ long mixin_elems(int i) { int kind = i % 3; return kind == 0 ? 3145728L : (kind == 1 ? 4194304L : 2097152L); }

struct Params {
  const float *x, *mem, *rel_bias, *norm_mem, *norm_final;
  const float *da_lq1, *da_lk1, *da_lq2, *da_lk2, *da_subln;
  const float *hg_lb, *hg_onorm;
  const float *sg_vnorm, *sg_w_s, *sg_b_s;
  float* out;
  u16* xb; float* rpart; float* vpart; u16* memn; u16* memK; u16* memVT; float* lbv; float* biastab;
  u16 *B0, *B1, *B2, *B3, *B4; float* dbuf; u16* wbase;
};
typedef const KArgs __attribute__((address_space(4)))* KArgsP;
__device__ __forceinline__ KArgsP kargs_ptr() {
  KArgsP kp = (KArgsP)__builtin_amdgcn_kernarg_segment_ptr();
  asm volatile("" : "+s"(kp));
  return kp;
}
template <class KA>
__device__ __forceinline__ Params make_params(const KA& k) {
  Params p;
  p.x = k.x; p.mem = k.mem; p.rel_bias = k.rel_bias; p.norm_mem = k.norm_mem; p.norm_final = k.norm_final;
  p.da_lq1 = k.da_lq1; p.da_lk1 = k.da_lk1; p.da_lq2 = k.da_lq2; p.da_lk2 = k.da_lk2; p.da_subln = k.da_subln;
  p.hg_lb = k.hg_lb; p.hg_onorm = k.hg_onorm; p.sg_vnorm = k.sg_vnorm; p.sg_w_s = k.sg_w_s; p.sg_b_s = k.sg_b_s; p.out = k.out;
  char* ws = k.ws;
  p.xb = (u16*)(ws + OFF_XB); p.rpart = (float*)(ws + OFF_RPART); p.vpart = (float*)(ws + OFF_VPART); p.memn = (u16*)(ws + OFF_MEMN);
  p.memK = (u16*)(ws + OFF_MEMK); p.memVT = (u16*)(ws + OFF_MEMVT); p.lbv = (float*)(ws + OFF_LBV); p.biastab = (float*)(ws + OFF_BIAS);
  p.B0 = (u16*)(ws + OFF_B0); p.B1 = (u16*)(ws + OFF_B1); p.B2 = (u16*)(ws + OFF_B2); p.B3 = (u16*)(ws + OFF_B3); p.B4 = (u16*)(ws + OFF_B4);
  p.dbuf = (float*)(ws + OFF_DBUF); p.wbase = (u16*)(ws + OFF_W);
  return p;
}


constexpr int BM = 256, BK = 64, HALF = 128, HT = HALF * BK;

__device__ __forceinline__ int lds_byte(int r, int c) {
  int st = (r >> 4) * 2 + (c >> 5), rr = r & 15, cc = c & 31, ob = rr * 64 + cc * 2;
  return st * 1024 + (ob ^ (((ob >> 9) & 1) << 5));
}
__device__ __forceinline__ void stage_rc(int b, int& R, int& C) {
  int st = b / 1024, sb = b % 1024, swz = sb ^ (((sb >> 9) & 1) << 5);
  R = (st >> 1) * 16 + swz / 64; C = (st & 1) * 32 + (swz % 64) / 2;
}

template <class Epi>
__device__ __forceinline__ void gemm_tile(const u16* __restrict__ A, const u16* __restrict__ Bt, int K, int brow, int bcol,
                                          char* shmc, Epi& epi, int tr0, int fc0, bool sw, bool pre, bool has_next,
                                          const u16* __restrict__ nA, const u16* __restrict__ nBt, int nbrow, int nbcol, int wv) {
  u16* shm = (u16*)shmc;
  const int tx = opaque_tid(wv);
#define SA(b, h) (shm + ((b) * 2 + (h)) * HT)
#define SB(b, h) (shm + (4 + (b) * 2 + (h)) * HT)
#define STAGE(P, BASE, br, kt) do { int _so = ((br) * K + (kt) * BK) * 2; \
    __builtin_amdgcn_raw_ptr_buffer_load_lds(rs_##BASE, (__attribute__((address_space(3))) void*)((char*)(P) + tx * 16), 16, voff0, _so, 0, 0); \
    __builtin_amdgcn_raw_ptr_buffer_load_lds(rs_##BASE, (__attribute__((address_space(3))) void*)((char*)(P) + tx * 16 + 8192), 16, voff1, _so, 0, 0); } while (0)
#define LDA(dst, b, h) _Pragma("unroll") for (int m = 0; m < 4; ++m) _Pragma("unroll") for (int k = 0; k < 2; ++k) \
    dst[m][k] = *reinterpret_cast<const bf16x8*>((char*)SA(b, h) + lds_byte(wr * 64 + m * 16 + fr, k * 32 + fq * 8))
#define LDB(dst, b, h) _Pragma("unroll") for (int n = 0; n < 2; ++n) _Pragma("unroll") for (int k = 0; k < 2; ++k) \
    dst[n][k] = *reinterpret_cast<const bf16x8*>((char*)SB(b, h) + lds_byte(wc * 32 + n * 16 + fr, k * 32 + fq * 8))
#define MMA(ai, bj, At, Bt_) do { __builtin_amdgcn_s_setprio(1); \
    _Pragma("unroll") for (int m = 0; m < 4; ++m) _Pragma("unroll") for (int n = 0; n < 2; ++n) _Pragma("unroll") for (int k = 0; k < 2; ++k) \
      acc[ai][bj][m][n] = __builtin_amdgcn_mfma_f32_16x16x32_bf16(At[m][k], Bt_[n][k], acc[ai][bj][m][n], 0, 0, 0); \
    __builtin_amdgcn_s_setprio(0); } while (0)
#define WAIT_V(n) asm volatile("s_waitcnt vmcnt(" #n ")" ::: "memory")
#define WAIT_L(n) asm volatile("s_waitcnt lgkmcnt(" #n ")" ::: "memory")
#define BAR __builtin_amdgcn_s_barrier()
#define SCHED __builtin_amdgcn_sched_barrier(0)

  int wid = tx >> 6, lane = tx & 63, wr = wid >> 2, wc = wid & 3, fr = lane & 15, fq = lane >> 4;
  f32x4 acc[2][2][4][2] = {};
  bf16x8 At[4][2], B0[2][2], B1[2][2];
  int nt = K / BK;
  int voff0, voff1;
  { int _r, _c; stage_rc(tx * 16, _r, _c); voff0 = (_r * K + _c) * 2; stage_rc(tx * 16 + 8192, _r, _c); voff1 = (_r * K + _c) * 2; }
  __amdgpu_buffer_rsrc_t rs_A = __builtin_amdgcn_make_buffer_rsrc((void*)A, 0, 0x7fffffff, 0x00020000);
  __amdgpu_buffer_rsrc_t rs_Bt = __builtin_amdgcn_make_buffer_rsrc((void*)Bt, 0, 0x7fffffff, 0x00020000);
  if (!pre) {
    STAGE(SB(0, 0), Bt, bcol, 0); STAGE(SA(0, 0), A, brow, 0);
    STAGE(SB(0, 1), Bt, bcol + HALF, 0); STAGE(SA(0, 1), A, brow + HALF, 0);
  }
  if (wr == 1) BAR;
  if (pre) { WAIT_V(0); } else { WAIT_V(4); }
  BAR;
  STAGE(SB(1, 0), Bt, bcol, 1); STAGE(SA(1, 0), A, brow, 1); STAGE(SB(1, 1), Bt, bcol + HALF, 1);
  WAIT_V(6); BAR;
  for (int t = 0; t < nt - 2; t += 2) {
    LDB(B0, 0, 0); SCHED; LDA(At, 0, 0); STAGE(SA(1, 1), A, brow + HALF, t + 1);
    WAIT_L(8); BAR; WAIT_L(0); MMA(0, 0, At, B0); BAR; SCHED;
    LDB(B1, 0, 1); STAGE(SB(0, 0), Bt, bcol, t + 2);
    BAR; WAIT_L(0); MMA(0, 1, At, B1); BAR;
    LDA(At, 0, 1); STAGE(SA(0, 0), A, brow, t + 2);
    BAR; WAIT_L(0); MMA(1, 0, At, B0); BAR; SCHED;
    STAGE(SB(0, 1), Bt, bcol + HALF, t + 2);
    WAIT_V(6); BAR; MMA(1, 1, At, B1); BAR;
    LDB(B0, 1, 0); SCHED; LDA(At, 1, 0); STAGE(SA(0, 1), A, brow + HALF, t + 2);
    WAIT_L(8); BAR; WAIT_L(0); MMA(0, 0, At, B0); BAR; SCHED;
    LDB(B1, 1, 1); STAGE(SB(1, 0), Bt, bcol, t + 3);
    BAR; WAIT_L(0); MMA(0, 1, At, B1); BAR;
    LDA(At, 1, 1); STAGE(SA(1, 0), A, brow, t + 3);
    BAR; WAIT_L(0); MMA(1, 0, At, B0); BAR; SCHED;
    STAGE(SB(1, 1), Bt, bcol + HALF, t + 3);
    WAIT_V(6); BAR; MMA(1, 1, At, B1); BAR;
  }
  { LDB(B0, 0, 0); LDA(At, 0, 0); STAGE(SA(1, 1), A, brow + HALF, nt - 1);
    BAR; WAIT_L(0); MMA(0, 0, At, B0); BAR;
    LDB(B1, 0, 1); BAR; WAIT_L(0); MMA(0, 1, At, B1); BAR;
    LDA(At, 0, 1); WAIT_V(4); BAR; WAIT_L(0); MMA(1, 0, At, B0); MMA(1, 1, At, B1); BAR; }
  { LDB(B0, 1, 0); LDA(At, 1, 0); WAIT_V(2); BAR; WAIT_L(0); MMA(0, 0, At, B0); BAR;
    LDB(B1, 1, 1); WAIT_V(0); BAR; WAIT_L(0); MMA(0, 1, At, B1); BAR;
    LDA(At, 1, 1); BAR; WAIT_L(0); MMA(1, 0, At, B0); MMA(1, 1, At, B1); BAR; }
  if (wr == 0) BAR;
  if (has_next) {
    __amdgpu_buffer_rsrc_t rs_nA = __builtin_amdgcn_make_buffer_rsrc((void*)nA, 0, 0x7fffffff, 0x00020000);
    __amdgpu_buffer_rsrc_t rs_nBt = __builtin_amdgcn_make_buffer_rsrc((void*)nBt, 0, 0x7fffffff, 0x00020000);
    STAGE(SB(0, 0), nBt, nbcol, 0); STAGE(SA(0, 0), nA, nbrow, 0);
    STAGE(SB(0, 1), nBt, nbcol + HALF, 0); STAGE(SA(0, 1), nA, nbrow + HALF, 0);
  }
  {
    const int tx2 = opaque_tid(wv); const int wid2 = tx2 >> 6, lane2 = tx2 & 63;
    epi(acc, tr0, fc0, sw, wid2 >> 2, wid2 & 3, lane2 & 15, lane2 >> 4);
  }
  __syncthreads();
#undef SA
#undef SB
#undef STAGE
#undef LDA
#undef LDB
#undef MMA
}

template <class Epi>
__device__ __forceinline__ void gemm_phase(const u16* A, const u16* Bt, int M, int N, int K, char* shm, Epi& epi, int wv) {
  int nM = M / BM, nN = N / BM;
  int G = gridDim.x, bid = blockIdx.x;
  bool xmap = ((G & 7) == 0 && (nM & 63) == 0);
  int xcd = bid & 7, slot = bid >> 3, nslots = G >> 3, gpx = nM / 64;
  int first = xmap ? slot : bid, step = xmap ? nslots : G, total = xmap ? gpx * 8 * nN : nM * nN;
  auto coords = [&](int L, int& tr0, int& fc0) {
    if (xmap) { int grp = xcd * gpx + L / (8 * nN), within = L % (8 * nN); tr0 = (grp * 8 + (within & 7)) * BM; fc0 = (within >> 3) * BM; }
    else { tr0 = (L % nM) * BM; fc0 = (L / nM) * BM; }
  };
  bool pre = false;
  for (int L = first; L < total; L += step) {
    int tr0, fc0, ntr0 = 0, nfc0 = 0;
    coords(L, tr0, fc0);
    bool hn = (L + step) < total;
    if (hn) coords(L + step, ntr0, nfc0);
    bool sw = epi.swap(fc0), nsw = epi.swap(nfc0);
    gemm_tile(sw ? Bt : A, sw ? A : Bt, K, sw ? fc0 : tr0, sw ? tr0 : fc0, shm, epi, tr0, fc0, sw, pre, hn,
              nsw ? Bt : A, nsw ? A : Bt, nsw ? nfc0 : ntr0, nsw ? ntr0 : nfc0, wv);
    pre = hn;
  }
}

__device__ __forceinline__ float row_rs(const float* part, int row) {
  const float4* q = (const float4*)(part + (long)row * 16);
  float4 a = q[0], b = q[1], c = q[2], d = q[3];
  float s = ((a.x + a.y) + (a.z + a.w)) + ((b.x + b.y) + (b.z + b.w)) + ((c.x + c.y) + (c.z + c.w)) + ((d.x + d.y) + (d.z + d.w));
  return rsqrtf(s * (1.f / DM) + EPS);
}
#define EPI_ARGS f32x4 (&acc)[2][2][4][2], int tr0, int fc0, bool sw, int wr, int wc, int fr, int fq
#define S_FEAT(ai, m) (fc0 + (ai) * 128 + wr * 64 + (m) * 16 + fq * 4)
#define S_TOK(bj, n) (tr0 + (bj) * 128 + wc * 32 + (n) * 16 + fr)
#define U_TOK(ai, m) (tr0 + (ai) * 128 + wr * 64 + (m) * 16 + fq * 4)
#define U_FEAT(bj, n) (fc0 + (bj) * 128 + wc * 32 + (n) * 16 + fr)

__device__ __forceinline__ uint2 pack4(float a, float b, float c, float d) { uint2 r; r.x = pk2(a, b); r.y = pk2(c, d); return r; }

struct EpiRes {
  u16* xb; float* part;
  __device__ __forceinline__ bool swap(int) const { return true; }
  __device__ __forceinline__ void operator()(EPI_ARGS) {
    _Pragma("unroll") for (int bj = 0; bj < 2; ++bj) _Pragma("unroll") for (int n = 0; n < 2; ++n) {
      int t = S_TOK(bj, n); float ss = 0.f;
      u16* xbp = xb + (long)t * DM;
      _Pragma("unroll") for (int ai = 0; ai < 2; ++ai) _Pragma("unroll") for (int m = 0; m < 4; ++m) {
        int f = S_FEAT(ai, m); f32x4 a = acc[ai][bj][m][n];
        uint2 xv = *(const uint2*)(xbp + f);
        float v0 = __uint_as_float(xv.x << 16) + a[0], v1 = __uint_as_float(xv.x & 0xffff0000u) + a[1];
        float v2 = __uint_as_float(xv.y << 16) + a[2], v3 = __uint_as_float(xv.y & 0xffff0000u) + a[3];
        *(uint2*)(xbp + f) = pack4(v0, v1, v2, v3);
        ss += v0 * v0 + v1 * v1 + v2 * v2 + v3 * v3;
      }
      ss += sx<16>(ss, fq * 16 + fr); ss += sx<32>(ss, fq * 16 + fr);
      if (fq == 0) part[(long)t * 16 + (fc0 >> 8) * 4 + wr] = ss;
      __builtin_amdgcn_sched_barrier(0);
    }
  }
};

struct EpiDaIn {
  const float* rowss; u16 *q, *k, *vT;
  __device__ __forceinline__ bool swap(int fc0) const { return (fc0 >> 10) < 2; }
  __device__ __forceinline__ void operator()(EPI_ARGS) {
    int sect = fc0 >> 10, cb = fc0 & 1023;
    if (sw) {
      u16* dst = sect ? k : q;
      _Pragma("unroll") for (int bj = 0; bj < 2; ++bj) _Pragma("unroll") for (int n = 0; n < 2; ++n) {
        int t = S_TOK(bj, n); float rs = row_rs(rowss, t); u16* d = dst + (long)t * DM + (cb - fc0);
        _Pragma("unroll") for (int ai = 0; ai < 2; ++ai) _Pragma("unroll") for (int m = 0; m < 4; ++m) {
          f32x4 a = acc[ai][bj][m][n]; *(uint2*)(d + S_FEAT(ai, m)) = pack4(a[0] * rs, a[1] * rs, a[2] * rs, a[3] * rs);
        }
      }
    } else {
      _Pragma("unroll") for (int ai = 0; ai < 2; ++ai) _Pragma("unroll") for (int m = 0; m < 4; ++m) {
        int r0 = U_TOK(ai, m); float rs[4];
        _Pragma("unroll") for (int j = 0; j < 4; ++j) rs[j] = row_rs(rowss, r0 + j);
        int b = r0 / SEQ, s0 = r0 % SEQ;
        _Pragma("unroll") for (int bj = 0; bj < 2; ++bj) _Pragma("unroll") for (int n = 0; n < 2; ++n) {
          int c = U_FEAT(bj, n) - fc0 + cb; f32x4 a = acc[ai][bj][m][n];
          *(uint2*)&vT[((long)(b * DM + c)) * SEQ + s0] = pack4(a[0] * rs[0], a[1] * rs[1], a[2] * rs[2], a[3] * rs[3]);
        }
        __builtin_amdgcn_sched_barrier(0);
      }
    }
  }
};

struct EpiHgIn {
  const float* rowss; const float* lbv; u16 *q, *logf_, *iT, *g;
  __device__ __forceinline__ bool swap(int fc0) const { return (fc0 >> 10) != 2; }
  __device__ __forceinline__ void operator()(EPI_ARGS) {
    int sect = fc0 >> 10, cb = fc0 & 1023;
    if (sw) {
      u16* dst = q + (long)sect * (32L << 20);
      _Pragma("unroll") for (int bj = 0; bj < 2; ++bj) _Pragma("unroll") for (int n = 0; n < 2; ++n) {
        int t = S_TOK(bj, n); float rs = row_rs(rowss, t); u16* d = dst + (long)t * DM + (cb - fc0);
        _Pragma("unroll") for (int ai = 0; ai < 2; ++ai) _Pragma("unroll") for (int m = 0; m < 4; ++m) {
          int f = S_FEAT(ai, m); f32x4 a = acc[ai][bj][m][n]; float v[4];
          if (sect == 0) { _Pragma("unroll") for (int j = 0; j < 4; ++j) v[j] = silu_f(a[j] * rs); }
          else if (sect == 1) {
            float4 lb = *(const float4*)&lbv[f - fc0 + cb]; float lbs[4] = {lb.x, lb.y, lb.z, lb.w};
            _Pragma("unroll") for (int j = 0; j < 4; ++j) v[j] = __logf(lbs[j] + (1.f - lbs[j]) * sigmoid_f(a[j] * rs));
          } else { _Pragma("unroll") for (int j = 0; j < 4; ++j) v[j] = a[j] * rs; }
          *(uint2*)(d + f) = pack4(v[0], v[1], v[2], v[3]);
        }
      }
    } else {
      _Pragma("unroll") for (int ai = 0; ai < 2; ++ai) _Pragma("unroll") for (int m = 0; m < 4; ++m) {
        int r0 = U_TOK(ai, m); float rs[4];
        _Pragma("unroll") for (int j = 0; j < 4; ++j) rs[j] = row_rs(rowss, r0 + j);
        _Pragma("unroll") for (int bj = 0; bj < 2; ++bj) _Pragma("unroll") for (int n = 0; n < 2; ++n) {
          int c = U_FEAT(bj, n) - fc0 + cb; f32x4 a = acc[ai][bj][m][n];
          *(uint2*)&iT[((long)(r0 >> 6) * DM + c) * 64 + (r0 & 63)] = pack4(a[0] * rs[0], a[1] * rs[1], a[2] * rs[2], a[3] * rs[3]);
        }
        __builtin_amdgcn_sched_barrier(0);
      }
    }
  }
};

__device__ __forceinline__ float gelu_f(float x) { return 0.5f * x * (1.f + erff(x * 0.70710678118654752f)); }

struct EpiSgIn {
  const float* rowss; u16 *u, *vT; float* rowss_v;
  __device__ __forceinline__ bool swap(int fc0) const { return (fc0 >> 10) == 0; }
  __device__ __forceinline__ void operator()(EPI_ARGS) {
    int cb = fc0 & 1023;
    if (sw) {
      _Pragma("unroll") for (int bj = 0; bj < 2; ++bj) _Pragma("unroll") for (int n = 0; n < 2; ++n) {
        int t = S_TOK(bj, n); float rs = row_rs(rowss, t); u16* d = u + (long)t * DM;
        _Pragma("unroll") for (int ai = 0; ai < 2; ++ai) _Pragma("unroll") for (int m = 0; m < 4; ++m) {
          f32x4 a = acc[ai][bj][m][n];
          *(uint2*)(d + S_FEAT(ai, m)) = pack4(gelu_f(a[0] * rs), gelu_f(a[1] * rs), gelu_f(a[2] * rs), gelu_f(a[3] * rs));
        }
      }
    } else {
      _Pragma("unroll") for (int ai = 0; ai < 2; ++ai) _Pragma("unroll") for (int m = 0; m < 4; ++m) {
        int r0 = U_TOK(ai, m); float rs[4], ss[4] = {0.f, 0.f, 0.f, 0.f};
        _Pragma("unroll") for (int j = 0; j < 4; ++j) rs[j] = row_rs(rowss, r0 + j);
        _Pragma("unroll") for (int bj = 0; bj < 2; ++bj) _Pragma("unroll") for (int n = 0; n < 2; ++n) {
          int c = U_FEAT(bj, n) - fc0 + cb; f32x4 a = acc[ai][bj][m][n];
          float gv[4]; _Pragma("unroll") for (int j = 0; j < 4; ++j) gv[j] = gelu_f(a[j] * rs[j]);
          *(uint2*)&vT[((long)(r0 >> 7) * DM + c) * 128 + (r0 & 127)] = pack4(gv[0], gv[1], gv[2], gv[3]);
          _Pragma("unroll") for (int j = 0; j < 4; ++j) ss[j] += gv[j] * gv[j];
        }
        _Pragma("unroll") for (int j = 0; j < 4; ++j) {
          float s = ss[j]; s += sx<1>(s, 0); s += sx<2>(s, 0); s += sx<4>(s, 0); s += sx<8>(s, 0);
          if (fr == 0) rowss_v[(long)(r0 + j) * 16 + (cb >> 8) * 4 + wc] = s;
        }
        __builtin_amdgcn_sched_barrier(0);
      }
    }
  }
};

struct EpiStore {
  const float* rowss; u16* dst; int ld;
  __device__ __forceinline__ bool swap(int) const { return true; }
  __device__ __forceinline__ void operator()(EPI_ARGS) {
    _Pragma("unroll") for (int bj = 0; bj < 2; ++bj) _Pragma("unroll") for (int n = 0; n < 2; ++n) {
      int t = S_TOK(bj, n); float rs = rowss ? row_rs(rowss, t) : 1.f; u16* d = dst + (long)t * ld;
      _Pragma("unroll") for (int ai = 0; ai < 2; ++ai) _Pragma("unroll") for (int m = 0; m < 4; ++m) {
        f32x4 a = acc[ai][bj][m][n]; *(uint2*)(d + S_FEAT(ai, m)) = pack4(a[0] * rs, a[1] * rs, a[2] * rs, a[3] * rs);
      }
    }
  }
};

struct EpiFfn {
  const float* rowss; u16* act;
  __device__ __forceinline__ bool swap(int) const { return true; }
  __device__ __forceinline__ void operator()(EPI_ARGS) {
    int tile = fc0 >> 8;
    _Pragma("unroll") for (int bj = 0; bj < 2; ++bj) _Pragma("unroll") for (int n = 0; n < 2; ++n) {
      int t = S_TOK(bj, n); float rs = row_rs(rowss, t); u16* d = act + (long)t * DFF + tile * 128 + wr * 64 + fq * 4;
      _Pragma("unroll") for (int m = 0; m < 4; ++m) {
        f32x4 g = acc[0][bj][m][n], u = acc[1][bj][m][n]; float v[4];
        _Pragma("unroll") for (int j = 0; j < 4; ++j) v[j] = silu_f(g[j] * rs) * (u[j] * rs);
        *(uint2*)(d + m * 16) = pack4(v[0], v[1], v[2], v[3]);
      }
    }
  }
};

struct EpiMemKV {
  u16 *K, *VT;
  __device__ __forceinline__ bool swap(int fc0) const { return (fc0 >> 10) == 0; }
  __device__ __forceinline__ void operator()(EPI_ARGS) {
    int cb = fc0 & 1023;
    if (sw) {
      _Pragma("unroll") for (int bj = 0; bj < 2; ++bj) _Pragma("unroll") for (int n = 0; n < 2; ++n) {
        int t = S_TOK(bj, n); u16* d = K + (long)t * DM;
        _Pragma("unroll") for (int ai = 0; ai < 2; ++ai) _Pragma("unroll") for (int m = 0; m < 4; ++m) {
          f32x4 a = acc[ai][bj][m][n]; *(uint2*)(d + S_FEAT(ai, m)) = pack4(a[0], a[1], a[2], a[3]);
        }
      }
    } else {
      _Pragma("unroll") for (int ai = 0; ai < 2; ++ai) _Pragma("unroll") for (int m = 0; m < 4; ++m) {
        int r0 = U_TOK(ai, m);
        _Pragma("unroll") for (int bj = 0; bj < 2; ++bj) _Pragma("unroll") for (int n = 0; n < 2; ++n) {
          int c = U_FEAT(bj, n) - fc0 + cb; f32x4 a = acc[ai][bj][m][n];
          *(uint2*)&VT[((long)((r0 >> 8) * DM + c)) * MEML + (r0 & 255)] = pack4(a[0], a[1], a[2], a[3]);
        }
      }
    }
  }
};

__device__ __forceinline__ void prep_phase(const Params& p, KArgsP kap, char* shm, int wv) {
  int tid = opaque_tid(wv), bid = blockIdx.x, G = gridDim.x;
  int lane = tid & 63, wid = tid >> 6;
  for (int row = bid * 8 + wid; row < T_TOK; row += G * 8) {
    const float4* src = (const float4*)(p.x + (long)row * DM);
    float ss = 0.f;
    _Pragma("unroll") for (int i = 0; i < 4; ++i) {
      float4 v = src[i * 64 + lane];
      ss += v.x * v.x + v.y * v.y + v.z * v.z + v.w * v.w;
      *(uint2*)&p.xb[(long)row * DM + (i * 64 + lane) * 4] = pack4(v.x, v.y, v.z, v.w);
    }
    ss = wave_sum(ss, lane);
    if (lane < 16) p.rpart[(long)row * 16 + lane] = (lane == 0) ? ss : 0.f;
  }
  for (int row = bid * 8 + wid; row < NB * MEML; row += G * 8) {
    const float4* src = (const float4*)(p.mem + (long)row * DM);
    float4 v[4]; float ss = 0.f;
    _Pragma("unroll") for (int i = 0; i < 4; ++i) { v[i] = src[i * 64 + lane]; ss += v[i].x * v[i].x + v[i].y * v[i].y + v[i].z * v[i].z + v[i].w * v[i].w; }
    ss = wave_sum(ss, lane);
    float rs = rsqrtf(ss * (1.f / DM) + EPS);
    _Pragma("unroll") for (int i = 0; i < 4; ++i) {
      float4 g = ((const float4*)p.norm_mem)[i * 64 + lane];
      *(uint2*)&p.memn[(long)row * DM + (i * 64 + lane) * 4] = pack4(v[i].x * rs * g.x, v[i].y * rs * g.y, v[i].z * rs * g.z, v[i].w * rs * g.w);
    }
  }
  if (bid == 0) {
    for (int i = tid; i < 3456; i += 512) ((unsigned*)((char*)p.xb - OFF_XB + OFF_BAR))[i] = 0u;
    for (int c = tid; c < DM; c += 512) {
      float v0 = p.hg_lb[c], v1 = p.hg_lb[DM + c], v2 = p.hg_lb[2 * DM + c], v3 = p.hg_lb[3 * DM + c];
      float mx = fmaxf(fmaxf(v0, v1), fmaxf(v2, v3));
      float e0 = expf(v0 - mx), e1 = expf(v1 - mx), e2 = expf(v2 - mx), e3 = expf(v3 - mx);
      p.lbv[c] = e1 / (e0 + e1 + e2 + e3);
    }
    for (int i = tid; i < 8 * 128; i += 512) {
      int h = i >> 7, n = i & 127, bucket;
      if (n < 16) bucket = n;
      else { float nf = (float)n; int lg = 16 + (int)(logf(nf / 16.f) / 2.0794415416798357f * 16.f); bucket = lg < 31 ? lg : 31; }
      p.biastab[i] = p.rel_bias[h * 32 + bucket] * LOG2E;
    }
  }
  float* tl = (float*)shm;
  for (int t = bid; t < kap->total_wtiles; t += G) {
    int wi = 0;
    while (wi + 1 < kap->nwd && kap->wd[wi + 1].tile0 <= t) ++wi;
    const float* src = kap->wd[wi].src; u16* dst = kap->wd[wi].dst; const float* gain = kap->wd[wi].gain;
    int K = kap->wd[wi].K, N = kap->wd[wi].N, perm = kap->wd[wi].perm;
    int lt = t - kap->wd[wi].tile0, nNt = N >> 6;
    int k0 = (lt / nNt) * 64, n0 = (lt % nNt) * 64;
    {
      int kk = tid >> 3, seg = (tid & 7) * 8;
      const float4* s4 = (const float4*)(src + (long)(k0 + kk) * N + n0 + seg);
      float4 a = s4[0], b = s4[1]; float g = gain ? gain[k0 + kk] : 1.f;
      float* d = tl + kk * 65 + seg;
      d[0] = a.x * g; d[1] = a.y * g; d[2] = a.z * g; d[3] = a.w * g; d[4] = b.x * g; d[5] = b.y * g; d[6] = b.z * g; d[7] = b.w * g;
    }
    __syncthreads();
    {
      int nn = tid >> 3, seg = (tid & 7) * 8;
      int n = n0 + nn, drow = n;
      if (perm) { int part = n / DFF, idx = n % DFF; drow = (idx >> 7) * 256 + part * 128 + (idx & 127); }
      float v[8]; _Pragma("unroll") for (int i = 0; i < 8; ++i) v[i] = tl[(seg + i) * 65 + nn];
      uint4 o; uint2 lo = pack4(v[0], v[1], v[2], v[3]), hi = pack4(v[4], v[5], v[6], v[7]);
      o.x = lo.x; o.y = lo.y; o.z = hi.x; o.w = hi.y;
      *(uint4*)&dst[(long)drow * K + k0 + seg] = o;
    }
    __syncthreads();
  }
}

template <int NC, int DQK, int DV, bool CAUSAL, bool PF>
__device__ __forceinline__ void flash_item(const u16* __restrict__ Qg, int q_stride, const u16* __restrict__ Kg, int k_stride,
                                           const u16* __restrict__ VTg, int vt_stride, int nkt, int q0, float scale_log2,
                                           const float* btab, float lam, const float* subln_g, float outscale,
                                           u16* __restrict__ Og, int o_stride, char* shm, int wv) {
  constexpr int KW = NC * DQK, KLD = KW + 8, VLD = 72;
  constexpr int KBUF = 64 * KLD, VBUF = DV * VLD;
  constexpr int KCH = KW / 8, KPT = 64 * KCH / 512, VPT = DV * 8 / 512;
  constexpr int NKS = DQK / 32, NVT = DV / 16;
  u16* Ks = (u16*)shm; u16* Vs = Ks + 2 * KBUF;
  int tid = opaque_tid(wv), wid = tid >> 6, lane = tid & 63, fr = lane & 15, fq = lane >> 4;
  int qw0 = q0 + wid * 16, qpos = qw0 + fr;

  bf16x8 qf[NC][NKS];
  _Pragma("unroll") for (int c = 0; c < NC; ++c) _Pragma("unroll") for (int ks = 0; ks < NKS; ++ks)
    qf[c][ks] = *(const bf16x8*)&Qg[(long)(wid * 16 + fr) * q_stride + c * DQK + ks * 32 + fq * 8];
  f32x4 O[NC][NVT];
  _Pragma("unroll") for (int c = 0; c < NC; ++c) _Pragma("unroll") for (int v = 0; v < NVT; ++v) O[c][v] = f32x4{0.f, 0.f, 0.f, 0.f};
  float mrun[NC], lsum[NC];
  _Pragma("unroll") for (int c = 0; c < NC; ++c) { mrun[c] = -1e30f; lsum[c] = 0.f; }

  u32x4 kreg[KPT], vreg[VPT];
#define FA_PREFETCH(kt_) do { int k0_ = (kt_) * 64; \
    _Pragma("unroll") for (int i = 0; i < KPT; ++i) { int id = tid + i * 512, row = id / KCH, cc = id % KCH; kreg[i] = *(const u32x4*)&Kg[(long)(k0_ + row) * k_stride + cc * 8]; } \
    _Pragma("unroll") for (int i = 0; i < VPT; ++i) { int id = tid + i * 512, row = id >> 3, cc = id & 7; vreg[i] = *(const u32x4*)&VTg[(long)row * vt_stride + k0_ + cc * 8]; } } while (0)
  if (PF) FA_PREFETCH(0);
  for (int kt = 0; kt < nkt; ++kt) {
    if (!PF) FA_PREFETCH(kt);
    u16* Kb = Ks + (kt & 1) * KBUF; u16* Vb = Vs + (kt & 1) * VBUF;
    _Pragma("unroll") for (int i = 0; i < KPT; ++i) { int id = tid + i * 512, row = id / KCH, cc = id % KCH; *(u32x4*)&Kb[row * KLD + cc * 8] = kreg[i]; }
    _Pragma("unroll") for (int i = 0; i < VPT; ++i) { int id = tid + i * 512, row = id >> 3, cc = id & 7; *(u32x4*)&Vb[row * VLD + cc * 8] = vreg[i]; }
    __syncthreads();
    if (PF && kt + 1 < nkt) FA_PREFETCH(kt + 1);
    int k0 = kt * 64;
    if (CAUSAL && k0 > qw0 + 15) continue;
    bf16x8 pf[NC][2];
    _Pragma("unroll") for (int c = 0; c < NC; ++c) {
      f32x4 s[4];
      _Pragma("unroll") for (int m = 0; m < 4; ++m) s[m] = f32x4{0.f, 0.f, 0.f, 0.f};
      _Pragma("unroll") for (int ks = 0; ks < NKS; ++ks) _Pragma("unroll") for (int m = 0; m < 4; ++m) {
        bf16x8 a = *(const bf16x8*)&Kb[(16 * m + fr) * KLD + c * DQK + ks * 32 + fq * 8];
        s[m] = __builtin_amdgcn_mfma_f32_16x16x32_bf16(a, qf[c][ks], s[m], 0, 0, 0);
      }
      bool general = false; float bb = 0.f;
      if (CAUSAL) { general = (qw0 - (k0 + 63)) < 128; bb = btab[127]; }
      float mnew, alpha, psum = 0.f;
      if (general) {
        bool diag = (k0 + 63) > qw0; float tmax = -1e30f;
        _Pragma("unroll") for (int m = 0; m < 4; ++m) _Pragma("unroll") for (int j = 0; j < 4; ++j) {
          int dist = qpos - (k0 + 16 * m + fq * 4 + j);
          int di = dist < 0 ? 0 : (dist > 127 ? 127 : dist);
          float v = s[m][j] * scale_log2 + btab[di];
          if (diag && dist < 0) v = -1e30f;
          s[m][j] = v; tmax = fmaxf(tmax, v);
        }
        tmax = fmaxf(tmax, sx<16>(tmax, lane)); tmax = fmaxf(tmax, sx<32>(tmax, lane));
        mnew = fmaxf(mrun[c], tmax);
        _Pragma("unroll") for (int m = 0; m < 4; ++m) _Pragma("unroll") for (int j = 0; j < 4; ++j) { float pv = __builtin_amdgcn_exp2f(s[m][j] - mnew); s[m][j] = pv; psum += pv; }
      } else {
        float rmax = fmaxf(fmaxf(s[0][0], s[0][1]), fmaxf(s[0][2], s[0][3]));
        _Pragma("unroll") for (int m = 1; m < 4; ++m) rmax = fmaxf(rmax, fmaxf(fmaxf(s[m][0], s[m][1]), fmaxf(s[m][2], s[m][3])));
        rmax = fmaxf(rmax, sx<16>(rmax, lane)); rmax = fmaxf(rmax, sx<32>(rmax, lane));
        mnew = fmaxf(mrun[c], rmax * scale_log2 + bb);
        float cc = bb - mnew;
        _Pragma("unroll") for (int m = 0; m < 4; ++m) _Pragma("unroll") for (int j = 0; j < 4; ++j) { float pv = __builtin_amdgcn_exp2f(s[m][j] * scale_log2 + cc); s[m][j] = pv; psum += pv; }
      }
      alpha = __builtin_amdgcn_exp2f(mrun[c] - mnew);
      mrun[c] = mnew;
      lsum[c] = lsum[c] * alpha + psum;
      if (__builtin_amdgcn_ballot_w64(alpha != 1.f) != 0ull) {
        _Pragma("unroll") for (int v = 0; v < NVT; ++v) _Pragma("unroll") for (int j = 0; j < 4; ++j) O[c][v][j] *= alpha;
      }
      _Pragma("unroll") for (int k2 = 0; k2 < 2; ++k2) {
        uint2 lo = pack4(s[2 * k2][0], s[2 * k2][1], s[2 * k2][2], s[2 * k2][3]);
        uint2 hi = pack4(s[2 * k2 + 1][0], s[2 * k2 + 1][1], s[2 * k2 + 1][2], s[2 * k2 + 1][3]);
        uint4 pk; pk.x = lo.x; pk.y = lo.y; pk.z = hi.x; pk.w = hi.y;
        pf[c][k2] = *(bf16x8*)&pk;
      }
    }
    _Pragma("unroll") for (int k2 = 0; k2 < 2; ++k2) _Pragma("unroll") for (int v = 0; v < NVT; ++v) {
      uint2 lo = *(const uint2*)&Vb[(16 * v + fr) * VLD + 32 * k2 + fq * 4];
      uint2 hi = *(const uint2*)&Vb[(16 * v + fr) * VLD + 32 * k2 + 16 + fq * 4];
      uint4 pk; pk.x = lo.x; pk.y = lo.y; pk.z = hi.x; pk.w = hi.y;
      bf16x8 a = *(bf16x8*)&pk;
      _Pragma("unroll") for (int c = 0; c < NC; ++c) O[c][v] = __builtin_amdgcn_mfma_f32_16x16x32_bf16(a, pf[c][k2], O[c][v], 0, 0, 0);
      if ((v & 3) == 3) __builtin_amdgcn_sched_barrier(0);
    }
  }
  float inv[NC];
  _Pragma("unroll") for (int c = 0; c < NC; ++c) { float l = lsum[c]; l += sx<16>(l, lane); l += sx<32>(l, lane); inv[c] = 1.f / l; }
  u16* orow = Og + (long)(wid * 16 + fr) * o_stride;
  if (NC == 2) {
    float ss = 0.f;
    _Pragma("unroll") for (int v = 0; v < NVT; ++v) _Pragma("unroll") for (int j = 0; j < 4; ++j) { float o = O[0][v][j] * inv[0] - lam * O[NC - 1][v][j] * inv[NC - 1]; O[0][v][j] = o; ss += o * o; }
    ss += sx<16>(ss, lane); ss += sx<32>(ss, lane);
    float rs = rsqrtf(ss * (1.f / DV) + EPS) * outscale;
    _Pragma("unroll") for (int v = 0; v < NVT; ++v) {
      float4 g = *(const float4*)&subln_g[16 * v + fq * 4];
      *(uint2*)&orow[16 * v + fq * 4] = pack4(O[0][v][0] * rs * g.x, O[0][v][1] * rs * g.y, O[0][v][2] * rs * g.z, O[0][v][3] * rs * g.w);
    }
  } else {
    _Pragma("unroll") for (int v = 0; v < NVT; ++v)
      *(uint2*)&orow[16 * v + fq * 4] = pack4(O[0][v][0] * inv[0], O[0][v][1] * inv[0], O[0][v][2] * inv[0], O[0][v][3] * inv[0]);
  }
}

__device__ __forceinline__ void diff_attn_phase(const Params& p, int j, int layer_idx, char* shm, int wv) {
  int tid = opaque_tid(wv), lane = tid & 63;
  float* btab = (float*)(shm + LDS_BYTES - 1024);
  float sa = p.da_lq1[j * 64 + lane] * p.da_lk1[j * 64 + lane], sb = p.da_lq2[j * 64 + lane] * p.da_lk2[j * 64 + lane];
  sa = wave_sum(sa, lane); sb = wave_sum(sb, lane);
  float lam_init = 0.8f - 0.6f * expf(-0.3f * (float)layer_idx);
  float lam = expf(sa) - expf(sb) + lam_init;
  const u16 *qb = p.B0, *kb = p.B1, *vT = p.B2; u16* ao = p.B3;
  for (int i = blockIdx.x; i < 2048; i += gridDim.x) {
    int wgl = i & 255, step = i >> 8, xcd = wgl & 7, slot = wgl >> 3;
    int bh = xcd + 8 * (step >> 1), qblk = (step & 1) ? 63 - slot : slot;
    int b = bh >> 3, h = bh & 7, q0 = qblk * 128;
    __syncthreads();
    if (tid < 128) btab[tid] = p.biastab[h * 128 + tid];
    flash_item<2, 64, 128, true, true>(qb + ((long)(b * SEQ + q0)) * DM + h * 128, DM, kb + ((long)b * SEQ) * DM + h * 128, DM,
                                 vT + ((long)(b * DM + h * 128)) * SEQ, SEQ, q0 / 64 + 2, q0, 0.125f * LOG2E, btab, lam,
                                 p.da_subln + j * 128, 1.f - lam_init, ao + ((long)(b * SEQ + q0)) * DM + h * 128, DM, shm, wv);
  }
}

__device__ __forceinline__ void cross_attn_phase(const Params& p, int layer, char* shm, int wv) {
  const u16* caq = p.B0; u16* cao = p.B1;
  const u16* mK = p.memK + (long)layer * NB * MEML * DM; const u16* mVT = p.memVT + (long)layer * NB * DM * MEML;
  for (int i = blockIdx.x; i < 1024; i += gridDim.x) {
    int head = i & 3, blk = i >> 2, b = blk >> 6, qblk = blk & 63;
    __syncthreads();
    flash_item<1, 256, 256, false, true>(caq + ((long)(b * SEQ + qblk * 128)) * DM + head * 256, DM, mK + ((long)b * MEML) * DM + head * 256, DM,
                                   mVT + ((long)(b * DM + head * 256)) * MEML, MEML, 4, 0, 0.0625f * LOG2E, nullptr, 0.f, nullptr, 1.f,
                                   cao + ((long)(b * SEQ + qblk * 128)) * DM + head * 256, DM, shm, wv);
  }
}

constexpr int HLD = 132;
__device__ __forceinline__ long kdt_off(int tok0, int h, int k) {
  return ((long)(tok0 + (k >> 1)) * DM + h * 128) + (k & 1) * 64;
}

__device__ __forceinline__ void hg1_phase(const Params& p, char* shm, int wv) {
  float* L = (float*)shm; float* Gs = L + 64 * HLD; float* Qs = Gs + 64 * HLD; float* R = Qs + 64 * HLD;
  int tid = opaque_tid(wv), wid = tid >> 6, lane = tid & 63, fr = lane & 15, fq = lane >> 4;
  u16* qbuf = p.B0; u16* lfbuf = p.B1; u16* Abuf = p.B4;
  u32x4 plv[2], pqv[2];
#define HG1_PREFETCH(it_) do { int h_ = (it_) & 7, cn_ = ((it_) >> 3) & 127, b_ = (it_) >> 10, tk_ = b_ * SEQ + cn_ * 64; \
    _Pragma("unroll") for (int i = 0; i < 2; ++i) { int id = tid + i * 512, row = id >> 4, cc = id & 15; \
      plv[i] = *(const u32x4*)&lfbuf[(long)(tk_ + row) * DM + h_ * 128 + cc * 8]; pqv[i] = *(const u32x4*)&qbuf[(long)(tk_ + row) * DM + h_ * 128 + cc * 8]; } } while (0)
  if ((int)blockIdx.x < 4096) HG1_PREFETCH((int)blockIdx.x);
  for (int it = blockIdx.x; it < 4096; it += gridDim.x) {
    int h = it & 7, cn = (it >> 3) & 127, b = it >> 10, tok0 = b * SEQ + cn * 64;
    __syncthreads();
    _Pragma("unroll") for (int i = 0; i < 2; ++i) {
      int id = tid + i * 512, row = id >> 4, cc = id & 15;
      _Pragma("unroll") for (int e = 0; e < 4; ++e) {
        unsigned lw = plv[i][e], qw = pqv[i][e];
        L[row * HLD + cc * 8 + 2 * e] = __uint_as_float(lw << 16); L[row * HLD + cc * 8 + 2 * e + 1] = __uint_as_float(lw & 0xffff0000u);
        Qs[row * HLD + cc * 8 + 2 * e] = __uint_as_float(qw << 16); Qs[row * HLD + cc * 8 + 2 * e + 1] = __uint_as_float(qw & 0xffff0000u);
      }
    }
    __syncthreads();
    if (it + (int)gridDim.x < 4096) HG1_PREFETCH(it + (int)gridDim.x);
    {
      int k = tid & 127, qd = tid >> 7; float run = 0.f;
      _Pragma("unroll") for (int i = 0; i < 16; ++i) { run += L[(16 * qd + i) * HLD + k]; Gs[(16 * qd + i) * HLD + k] = run; }
      R[(qd + 1) * 128 + k] = run;
    }
    __syncthreads();
    {
      int k = tid & 127, qd = tid >> 7; float r = 0.f;
      for (int i = 0; i < qd; ++i) r += R[(i + 1) * 128 + k];
      float tot = R[(qd + 1) * 128 + k];
      __syncthreads();
      _Pragma("unroll") for (int i = 0; i < 16; ++i) Gs[(16 * qd + i) * HLD + k] += r;
      R[qd * 128 + k] = r;
      if (qd == 3) R[4 * 128 + k] = r + tot;
    }
    __syncthreads();
    _Pragma("unroll") for (int i = 0; i < 2; ++i) {
      int id = tid + i * 512, row = id >> 4, cc = id & 15; float v[8];
      _Pragma("unroll") for (int e = 0; e < 8; ++e) v[e] = Qs[row * HLD + cc * 8 + e] * __expf(Gs[row * HLD + cc * 8 + e]);
      uint2 lo = pack4(v[0], v[1], v[2], v[3]), hi = pack4(v[4], v[5], v[6], v[7]);
      uint4 o; o.x = lo.x; o.y = lo.y; o.z = hi.x; o.w = hi.y;
      *(uint4*)&qbuf[(long)(tok0 + row) * DM + h * 128 + cc * 8] = o;
    }
    _Pragma("unroll") for (int i = 0; i < 2; ++i) {
      int id = tid + i * 512, k = id & 127, sc = id >> 7; float gl = R[4 * 128 + k]; float v[8];
      _Pragma("unroll") for (int e = 0; e < 8; ++e) { int s = sc * 8 + e; v[e] = (1.f - __expf(L[s * HLD + k])) * __expf(gl - Gs[s * HLD + k]); }
      uint2 lo = pack4(v[0], v[1], v[2], v[3]), hi = pack4(v[4], v[5], v[6], v[7]);
      uint4 o; o.x = lo.x; o.y = lo.y; o.z = hi.x; o.w = hi.y;
      *(uint4*)&lfbuf[kdt_off(tok0, h, k) + sc * 8] = o;
    }
    if (tid < 128) p.dbuf[(long)it * 128 + tid] = __expf(R[4 * 128 + tid]);
    u16* Ait = Abuf + (long)it * 4096;
    for (int blk = wid; blk < 10; blk += 8) {
      int ti = blk < 1 ? 0 : (blk < 3 ? 1 : (blk < 6 ? 2 : 3));
      int sj = blk - (ti * (ti + 1)) / 2;
      f32x4 acc = {0.f, 0.f, 0.f, 0.f};
      _Pragma("unroll") for (int ks = 0; ks < 4; ++ks) {
        float av[8], bv[8];
        _Pragma("unroll") for (int e = 0; e < 8; ++e) {
          int kk = ks * 32 + fq * 8 + e; float rr = R[ti * 128 + kk];
          av[e] = Qs[(16 * ti + fr) * HLD + kk] * __expf(Gs[(16 * ti + fr) * HLD + kk] - rr);
          bv[e] = (1.f - __expf(L[(16 * sj + fr) * HLD + kk])) * __expf(fminf(rr - Gs[(16 * sj + fr) * HLD + kk], 80.f));
        }
        uint2 al = pack4(av[0], av[1], av[2], av[3]), ah = pack4(av[4], av[5], av[6], av[7]);
        uint2 bl = pack4(bv[0], bv[1], bv[2], bv[3]), bh = pack4(bv[4], bv[5], bv[6], bv[7]);
        uint4 a4, b4; a4.x = al.x; a4.y = al.y; a4.z = ah.x; a4.w = ah.y; b4.x = bl.x; b4.y = bl.y; b4.z = bh.x; b4.w = bh.y;
        acc = __builtin_amdgcn_mfma_f32_16x16x32_bf16(*(bf16x8*)&a4, *(bf16x8*)&b4, acc, 0, 0, 0);
      }
      _Pragma("unroll") for (int j = 0; j < 4; ++j) {
        int t = 16 * ti + fq * 4 + j, s = 16 * sj + fr;
        float v = (s <= t) ? acc[j] : 0.f;
        Ait[t * 64 + s] = f2bf(v);
      }
    }
    if (wid < 6) {
      int ti = wid < 3 ? 0 : (wid < 5 ? 1 : 2);
      int sj = wid < 3 ? wid + 1 : (wid < 5 ? wid - 1 : 3);
      _Pragma("unroll") for (int j = 0; j < 4; ++j) Ait[(16 * ti + fq * 4 + j) * 64 + 16 * sj + fr] = 0;
    }
  }
}

template <int MODE>
__device__ __forceinline__ void hg2_phase(const Params& p, char* shm, int wv) {
  constexpr int QLD = 136, KLD = 72;
  constexpr int QB = 64 * QLD, KB = 128 * KLD, AB = 64 * KLD, VB = 128 * KLD;
  constexpr int BUF_EL = QB + KB + AB + VB + 256;
  int tid = opaque_tid(wv), wid = tid >> 6, lane = tid & 63, fr = lane & 15, fq = lane >> 4;
  u16* qbuf = p.B0; const u16* kdbuf = p.B1; const u16* iT = p.B2; const u16* Abuf = p.B4;
  float* Send = p.out; float* Dseg = Send + 32L * 8 * 128 * 128;
  for (int it = blockIdx.x; it < 256; it += gridDim.x) {
    int bh = it >> 3, seg = it & 7, b = bh >> 3, h = bh & 7;
    if (MODE == 0 && seg == 7) continue;
    f32x4 S[8];
    _Pragma("unroll") for (int m = 0; m < 8; ++m) S[m] = f32x4{0.f, 0.f, 0.f, 0.f};
    if (MODE == 1) {
      for (int g = 0; g < seg; ++g) {
        const float* se = Send + ((long)(bh * 8 + g)) * 16384; const float* dg = Dseg + (bh * 8 + g) * 128;
        _Pragma("unroll") for (int m = 0; m < 8; ++m) {
          float4 dv = *(const float4*)&dg[16 * m + fq * 4];
          S[m][0] = S[m][0] * dv.x + se[(16 * m + fq * 4 + 0) * 128 + 16 * wid + fr];
          S[m][1] = S[m][1] * dv.y + se[(16 * m + fq * 4 + 1) * 128 + 16 * wid + fr];
          S[m][2] = S[m][2] * dv.z + se[(16 * m + fq * 4 + 2) * 128 + 16 * wid + fr];
          S[m][3] = S[m][3] * dv.w + se[(16 * m + fq * 4 + 3) * 128 + 16 * wid + fr];
        }
      }
    }
    float dacc = 1.f;
    u32x4 rq[2], rk[2], ra, rv[2]; f32x4 rd = {0.f, 0.f, 0.f, 0.f};
#define HG_PREFETCH(cn_) do { int tok0_ = b * SEQ + (cn_) * 64; long it_ = ((long)(b * 128 + (cn_))) * 8 + h; \
      if (MODE == 1) { _Pragma("unroll") for (int i = 0; i < 2; ++i) { int id = tid + i * 512, row = id >> 4, cc = id & 15; rq[i] = *(const u32x4*)&qbuf[(long)(tok0_ + row) * DM + h * 128 + cc * 8]; } } \
      _Pragma("unroll") for (int i = 0; i < 2; ++i) { int id = tid + i * 512, k = id >> 3, sc = id & 7; rk[i] = *(const u32x4*)&kdbuf[kdt_off(tok0_, h, k) + sc * 8]; } \
      if (MODE == 1) { int t = tid >> 3, sc = tid & 7; ra = *(const u32x4*)&Abuf[it_ * 4096 + t * 64 + sc * 8]; } \
      _Pragma("unroll") for (int i = 0; i < 2; ++i) { int id = tid + i * 512, v = id >> 3, sc = id & 7; rv[i] = *(const u32x4*)&iT[((long)(b * 128 + (cn_)) * DM + h * 128 + v) * 64 + sc * 8]; } \
      if (tid < 32) rd = *(const f32x4*)&p.dbuf[it_ * 128 + tid * 4]; } while (0)
#define HG_STASH(bi_) do { \
      u16* base_ = (u16*)shm + (bi_) * BUF_EL; u16* Qt_ = base_; u16* Kd_ = Qt_ + QB; u16* At_ = Kd_ + KB; u16* Vt_ = At_ + AB; float* dd_ = (float*)(Vt_ + VB); \
      if (MODE == 1) { _Pragma("unroll") for (int i = 0; i < 2; ++i) { int id = tid + i * 512, row = id >> 4, cc = id & 15; *(u32x4*)&Qt_[row * QLD + cc * 8] = rq[i]; } } \
      _Pragma("unroll") for (int i = 0; i < 2; ++i) { int id = tid + i * 512, k = id >> 3, sc = id & 7; *(u32x4*)&Kd_[k * KLD + sc * 8] = rk[i]; } \
      if (MODE == 1) { int t = tid >> 3, sc = tid & 7; *(u32x4*)&At_[t * KLD + sc * 8] = ra; } \
      _Pragma("unroll") for (int i = 0; i < 2; ++i) { int id = tid + i * 512, v = id >> 3, sc = id & 7; *(u32x4*)&Vt_[v * KLD + sc * 8] = rv[i]; } \
      if (tid < 32) *(f32x4*)&dd_[tid * 4] = rd; } while (0)
    __syncthreads();
    HG_PREFETCH(seg * 16); HG_STASH(0);
    for (int c = 0; c < 16; ++c) {
      int cn = seg * 16 + c;
      __syncthreads();
      if (c + 1 < 16) HG_PREFETCH(cn + 1);
      u16* base = (u16*)shm + (c & 1) * BUF_EL; u16* Qt = base; u16* Kd = Qt + QB; u16* At = Kd + KB; u16* Vt = At + AB; float* dd = (float*)(Vt + VB);
      bf16x8 vb[2];
      _Pragma("unroll") for (int k2 = 0; k2 < 2; ++k2) vb[k2] = *(const bf16x8*)&Vt[(16 * wid + fr) * KLD + k2 * 32 + fq * 8];
      if (MODE == 1) {
        bf16x8 Sb[4];
        _Pragma("unroll") for (int ks = 0; ks < 4; ++ks) {
          uint2 lo = pack4(S[2 * ks][0], S[2 * ks][1], S[2 * ks][2], S[2 * ks][3]);
          uint2 hi = pack4(S[2 * ks + 1][0], S[2 * ks + 1][1], S[2 * ks + 1][2], S[2 * ks + 1][3]);
          uint4 pk; pk.x = lo.x; pk.y = lo.y; pk.z = hi.x; pk.w = hi.y; Sb[ks] = *(bf16x8*)&pk;
        }
        int tok0 = b * SEQ + cn * 64;
        _Pragma("unroll") for (int rt = 0; rt < 4; ++rt) {
          f32x4 o = {0.f, 0.f, 0.f, 0.f};
          _Pragma("unroll") for (int ks = 0; ks < 4; ++ks) {
            uint2 lo = *(const uint2*)&Qt[(16 * rt + fr) * QLD + 32 * ks + fq * 4];
            uint2 hi = *(const uint2*)&Qt[(16 * rt + fr) * QLD + 32 * ks + 16 + fq * 4];
            uint4 pk; pk.x = lo.x; pk.y = lo.y; pk.z = hi.x; pk.w = hi.y;
            o = __builtin_amdgcn_mfma_f32_16x16x32_bf16(*(bf16x8*)&pk, Sb[ks], o, 0, 0, 0);
          }
          _Pragma("unroll") for (int k2 = 0; k2 < 2; ++k2) {
            bf16x8 a = *(const bf16x8*)&At[(16 * rt + fr) * KLD + k2 * 32 + fq * 8];
            o = __builtin_amdgcn_mfma_f32_16x16x32_bf16(a, vb[k2], o, 0, 0, 0);
          }
          _Pragma("unroll") for (int j = 0; j < 4; ++j) qbuf[(long)(tok0 + 16 * rt + fq * 4 + j) * DM + h * 128 + 16 * wid + fr] = f2bf(o[j]);
        }
      } else if (tid < 128) dacc *= dd[tid];
      _Pragma("unroll") for (int m = 0; m < 8; ++m) {
        float4 dv = *(const float4*)&dd[16 * m + fq * 4];
        S[m][0] *= dv.x; S[m][1] *= dv.y; S[m][2] *= dv.z; S[m][3] *= dv.w;
        _Pragma("unroll") for (int k2 = 0; k2 < 2; ++k2) {
          bf16x8 a = *(const bf16x8*)&Kd[(16 * m + fr) * KLD + k2 * 32 + fq * 8];
          S[m] = __builtin_amdgcn_mfma_f32_16x16x32_bf16(a, vb[k2], S[m], 0, 0, 0);
        }
      }
      if (c + 1 < 16) HG_STASH((c + 1) & 1);
    }
    if (MODE == 0) {
      float* se = Send + ((long)(bh * 8 + seg)) * 16384;
      _Pragma("unroll") for (int m = 0; m < 8; ++m) _Pragma("unroll") for (int j = 0; j < 4; ++j) se[(16 * m + fq * 4 + j) * 128 + 16 * wid + fr] = S[m][j];
      if (tid < 128) Dseg[(bh * 8 + seg) * 128 + tid] = dacc;
    }
  }
}

__device__ __forceinline__ void hg3_phase(const Params& p, int wv) {
  int tid = opaque_tid(wv); int wid = tid >> 6, lane = tid & 63;
  u16* ob = p.B0; const u16* gb = p.B3;
  for (int row = blockIdx.x * 8 + wid; row < T_TOK; row += gridDim.x * 8) {
    uint4 o0 = *(const uint4*)&ob[(long)row * DM + lane * 16], o1 = *(const uint4*)&ob[(long)row * DM + lane * 16 + 8];
    uint4 g0 = *(const uint4*)&gb[(long)row * DM + lane * 16], g1 = *(const uint4*)&gb[(long)row * DM + lane * 16 + 8];
    float o[16], g[16];
    const u16* po0 = (const u16*)&o0; const u16* po1 = (const u16*)&o1; const u16* pg0 = (const u16*)&g0; const u16* pg1 = (const u16*)&g1;
    _Pragma("unroll") for (int e = 0; e < 8; ++e) { o[e] = bf2f(po0[e]); o[8 + e] = bf2f(po1[e]); g[e] = bf2f(pg0[e]); g[8 + e] = bf2f(pg1[e]); }
    float ss = 0.f; _Pragma("unroll") for (int e = 0; e < 16; ++e) ss += o[e] * o[e];
    ss += sx<1>(ss, lane); ss += sx<2>(ss, lane); ss += sx<4>(ss, lane);
    float rs = rsqrtf(ss * (1.f / 128.f) + EPS);
    int c0 = (lane & 7) * 16; float r[16];
    _Pragma("unroll") for (int e = 0; e < 16; ++e) r[e] = o[e] * rs * p.hg_onorm[c0 + e] * silu_f(g[e]);
    uint2 a = pack4(r[0], r[1], r[2], r[3]), b2 = pack4(r[4], r[5], r[6], r[7]), c = pack4(r[8], r[9], r[10], r[11]), d = pack4(r[12], r[13], r[14], r[15]);
    uint4 w0, w1; w0.x = a.x; w0.y = a.y; w0.z = b2.x; w0.w = b2.y; w1.x = c.x; w1.y = c.y; w1.z = d.x; w1.w = d.y;
    *(uint4*)&ob[(long)row * DM + lane * 16] = w0; *(uint4*)&ob[(long)row * DM + lane * 16 + 8] = w1;
  }
}

__device__ __forceinline__ void sgu_phase(const Params& p, char* shm, int wv) {
  constexpr int WLD = 136;
  u16* Wp = (u16*)shm; float* rsv = (float*)(shm + 128 * WLD * 2);
  int tid = opaque_tid(wv), wid = tid >> 6, lane = tid & 63, fr = lane & 15, fq = lane >> 4;
  const u16* ub = p.B0; const u16* vT = p.B1; u16* ob = p.B2; const float* rowss_v = p.vpart;
  for (int it = blockIdx.x; it < 2048; it += gridDim.x) {
    int g = it & 7, c128 = it >> 3, tok0 = c128 * 128;
    __syncthreads();
    if (tid < 128) rsv[tid] = row_rs(rowss_v, tok0 + tid);
    __syncthreads();
    _Pragma("unroll") for (int i = 0; i < 4; ++i) {
      int id = tid + i * 512, t = id >> 4, sc = id & 15;
      const float4* w4 = (const float4*)(p.sg_w_s + ((long)(g * 128 + t)) * 128 + sc * 8);
      float4 a = w4[0], b = w4[1]; float v[8] = {a.x, a.y, a.z, a.w, b.x, b.y, b.z, b.w};
      _Pragma("unroll") for (int e = 0; e < 8; ++e) { int s = sc * 8 + e; v[e] = (s <= t) ? v[e] * rsv[s] : 0.f; }
      uint2 lo = pack4(v[0], v[1], v[2], v[3]), hi = pack4(v[4], v[5], v[6], v[7]);
      uint4 o; o.x = lo.x; o.y = lo.y; o.z = hi.x; o.w = hi.y;
      *(uint4*)&Wp[t * WLD + sc * 8] = o;
    }
    bf16x8 vb[4];
    int cc = g * 128 + 16 * wid + fr;
    _Pragma("unroll") for (int ks = 0; ks < 4; ++ks) vb[ks] = *(const bf16x8*)&vT[((long)c128 * DM + cc) * 128 + ks * 32 + fq * 8];
    float gvn = p.sg_vnorm[cc];
    __syncthreads();
    _Pragma("unroll") for (int mt = 0; mt < 8; ++mt) {
      f32x4 acc = {0.f, 0.f, 0.f, 0.f};
      _Pragma("unroll") for (int ks = 0; ks <= (mt >> 1); ++ks) {
        bf16x8 a = *(const bf16x8*)&Wp[(16 * mt + fr) * WLD + ks * 32 + fq * 8];
        acc = __builtin_amdgcn_mfma_f32_16x16x32_bf16(a, vb[ks], acc, 0, 0, 0);
      }
      _Pragma("unroll") for (int j = 0; j < 4; ++j) {
        int t = 16 * mt + fq * 4 + j;
        float mixed = acc[j] * gvn + p.sg_b_s[g * 128 + t];
        long idx = (long)(tok0 + t) * DM + cc;
        ob[idx] = f2bf(bf2f(ub[idx]) * mixed);
      }
    }
  }
}

__device__ __forceinline__ void final_phase(const Params& p, int wv) {
  int tid = opaque_tid(wv); int wid = tid >> 6, lane = tid & 63;
  for (int row = blockIdx.x * 8 + wid; row < T_TOK; row += gridDim.x * 8) {
    float rs = row_rs(p.rpart, row);
    float4* o4 = (float4*)(p.out + (long)row * DM);
    const uint2* x2 = (const uint2*)(p.xb + (long)row * DM);
    _Pragma("unroll") for (int i = 0; i < 4; ++i) {
      uint2 xv = x2[i * 64 + lane]; float4 g = ((const float4*)p.norm_final)[i * 64 + lane]; float4 v;
      v.x = __uint_as_float(xv.x << 16) * rs * g.x; v.y = __uint_as_float(xv.x & 0xffff0000u) * rs * g.y;
      v.z = __uint_as_float(xv.y << 16) * rs * g.z; v.w = __uint_as_float(xv.y & 0xffff0000u) * rs * g.w;
      o4[i * 64 + lane] = v;
    }
  }
}

#define XB_TMO      128
#define XB_XCNT(j)  (256  + 64 * (j))
#define XB_XSUB(j)  (1280 + 64 * (j))
#define XB_XGEN(j)  (2304 + 64 * (j))
#define XB_TOP      3328
#define XB_TOPGEN   3392
#define XCD_BAR_WORDS 3456
#define XB_SPIN_CAP (1u << 22)
#define LAS __attribute__((address_space(3)))

__device__ __forceinline__ unsigned xb_ld(unsigned* p)              { return __hip_atomic_load(p, __ATOMIC_RELAXED, __HIP_MEMORY_SCOPE_AGENT); }
__device__ __forceinline__ unsigned xb_add(unsigned* p, unsigned v) { return __hip_atomic_fetch_add(p, v, __ATOMIC_RELAXED, __HIP_MEMORY_SCOPE_AGENT); }
__device__ __forceinline__ unsigned xb_xcc_id() { return (unsigned)__builtin_amdgcn_s_getreg((3 << 11) | 20) & 0xFu; }
#define XB_SPIN(cond, bar) do { unsigned _sp = 0; while (cond) { __builtin_amdgcn_s_sleep(1); \
    if ((++_sp & 255u) == 0u) { if (xb_ld(&(bar)[XB_TMO])) break; if (_sp > XB_SPIN_CAP) { atomicAdd(&(bar)[XB_TMO], 1u); break; } } } } while (0)

struct XcdBarrier {
    unsigned* bar; unsigned x;
    volatile LAS unsigned* st;
};

__device__ __forceinline__ XcdBarrier xcd_barrier_post(unsigned* bar, volatile LAS unsigned* st, bool t0) {
    XcdBarrier b; b.bar = bar; b.x = xb_xcc_id(); b.st = st;
    if (t0) (void)xb_add(&bar[XB_XCNT(b.x)], 1u);
    return b;
}
__device__ __forceinline__ void xcd_barrier_complete(unsigned* bar, unsigned x, unsigned& nloc, unsigned& nx) {
    const unsigned G = gridDim.x * gridDim.y * gridDim.z;
    unsigned sum, cnt, mine, sp = 0u;
    for (;;) {
        sum = 0u; cnt = 0u; mine = 0u;
#pragma unroll
        for (unsigned j = 0; j < 16; ++j) { const unsigned c = xb_ld(&bar[XB_XCNT(j)]); sum += c; cnt += (c > 0u) ? 1u : 0u; mine = (j == x) ? c : mine; }
        if (sum == G) break;
        __builtin_amdgcn_s_sleep(1);
        if ((++sp & 255u) == 0u) { if (xb_ld(&bar[XB_TMO])) break; if (sp > XB_SPIN_CAP) { atomicAdd(&bar[XB_TMO], 1u); break; } }
    }
    nloc = mine > 0u ? mine : 1u; nx = cnt > 0u ? cnt : 1u;
}

__device__ __forceinline__ void xcd_barrier(const XcdBarrier& b, bool t0) {
    asm volatile("s_waitcnt vmcnt(0)" ::: "memory");
    __syncthreads();
    if (t0) {
        unsigned* bar = b.bar;
        __builtin_amdgcn_s_waitcnt(0);
        unsigned nloc = b.st[0], nx = b.st[1];
        if (nloc == 0u) { xcd_barrier_complete(bar, b.x, nloc, nx); b.st[0] = nloc; b.st[1] = nx; }
        const unsigned old = xb_add(&bar[XB_XSUB(b.x)], 1u);
        const unsigned gen = old / nloc;
        if (old + 1u == (gen + 1u) * nloc) {
            __builtin_amdgcn_fence(__ATOMIC_RELEASE, "agent");
            asm volatile("s_waitcnt vmcnt(0)" ::: "memory");
            const unsigned og = xb_add(&bar[XB_TOP], 1u);
            const unsigned tg = og / nx;
            if (og + 1u == (tg + 1u) * nx) xb_add(&bar[XB_TOPGEN], 1u);
            else XB_SPIN(xb_ld(&bar[XB_TOPGEN]) == tg, bar);
            __builtin_amdgcn_fence(__ATOMIC_ACQUIRE, "agent");
            xb_add(&bar[XB_XGEN(b.x)], 1u);
            asm volatile("s_waitcnt vmcnt(0)" ::: "memory");
        } else {
            XB_SPIN(xb_ld(&bar[XB_XGEN(b.x)]) == gen, bar);
            __builtin_amdgcn_fence(__ATOMIC_ACQUIRE, "agent");
            asm volatile("s_waitcnt vmcnt(0)" ::: "memory");
        }
    }
    __syncthreads();
}


#define SEL4(arr, i) ((i) == 0 ? (arr)[0] : ((i) == 1 ? (arr)[1] : ((i) == 2 ? (arr)[2] : (arr)[3])))
__global__ void __launch_bounds__(512, 2) fwd_megakernel(KArgs ka_unused) {
  extern __shared__ __attribute__((aligned(16))) char shm[];
  const int wv = __builtin_amdgcn_readfirstlane((int)(threadIdx.x >> 6));
  int ph = 0;
#define BARRIER_WS ((unsigned*)(kargs_ptr()->ws + OFF_BAR))
#if MULTI_LAUNCH
#define PHASE_BEGIN if (ph >= kargs_ptr()->phase_lo && ph < kargs_ptr()->phase_hi) { const Params p = make_params(*kargs_ptr());
#define PHASE_END } ++ph;
#else
  cg::grid_group grid = cg::this_grid();
#define PHASE_BEGIN { const Params p = make_params(*kargs_ptr());
#define PHASE_END } ++ph; { XcdBarrier xb_; xb_.bar = BARRIER_WS; xb_.x = xb_xcc_id(); xb_.st = (volatile LAS unsigned*)(shm + LDS_BYTES - 16); xcd_barrier(xb_, opaque_tid(wv) == 0); }
#endif
#define LAYER_VARS \
    const float* xin = (i == 0) ? p.x : p.out; float* rs_mix = p.rpart; float* rs_cross = p.rpart; float* rs_ffn = p.rpart; float* rs_next = p.rpart; \
    const u16* w_mix_in = p.wbase + layer_woff(i); const u16* w_mix_out = w_mix_in + mixin_elems(i); const u16* w_caq = w_mix_out + 1048576L; \
    const u16* w_cao = w_caq + 3145728L; const u16* w_gu = w_cao + 1048576L; const u16* w_down = w_gu + 5767168L; \
    const u16* mix_out_A = kind == 0 ? p.B3 : (kind == 1 ? p.B0 : p.B2); \
    (void)xin; (void)rs_mix; (void)rs_cross; (void)rs_ffn; (void)rs_next; (void)w_mix_in; (void)w_mix_out; (void)w_caq; (void)w_cao; (void)w_gu; (void)w_down; (void)mix_out_A;
#if MULTI_LAUNCH
  PHASE_BEGIN prep_phase(p, kargs_ptr(), shm, wv); PHASE_END
#else
  { const Params p = make_params(*kargs_ptr()); prep_phase(p, kargs_ptr(), shm, wv); } ++ph;
  grid.sync();
  {
    volatile LAS unsigned* xb_st = (volatile LAS unsigned*)(shm + LDS_BYTES - 16);
    if (opaque_tid(wv) == 0) { xb_st[0] = 0u; xb_st[1] = 0u; }
    __syncthreads();
    (void)xcd_barrier_post(BARRIER_WS, xb_st, opaque_tid(wv) == 0);
  }
#endif
  _Pragma("nounroll") for (int i = 0; i < 4; ++i) {
    int kind = i % 3, j = i / 3;
    if (kind == 0) {
      PHASE_BEGIN LAYER_VARS
        if (i == 0) {
          for (int t = blockIdx.x; t < 128; t += gridDim.x) {
            int l = t >> 5, tt = t & 31, tr0 = (tt & 3) * BM, fc0 = (tt >> 2) * BM;
            EpiMemKV em{p.memK + (long)l * NB * MEML * DM, p.memVT + (long)l * NB * DM * MEML};
            const u16* mA = p.memn; const u16* mB = p.wbase + layer_woff(l) + mixin_elems(l) + 2097152L;
            bool sw = em.swap(fc0);
            gemm_tile(sw ? mB : mA, sw ? mA : mB, DM, sw ? fc0 : tr0, sw ? tr0 : fc0, shm, em, tr0, fc0, sw, false, false, mA, mB, 0, 0, wv);
          }
        }
        EpiDaIn e{rs_mix, p.B0, p.B1, p.B2}; gemm_phase(p.xb, w_mix_in, T_TOK, 3 * DM, DM, shm, e, wv);
      PHASE_END
      PHASE_BEGIN diff_attn_phase(p, j, i, shm, wv); PHASE_END
    } else if (kind == 1) {
      PHASE_BEGIN LAYER_VARS EpiHgIn e{rs_mix, p.lbv, p.B0, p.B1, p.B2, p.B3}; gemm_phase(p.xb, w_mix_in, T_TOK, 4 * DM, DM, shm, e, wv); PHASE_END
      PHASE_BEGIN hg1_phase(p, shm, wv); PHASE_END
      PHASE_BEGIN hg2_phase<0>(p, shm, wv); PHASE_END
      PHASE_BEGIN hg2_phase<1>(p, shm, wv); PHASE_END
      PHASE_BEGIN hg3_phase(p, wv); PHASE_END
    } else {
      PHASE_BEGIN LAYER_VARS EpiSgIn e{rs_mix, p.B0, p.B1, p.vpart}; gemm_phase(p.xb, w_mix_in, T_TOK, 2 * DM, DM, shm, e, wv); PHASE_END
      PHASE_BEGIN sgu_phase(p, shm, wv); PHASE_END
    }
    PHASE_BEGIN LAYER_VARS EpiRes e{p.xb, rs_cross}; gemm_phase(mix_out_A, w_mix_out, T_TOK, DM, DM, shm, e, wv); PHASE_END
    PHASE_BEGIN LAYER_VARS EpiStore e{rs_cross, p.B0, DM}; gemm_phase(p.xb, w_caq, T_TOK, DM, DM, shm, e, wv); PHASE_END
    PHASE_BEGIN cross_attn_phase(p, i, shm, wv); PHASE_END
    PHASE_BEGIN LAYER_VARS EpiRes e{p.xb, rs_ffn}; gemm_phase(p.B1, w_cao, T_TOK, DM, DM, shm, e, wv); PHASE_END
    PHASE_BEGIN LAYER_VARS EpiFfn e{rs_ffn, p.B0}; gemm_phase(p.xb, w_gu, T_TOK, 2 * DFF, DM, shm, e, wv); PHASE_END
    PHASE_BEGIN LAYER_VARS EpiRes e{p.xb, rs_next}; gemm_phase(p.B0, w_down, T_TOK, DM, DFF, shm, e, wv); PHASE_END
  }
#if MULTI_LAUNCH
  PHASE_BEGIN final_phase(p, wv); PHASE_END
#else
  { const Params p = make_params(*kargs_ptr()); final_phase(p, wv); }
#endif
}

extern "C" void kernel_launch(void* const* d_in, const int* in_sizes, int n_in, void* d_out, int out_size, void* d_ws, size_t ws_size,
                              hipStream_t stream) {
  static int grid_blocks = 0;
  if (!grid_blocks) {
    int dev = 0, cus = 0, per_cu = 0;
    hipGetDevice(&dev);
    hipDeviceGetAttribute(&cus, hipDeviceAttributeMultiprocessorCount, dev);
    if (hipFuncSetAttribute((const void*)fwd_megakernel, hipFuncAttributeMaxDynamicSharedMemorySize, LDS_BYTES) != hipSuccess)
      fprintf(stderr, "hipFuncSetAttribute failed\n");
    hipOccupancyMaxActiveBlocksPerMultiprocessor(&per_cu, (const void*)fwd_megakernel, 512, LDS_BYTES);
    if (per_cu < 1) { fprintf(stderr, "occupancy query returned %d\n", per_cu); per_cu = 1; }
    grid_blocks = cus * per_cu;
    (void)hipGetLastError();
  }
  KArgs p;
  memset(&p, 0, sizeof(p));
  const float* const* in = (const float* const*)d_in;
  p.x = in[0]; p.mem = in[1]; p.rel_bias = in[2];
  const float *norm_mix = in[3], *norm_cross = in[4], *norm_ffn = in[5];
  p.norm_mem = in[6]; p.norm_final = in[7];
  const float *da_w_in = in[8], *da_w_out = in[9];
  p.da_lq1 = in[10]; p.da_lk1 = in[11]; p.da_lq2 = in[12]; p.da_lk2 = in[13]; p.da_subln = in[14];
  const float *hg_w_in = in[15], *hg_w_out = in[16];
  p.hg_lb = in[17]; p.hg_onorm = in[18];
  const float *sg_w_in = in[19], *sg_w_out = in[20];
  p.sg_vnorm = in[21]; p.sg_w_s = in[22]; p.sg_b_s = in[23];
  const float *ca_w_q = in[24], *ca_w_kv = in[25], *ca_w_o = in[26], *ffn_w_gu = in[27], *ffn_w_down = in[28];
  p.out = (float*)d_out; p.ws = (char*)d_ws;
  if (WS_END > ws_size) { fprintf(stderr, "workspace too small: need %zu have %zu\n", (size_t)WS_END, ws_size); return; }
  int nwd = 0, tiles = 0;
  u16* wcur = (u16*)((char*)d_ws + OFF_W);
  auto addw = [&](const float* src, int K, int N, const float* gain, int perm) {
    WDesc& w = p.wd[nwd++]; w.src = src; w.dst = wcur; w.gain = gain; w.K = K; w.N = N; w.perm = perm; w.tile0 = tiles;
    tiles += (K / 64) * (N / 64); wcur += (size_t)K * N;
  };
  for (int i = 0; i < 4; ++i) {
    int kind = i % 3, j = i / 3;
    if (wcur != (u16*)((char*)d_ws + OFF_W) + layer_woff(i)) fprintf(stderr, "weight layout mismatch at layer %d\n", i);
    if (kind == 0) { addw(da_w_in + (size_t)j * DM * 3 * DM, DM, 3 * DM, norm_mix + i * DM, 0); addw(da_w_out + (size_t)j * DM * DM, DM, DM, nullptr, 0); }
    else if (kind == 1) { addw(hg_w_in + (size_t)j * DM * 4 * DM, DM, 4 * DM, norm_mix + i * DM, 0); addw(hg_w_out + (size_t)j * DM * DM, DM, DM, nullptr, 0); }
    else { addw(sg_w_in + (size_t)j * DM * 2 * DM, DM, 2 * DM, norm_mix + i * DM, 0); addw(sg_w_out + (size_t)j * DM * DM, DM, DM, nullptr, 0); }
    addw(ca_w_q + (size_t)i * DM * DM, DM, DM, norm_cross + i * DM, 0);
    addw(ca_w_kv + (size_t)i * DM * 2 * DM, DM, 2 * DM, nullptr, 0);
    addw(ca_w_o + (size_t)i * DM * DM, DM, DM, nullptr, 0);
    addw(ffn_w_gu + (size_t)i * DM * 2 * DFF, DM, 2 * DFF, norm_ffn + i * DM, 1);
    addw(ffn_w_down + (size_t)i * DFF * DM, DFF, DM, nullptr, 0);
  }
  p.nwd = nwd; p.total_wtiles = tiles;
#if MULTI_LAUNCH
  _Pragma("unroll") for (int ph = 0; ph < 64; ++ph) {
    p.phase_lo = ph; p.phase_hi = ph + 1;
    hipLaunchKernelGGL(fwd_megakernel, dim3(grid_blocks), dim3(512), LDS_BYTES, stream, p);
  }
#else
  p.phase_lo = 0; p.phase_hi = 1 << 30;
  void* args[] = {&p};
  hipError_t e = hipLaunchCooperativeKernel((void*)fwd_megakernel, dim3(grid_blocks), dim3(512), args, LDS_BYTES, stream);
  if (e != hipSuccess) fprintf(stderr, "cooperative launch failed: %s (grid %d)\n", hipGetErrorString(e), grid_blocks);
#endif
}
```

```cpp
#include <hip/hip_runtime.h>
#include <hip/hip_cooperative_groups.h>
#include <cstdio>
#include <cmath>
#include <cstring>
namespace cg = cooperative_groups;

typedef unsigned short u16;
using bf16x8 = __attribute__((ext_vector_type(8))) short;
using bf16x4 = __attribute__((ext_vector_type(4))) short;
using f32x4 = __attribute__((ext_vector_type(4))) float;
using u32x4 = __attribute__((ext_vector_type(4))) unsigned;

#ifndef MULTI_LAUNCH
#define MULTI_LAUNCH 0
#endif

constexpr int T_TOK = 32768, DM = 1024, SEQ = 8192, NB = 4, DFF = 2816, MEML = 256;
constexpr float EPS = 1e-6f;
constexpr int LDS_BYTES = 147456;
constexpr float LOG2E = 1.4426950408889634f;

typedef __attribute__((ext_vector_type(2))) float f32x2;
typedef __attribute__((ext_vector_type(2))) __bf16 bf16x2_t;
__device__ __forceinline__ unsigned pk2(float a, float b) { f32x2 v = {a, b}; bf16x2_t r = __builtin_convertvector(v, bf16x2_t); return *(unsigned*)&r; }
__device__ __forceinline__ u16 f2bf(float f) { return (u16)(pk2(f, 0.f) & 0xffffu); }
__device__ __forceinline__ float bf2f(u16 h) { return __uint_as_float(((unsigned)h) << 16); }
__device__ __forceinline__ float sigmoid_f(float x) { return __builtin_amdgcn_rcpf(1.f + __builtin_amdgcn_exp2f(-x * LOG2E)); }
__device__ __forceinline__ float silu_f(float x) { return x * sigmoid_f(x); }

__device__ __forceinline__ int opaque_tid(int wv) { unsigned ones = ~0u; asm volatile("" : "+s"(ones)); int lane = __builtin_amdgcn_mbcnt_hi(ones, __builtin_amdgcn_mbcnt_lo(ones, 0u)); int t = (wv << 6) | lane; asm volatile("" : "+v"(t)); return t; }

template <int M> __device__ __forceinline__ float sx(float v, int lane) {
  if (M < 32) return __int_as_float(__builtin_amdgcn_ds_swizzle(__float_as_int(v), (M << 10) | 0x1f));
  else return __int_as_float(__builtin_amdgcn_ds_bpermute((lane ^ M) << 2, __float_as_int(v)));
}
__device__ __forceinline__ float wave_sum(float v, int lane) {
  v += sx<1>(v, lane); v += sx<2>(v, lane); v += sx<4>(v, lane); v += sx<8>(v, lane); v += sx<16>(v, lane); v += sx<32>(v, lane); return v;
}

struct WDesc { const float* src; u16* dst; const float* gain; int K; int N; int perm; int tile0; };

struct KArgs {
  const float *x, *mem, *rel_bias, *norm_mem, *norm_final;
  const float *da_lq1, *da_lk1, *da_lq2, *da_lk2, *da_subln;
  const float *hg_lb, *hg_onorm;
  const float *sg_vnorm, *sg_w_s, *sg_b_s;
  float* out; char* ws;
  WDesc wd[28];
  int nwd; int total_wtiles;
  int phase_lo, phase_hi;
};

constexpr size_t MIB = 1u << 20;
constexpr size_t OFF_XB = 0, OFF_RPART = OFF_XB + 64 * MIB, OFF_VPART = OFF_RPART + 2 * MIB, OFF_MEMN = OFF_VPART + 2 * MIB,
                 OFF_MEMK = OFF_MEMN + 2 * MIB, OFF_MEMVT = OFF_MEMK + 8 * MIB, OFF_LBV = OFF_MEMVT + 8 * MIB, OFF_BIAS = OFF_LBV + 4096,
                 OFF_B0 = OFF_BIAS + 4096, OFF_B1 = OFF_B0 + 64 * MIB, OFF_B2 = OFF_B1 + 64 * MIB, OFF_B3 = OFF_B2 + 64 * MIB,
                 OFF_B4 = OFF_B3 + 64 * MIB, OFF_DBUF = OFF_B4 + 32 * MIB, OFF_W = OFF_DBUF + 2 * MIB, OFF_BAR = OFF_W + 130 * MIB, WS_END = OFF_BAR + 16384;
__host__ __device__ __forceinline__ long layer_woff(int i) { return i == 0 ? 0L : (i == 1 ? 17039360L : (i == 2 ? 35127296L : 51118080L)); }
__host__ __device__ __forceinline__ long mixin_elems(int i) { int kind = i % 3; return kind == 0 ? 3145728L : (kind == 1 ? 4194304L : 2097152L); }

struct Params {
  const float *x, *mem, *rel_bias, *norm_mem, *norm_final;
  const float *da_lq1, *da_lk1, *da_lq2, *da_lk2, *da_subln;
  const float *hg_lb, *hg_onorm;
  const float *sg_vnorm, *sg_w_s, *sg_b_s;
  float* out;
  u16* xb; float* rpart; float* vpart; u16* memn; u16* memK; u16* memVT; float* lbv; float* biastab;
  u16 *B0, *B1, *B2, *B3, *B4; float* dbuf; u16* wbase;
};
typedef const KArgs __attribute__((address_space(4)))* KArgsP;
__device__ __forceinline__ KArgsP kargs_ptr() {
  KArgsP kp = (KArgsP)__builtin_amdgcn_kernarg_segment_ptr();
  asm volatile("" : "+s"(kp));
  return kp;
}
template <class KA>
__device__ __forceinline__ Params make_params(const KA& k) {
  Params p;
  p.x = k.x; p.mem = k.mem; p.rel_bias = k.rel_bias; p.norm_mem = k.norm_mem; p.norm_final = k.norm_final;
  p.da_lq1 = k.da_lq1; p.da_lk1 = k.da_lk1; p.da_lq2 = k.da_lq2; p.da_lk2 = k.da_lk2; p.da_subln = k.da_subln;
  p.hg_lb = k.hg_lb; p.hg_onorm = k.hg_onorm; p.sg_vnorm = k.sg_vnorm; p.sg_w_s = k.sg_w_s; p.sg_b_s = k.sg_b_s; p.out = k.out;
  char* ws = k.ws;
  p.xb = (u16*)(ws + OFF_XB); p.rpart = (float*)(ws + OFF_RPART); p.vpart = (float*)(ws + OFF_VPART); p.memn = (u16*)(ws + OFF_MEMN);
  p.memK = (u16*)(ws + OFF_MEMK); p.memVT = (u16*)(ws + OFF_MEMVT); p.lbv = (float*)(ws + OFF_LBV); p.biastab = (float*)(ws + OFF_BIAS);
  p.B0 = (u16*)(ws + OFF_B0); p.B1 = (u16*)(ws + OFF_B1); p.B2 = (u16*)(ws + OFF_B2); p.B3 = (u16*)(ws + OFF_B3); p.B4 = (u16*)(ws + OFF_B4);
  p.dbuf = (float*)(ws + OFF_DBUF); p.wbase = (u16*)(ws + OFF_W);
  return p;
}


constexpr int BM = 256, BK = 64, HALF = 128, HT = HALF * BK;

__device__ __forceinline__ int lds_byte(int r, int c) {
  int st = (r >> 4) * 2 + (c >> 5), rr = r & 15, cc = c & 31, ob = rr * 64 + cc * 2;
  return st * 1024 + (ob ^ (((ob >> 9) & 1) << 5));
}
__device__ __forceinline__ void stage_rc(int b, int& R, int& C) {
  int st = b / 1024, sb = b % 1024, swz = sb ^ (((sb >> 9) & 1) << 5);
  R = (st >> 1) * 16 + swz / 64; C = (st & 1) * 32 + (swz % 64) / 2;
}

template <class Epi>
__device__ __forceinline__ void gemm_tile(const u16* __restrict__ A, const u16* __restrict__ Bt, int K, int brow, int bcol,
                                          char* shmc, Epi& epi, int tr0, int fc0, bool sw, bool pre, bool has_next,
                                          const u16* __restrict__ nA, const u16* __restrict__ nBt, int nbrow, int nbcol, int wv) {
  u16* shm = (u16*)shmc;
  const int tx = opaque_tid(wv);
#define SA(b, h) (shm + ((b) * 2 + (h)) * HT)
#define SB(b, h) (shm + (4 + (b) * 2 + (h)) * HT)
#define STAGE(P, BASE, br, kt) do { int _so = ((br) * K + (kt) * BK) * 2; \
    __builtin_amdgcn_raw_ptr_buffer_load_lds(rs_##BASE, (__attribute__((address_space(3))) void*)((char*)(P) + tx * 16), 16, voff0, _so, 0, 0); \
    __builtin_amdgcn_raw_ptr_buffer_load_lds(rs_##BASE, (__attribute__((address_space(3))) void*)((char*)(P) + tx * 16 + 8192), 16, voff1, _so, 0, 0); } while (0)
#define LDA(dst, b, h) _Pragma("unroll") for (int m = 0; m < 4; ++m) _Pragma("unroll") for (int k = 0; k < 2; ++k) \
    dst[m][k] = *reinterpret_cast<const bf16x8*>((char*)SA(b, h) + lds_byte(wr * 64 + m * 16 + fr, k * 32 + fq * 8))
#define LDB(dst, b, h) _Pragma("unroll") for (int n = 0; n < 2; ++n) _Pragma("unroll") for (int k = 0; k < 2; ++k) \
    dst[n][k] = *reinterpret_cast<const bf16x8*>((char*)SB(b, h) + lds_byte(wc * 32 + n * 16 + fr, k * 32 + fq * 8))
#define MMA(ai, bj, At, Bt_) do { __builtin_amdgcn_s_setprio(1); \
    _Pragma("unroll") for (int m = 0; m < 4; ++m) _Pragma("unroll") for (int n = 0; n < 2; ++n) _Pragma("unroll") for (int k = 0; k < 2; ++k) \
      acc[ai][bj][m][n] = __builtin_amdgcn_mfma_f32_16x16x32_bf16(At[m][k], Bt_[n][k], acc[ai][bj][m][n], 0, 0, 0); \
    __builtin_amdgcn_s_setprio(0); } while (0)
#define WAIT_V(n) asm volatile("s_waitcnt vmcnt(" #n ")" ::: "memory")
#define WAIT_L(n) asm volatile("s_waitcnt lgkmcnt(" #n ")" ::: "memory")
#define BAR __builtin_amdgcn_s_barrier()
#define SCHED __builtin_amdgcn_sched_barrier(0)

  int wid = tx >> 6, lane = tx & 63, wr = wid >> 2, wc = wid & 3, fr = lane & 15, fq = lane >> 4;
  f32x4 acc[2][2][4][2] = {};
  bf16x8 At[4][2], B0[2][2], B1[2][2];
  int nt = K / BK;
  int voff0, voff1;
  { int _r, _c; stage_rc(tx * 16, _r, _c); voff0 = (_r * K + _c) * 2; stage_rc(tx * 16 + 8192, _r, _c); voff1 = (_r * K + _c) * 2; }
  __amdgpu_buffer_rsrc_t rs_A = __builtin_amdgcn_make_buffer_rsrc((void*)A, 0, 0x7fffffff, 0x00020000);
  __amdgpu_buffer_rsrc_t rs_Bt = __builtin_amdgcn_make_buffer_rsrc((void*)Bt, 0, 0x7fffffff, 0x00020000);
  if (!pre) {
    STAGE(SB(0, 0), Bt, bcol, 0); STAGE(SA(0, 0), A, brow, 0);
    STAGE(SB(0, 1), Bt, bcol + HALF, 0); STAGE(SA(0, 1), A, brow + HALF, 0);
  }
  if (wr == 1) BAR;
  if (pre) { WAIT_V(0); } else { WAIT_V(4); }
  BAR;
  STAGE(SB(1, 0), Bt, bcol, 1); STAGE(SA(1, 0), A, brow, 1); STAGE(SB(1, 1), Bt, bcol + HALF, 1);
  WAIT_V(6); BAR;
  for (int t = 0; t < nt - 2; t += 2) {
    LDB(B0, 0, 0); SCHED; LDA(At, 0, 0); STAGE(SA(1, 1), A, brow + HALF, t + 1);
    WAIT_L(8); BAR; WAIT_L(0); MMA(0, 0, At, B0); BAR; SCHED;
    LDB(B1, 0, 1); STAGE(SB(0, 0), Bt, bcol, t + 2);
    BAR; WAIT_L(0); MMA(0, 1, At, B1); BAR;
    LDA(At, 0, 1); STAGE(SA(0, 0), A, brow, t + 2);
    BAR; WAIT_L(0); MMA(1, 0, At, B0); BAR; SCHED;
    STAGE(SB(0, 1), Bt, bcol + HALF, t + 2);
    WAIT_V(6); BAR; MMA(1, 1, At, B1); BAR;
    LDB(B0, 1, 0); SCHED; LDA(At, 1, 0); STAGE(SA(0, 1), A, brow + HALF, t + 2);
    WAIT_L(8); BAR; WAIT_L(0); MMA(0, 0, At, B0); BAR; SCHED;
    LDB(B1, 1, 1); STAGE(SB(1, 0), Bt, bcol, t + 3);
    BAR; WAIT_L(0); MMA(0, 1, At, B1); BAR;
    LDA(At, 1, 1); STAGE(SA(1, 0), A, brow, t + 3);
    BAR; WAIT_L(0); MMA(1, 0, At, B0); BAR; SCHED;
    STAGE(SB(1, 1), Bt, bcol + HALF, t + 3);
    WAIT_V(6); BAR; MMA(1, 1, At, B1); BAR;
  }
  { LDB(B0, 0, 0); LDA(At, 0, 0); STAGE(SA(1, 1), A, brow + HALF, nt - 1);
    BAR; WAIT_L(0); MMA(0, 0, At, B0); BAR;
    LDB(B1, 0, 1); BAR; WAIT_L(0); MMA(0, 1, At, B1); BAR;
    LDA(At, 0, 1); WAIT_V(4); BAR; WAIT_L(0); MMA(1, 0, At, B0); MMA(1, 1, At, B1); BAR; }
  { LDB(B0, 1, 0); LDA(At, 1, 0); WAIT_V(2); BAR; WAIT_L(0); MMA(0, 0, At, B0); BAR;
    LDB(B1, 1, 1); WAIT_V(0); BAR; WAIT_L(0); MMA(0, 1, At, B1); BAR;
    LDA(At, 1, 1); BAR; WAIT_L(0); MMA(1, 0, At, B0); MMA(1, 1, At, B1); BAR; }
  if (wr == 0) BAR;
  if (has_next) {
    __amdgpu_buffer_rsrc_t rs_nA = __builtin_amdgcn_make_buffer_rsrc((void*)nA, 0, 0x7fffffff, 0x00020000);
    __amdgpu_buffer_rsrc_t rs_nBt = __builtin_amdgcn_make_buffer_rsrc((void*)nBt, 0, 0x7fffffff, 0x00020000);
    STAGE(SB(0, 0), nBt, nbcol, 0); STAGE(SA(0, 0), nA, nbrow, 0);
    STAGE(SB(0, 1), nBt, nbcol + HALF, 0); STAGE(SA(0, 1), nA, nbrow + HALF, 0);
  }
  {
    const int tx2 = opaque_tid(wv); const int wid2 = tx2 >> 6, lane2 = tx2 & 63;
    epi(acc, tr0, fc0, sw, wid2 >> 2, wid2 & 3, lane2 & 15, lane2 >> 4);
  }
  __syncthreads();
#undef SA
#undef SB
#undef STAGE
#undef LDA
#undef LDB
#undef MMA
}

template <class Epi>
__device__ __forceinline__ void gemm_phase(const u16* A, const u16* Bt, int M, int N, int K, char* shm, Epi& epi, int wv) {
  int nM = M / BM, nN = N / BM;
  int G = gridDim.x, bid = blockIdx.x;
  bool xmap = ((G & 7) == 0 && (nM & 63) == 0);
  int xcd = bid & 7, slot = bid >> 3, nslots = G >> 3, gpx = nM / 64;
  int first = xmap ? slot : bid, step = xmap ? nslots : G, total = xmap ? gpx * 8 * nN : nM * nN;
  auto coords = [&](int L, int& tr0, int& fc0) {
    if (xmap) { int grp = xcd * gpx + L / (8 * nN), within = L % (8 * nN); tr0 = (grp * 8 + (within & 7)) * BM; fc0 = (within >> 3) * BM; }
    else { tr0 = (L % nM) * BM; fc0 = (L / nM) * BM; }
  };
  bool pre = false;
  for (int L = first; L < total; L += step) {
    int tr0, fc0, ntr0 = 0, nfc0 = 0;
    coords(L, tr0, fc0);
    bool hn = (L + step) < total;
    if (hn) coords(L + step, ntr0, nfc0);
    bool sw = epi.swap(fc0), nsw = epi.swap(nfc0);
    gemm_tile(sw ? Bt : A, sw ? A : Bt, K, sw ? fc0 : tr0, sw ? tr0 : fc0, shm, epi, tr0, fc0, sw, pre, hn,
              nsw ? Bt : A, nsw ? A : Bt, nsw ? nfc0 : ntr0, nsw ? ntr0 : nfc0, wv);
    pre = hn;
  }
}

__device__ __forceinline__ float row_rs(const float* part, int row) {
  const float4* q = (const float4*)(part + (long)row * 16);
  float4 a = q[0], b = q[1], c = q[2], d = q[3];
  float s = ((a.x + a.y) + (a.z + a.w)) + ((b.x + b.y) + (b.z + b.w)) + ((c.x + c.y) + (c.z + c.w)) + ((d.x + d.y) + (d.z + d.w));
  return rsqrtf(s * (1.f / DM) + EPS);
}
#define EPI_ARGS f32x4 (&acc)[2][2][4][2], int tr0, int fc0, bool sw, int wr, int wc, int fr, int fq
#define S_FEAT(ai, m) (fc0 + (ai) * 128 + wr * 64 + (m) * 16 + fq * 4)
#define S_TOK(bj, n) (tr0 + (bj) * 128 + wc * 32 + (n) * 16 + fr)
#define U_TOK(ai, m) (tr0 + (ai) * 128 + wr * 64 + (m) * 16 + fq * 4)
#define U_FEAT(bj, n) (fc0 + (bj) * 128 + wc * 32 + (n) * 16 + fr)

__device__ __forceinline__ uint2 pack4(float a, float b, float c, float d) { uint2 r; r.x = pk2(a, b); r.y = pk2(c, d); return r; }

struct EpiRes {
  u16* xb; float* part;
  __device__ __forceinline__ bool swap(int) const { return true; }
  __device__ __forceinline__ void operator()(EPI_ARGS) {
    _Pragma("unroll") for (int bj = 0; bj < 2; ++bj) _Pragma("unroll") for (int n = 0; n < 2; ++n) {
      int t = S_TOK(bj, n); float ss = 0.f;
      u16* xbp = xb + (long)t * DM;
      _Pragma("unroll") for (int ai = 0; ai < 2; ++ai) _Pragma("unroll") for (int m = 0; m < 4; ++m) {
        int f = S_FEAT(ai, m); f32x4 a = acc[ai][bj][m][n];
        uint2 xv = *(const uint2*)(xbp + f);
        float v0 = __uint_as_float(xv.x << 16) + a[0], v1 = __uint_as_float(xv.x & 0xffff0000u) + a[1];
        float v2 = __uint_as_float(xv.y << 16) + a[2], v3 = __uint_as_float(xv.y & 0xffff0000u) + a[3];
        *(uint2*)(xbp + f) = pack4(v0, v1, v2, v3);
        ss += v0 * v0 + v1 * v1 + v2 * v2 + v3 * v3;
      }
      ss += sx<16>(ss, fq * 16 + fr); ss += sx<32>(ss, fq * 16 + fr);
      if (fq == 0) part[(long)t * 16 + (fc0 >> 8) * 4 + wr] = ss;
      __builtin_amdgcn_sched_barrier(0);
    }
  }
};

struct EpiDaIn {
  const float* rowss; u16 *q, *k, *vT;
  __device__ __forceinline__ bool swap(int fc0) const { return (fc0 >> 10) < 2; }
  __device__ __forceinline__ void operator()(EPI_ARGS) {
    int sect = fc0 >> 10, cb = fc0 & 1023;
    if (sw) {
      u16* dst = sect ? k : q;
      _Pragma("unroll") for (int bj = 0; bj < 2; ++bj) _Pragma("unroll") for (int n = 0; n < 2; ++n) {
        int t = S_TOK(bj, n); float rs = row_rs(rowss, t); u16* d = dst + (long)t * DM + (cb - fc0);
        _Pragma("unroll") for (int ai = 0; ai < 2; ++ai) _Pragma("unroll") for (int m = 0; m < 4; ++m) {
          f32x4 a = acc[ai][bj][m][n]; *(uint2*)(d + S_FEAT(ai, m)) = pack4(a[0] * rs, a[1] * rs, a[2] * rs, a[3] * rs);
        }
      }
    } else {
      _Pragma("unroll") for (int ai = 0; ai < 2; ++ai) _Pragma("unroll") for (int m = 0; m < 4; ++m) {
        int r0 = U_TOK(ai, m); float rs[4];
        _Pragma("unroll") for (int j = 0; j < 4; ++j) rs[j] = row_rs(rowss, r0 + j);
        int b = r0 / SEQ, s0 = r0 % SEQ;
        _Pragma("unroll") for (int bj = 0; bj < 2; ++bj) _Pragma("unroll") for (int n = 0; n < 2; ++n) {
          int c = U_FEAT(bj, n) - fc0 + cb; f32x4 a = acc[ai][bj][m][n];
          *(uint2*)&vT[((long)(b * DM + c)) * SEQ + s0] = pack4(a[0] * rs[0], a[1] * rs[1], a[2] * rs[2], a[3] * rs[3]);
        }
        __builtin_amdgcn_sched_barrier(0);
      }
    }
  }
};

struct EpiHgIn {
  const float* rowss; const float* lbv; u16 *q, *logf_, *iT, *g;
  __device__ __forceinline__ bool swap(int fc0) const { return (fc0 >> 10) != 2; }
  __device__ __forceinline__ void operator()(EPI_ARGS) {
    int sect = fc0 >> 10, cb = fc0 & 1023;
    if (sw) {
      u16* dst = q + (long)sect * (32L << 20);
      _Pragma("unroll") for (int bj = 0; bj < 2; ++bj) _Pragma("unroll") for (int n = 0; n < 2; ++n) {
        int t = S_TOK(bj, n); float rs = row_rs(rowss, t); u16* d = dst + (long)t * DM + (cb - fc0);
        _Pragma("unroll") for (int ai = 0; ai < 2; ++ai) _Pragma("unroll") for (int m = 0; m < 4; ++m) {
          int f = S_FEAT(ai, m); f32x4 a = acc[ai][bj][m][n]; float v[4];
          if (sect == 0) { _Pragma("unroll") for (int j = 0; j < 4; ++j) v[j] = silu_f(a[j] * rs); }
          else if (sect == 1) {
            float4 lb = *(const float4*)&lbv[f - fc0 + cb]; float lbs[4] = {lb.x, lb.y, lb.z, lb.w};
            _Pragma("unroll") for (int j = 0; j < 4; ++j) v[j] = __logf(lbs[j] + (1.f - lbs[j]) * sigmoid_f(a[j] * rs));
          } else { _Pragma("unroll") for (int j = 0; j < 4; ++j) v[j] = a[j] * rs; }
          *(uint2*)(d + f) = pack4(v[0], v[1], v[2], v[3]);
        }
      }
    } else {
      _Pragma("unroll") for (int ai = 0; ai < 2; ++ai) _Pragma("unroll") for (int m = 0; m < 4; ++m) {
        int r0 = U_TOK(ai, m); float rs[4];
        _Pragma("unroll") for (int j = 0; j < 4; ++j) rs[j] = row_rs(rowss, r0 + j);
        _Pragma("unroll") for (int bj = 0; bj < 2; ++bj) _Pragma("unroll") for (int n = 0; n < 2; ++n) {
          int c = U_FEAT(bj, n) - fc0 + cb; f32x4 a = acc[ai][bj][m][n];
          *(uint2*)&iT[((long)(r0 >> 6) * DM + c) * 64 + (r0 & 63)] = pack4(a[0] * rs[0], a[1] * rs[1], a[2] * rs[2], a[3] * rs[3]);
        }
        __builtin_amdgcn_sched_barrier(0);
      }
    }
  }
};

__device__ __forceinline__ float gelu_f(float x) { return 0.5f * x * (1.f + erff(x * 0.70710678118654752f)); }

struct EpiSgIn {
  const float* rowss; u16 *u, *vT; float* rowss_v;
  __device__ __forceinline__ bool swap(int fc0) const { return (fc0 >> 10) == 0; }
  __device__ __forceinline__ void operator()(EPI_ARGS) {
    int cb = fc0 & 1023;
    if (sw) {
      _Pragma("unroll") for (int bj = 0; bj < 2; ++bj) _Pragma("unroll") for (int n = 0; n < 2; ++n) {
        int t = S_TOK(bj, n); float rs = row_rs(rowss, t); u16* d = u + (long)t * DM;
        _Pragma("unroll") for (int ai = 0; ai < 2; ++ai) _Pragma("unroll") for (int m = 0; m < 4; ++m) {
          f32x4 a = acc[ai][bj][m][n];
          *(uint2*)(d + S_FEAT(ai, m)) = pack4(gelu_f(a[0] * rs), gelu_f(a[1] * rs), gelu_f(a[2] * rs), gelu_f(a[3] * rs));
        }
      }
    } else {
      _Pragma("unroll") for (int ai = 0; ai < 2; ++ai) _Pragma("unroll") for (int m = 0; m < 4; ++m) {
        int r0 = U_TOK(ai, m); float rs[4], ss[4] = {0.f, 0.f, 0.f, 0.f};
        _Pragma("unroll") for (int j = 0; j < 4; ++j) rs[j] = row_rs(rowss, r0 + j);
        _Pragma("unroll") for (int bj = 0; bj < 2; ++bj) _Pragma("unroll") for (int n = 0; n < 2; ++n) {
          int c = U_FEAT(bj, n) - fc0 + cb; f32x4 a = acc[ai][bj][m][n];
          float gv[4]; _Pragma("unroll") for (int j = 0; j < 4; ++j) gv[j] = gelu_f(a[j] * rs[j]);
          *(uint2*)&vT[((long)(r0 >> 7) * DM + c) * 128 + (r0 & 127)] = pack4(gv[0], gv[1], gv[2], gv[3]);
          _Pragma("unroll") for (int j = 0; j < 4; ++j) ss[j] += gv[j] * gv[j];
        }
        _Pragma("unroll") for (int j = 0; j < 4; ++j) {
          float s = ss[j]; s += sx<1>(s, 0); s += sx<2>(s, 0); s += sx<4>(s, 0); s += sx<8>(s, 0);
          if (fr == 0) rowss_v[(long)(r0 + j) * 16 + (cb >> 8) * 4 + wc] = s;
        }
        __builtin_amdgcn_sched_barrier(0);
      }
    }
  }
};

struct EpiStore {
  const float* rowss; u16* dst; int ld;
  __device__ __forceinline__ bool swap(int) const { return true; }
  __device__ __forceinline__ void operator()(EPI_ARGS) {
    _Pragma("unroll") for (int bj = 0; bj < 2; ++bj) _Pragma("unroll") for (int n = 0; n < 2; ++n) {
      int t = S_TOK(bj, n); float rs = rowss ? row_rs(rowss, t) : 1.f; u16* d = dst + (long)t * ld;
      _Pragma("unroll") for (int ai = 0; ai < 2; ++ai) _Pragma("unroll") for (int m = 0; m < 4; ++m) {
        f32x4 a = acc[ai][bj][m][n]; *(uint2*)(d + S_FEAT(ai, m)) = pack4(a[0] * rs, a[1] * rs, a[2] * rs, a[3] * rs);
      }
    }
  }
};

struct EpiFfn {
  const float* rowss; u16* act;
  __device__ __forceinline__ bool swap(int) const { return true; }
  __device__ __forceinline__ void operator()(EPI_ARGS) {
    int tile = fc0 >> 8;
    _Pragma("unroll") for (int bj = 0; bj < 2; ++bj) _Pragma("unroll") for (int n = 0; n < 2; ++n) {
      int t = S_TOK(bj, n); float rs = row_rs(rowss, t); u16* d = act + (long)t * DFF + tile * 128 + wr * 64 + fq * 4;
      _Pragma("unroll") for (int m = 0; m < 4; ++m) {
        f32x4 g = acc[0][bj][m][n], u = acc[1][bj][m][n]; float v[4];
        _Pragma("unroll") for (int j = 0; j < 4; ++j) v[j] = silu_f(g[j] * rs) * (u[j] * rs);
        *(uint2*)(d + m * 16) = pack4(v[0], v[1], v[2], v[3]);
      }
    }
  }
};

struct EpiMemKV {
  u16 *K, *VT;
  __device__ __forceinline__ bool swap(int fc0) const { return (fc0 >> 10) == 0; }
  __device__ __forceinline__ void operator()(EPI_ARGS) {
    int cb = fc0 & 1023;
    if (sw) {
      _Pragma("unroll") for (int bj = 0; bj < 2; ++bj) _Pragma("unroll") for (int n = 0; n < 2; ++n) {
        int t = S_TOK(bj, n); u16* d = K + (long)t * DM;
        _Pragma("unroll") for (int ai = 0; ai < 2; ++ai) _Pragma("unroll") for (int m = 0; m < 4; ++m) {
          f32x4 a = acc[ai][bj][m][n]; *(uint2*)(d + S_FEAT(ai, m)) = pack4(a[0], a[1], a[2], a[3]);
        }
      }
    } else {
      _Pragma("unroll") for (int ai = 0; ai < 2; ++ai) _Pragma("unroll") for (int m = 0; m < 4; ++m) {
        int r0 = U_TOK(ai, m);
        _Pragma("unroll") for (int bj = 0; bj < 2; ++bj) _Pragma("unroll") for (int n = 0; n < 2; ++n) {
          int c = U_FEAT(bj, n) - fc0 + cb; f32x4 a = acc[ai][bj][m][n];
          *(uint2*)&VT[((long)((r0 >> 8) * DM + c)) * MEML + (r0 & 255)] = pack4(a[0], a[1], a[2], a[3]);
        }
      }
    }
  }
};

__device__ __forceinline__ void prep_phase(const Params& p, KArgsP kap, char* shm, int wv) {
  int tid = opaque_tid(wv), bid = blockIdx.x, G = gridDim.x;
  int lane = tid & 63, wid = tid >> 6;
  for (int row = bid * 8 + wid; row < T_TOK; row += G * 8) {
    const float4* src = (const float4*)(p.x + (long)row * DM);
    float ss = 0.f;
    _Pragma("unroll") for (int i = 0; i < 4; ++i) {
      float4 v = src[i * 64 + lane];
      ss += v.x * v.x + v.y * v.y + v.z * v.z + v.w * v.w;
      *(uint2*)&p.xb[(long)row * DM + (i * 64 + lane) * 4] = pack4(v.x, v.y, v.z, v.w);
    }
    ss = wave_sum(ss, lane);
    if (lane < 16) p.rpart[(long)row * 16 + lane] = (lane == 0) ? ss : 0.f;
  }
  for (int row = bid * 8 + wid; row < NB * MEML; row += G * 8) {
    const float4* src = (const float4*)(p.mem + (long)row * DM);
    float4 v[4]; float ss = 0.f;
    _Pragma("unroll") for (int i = 0; i < 4; ++i) { v[i] = src[i * 64 + lane]; ss += v[i].x * v[i].x + v[i].y * v[i].y + v[i].z * v[i].z + v[i].w * v[i].w; }
    ss = wave_sum(ss, lane);
    float rs = rsqrtf(ss * (1.f / DM) + EPS);
    _Pragma("unroll") for (int i = 0; i < 4; ++i) {
      float4 g = ((const float4*)p.norm_mem)[i * 64 + lane];
      *(uint2*)&p.memn[(long)row * DM + (i * 64 + lane) * 4] = pack4(v[i].x * rs * g.x, v[i].y * rs * g.y, v[i].z * rs * g.z, v[i].w * rs * g.w);
    }
  }
  if (bid == 0) {
    for (int i = tid; i < 3456; i += 512) ((unsigned*)((char*)p.xb - OFF_XB + OFF_BAR))[i] = 0u;
    for (int c = tid; c < DM; c += 512) {
      float v0 = p.hg_lb[c], v1 = p.hg_lb[DM + c], v2 = p.hg_lb[2 * DM + c], v3 = p.hg_lb[3 * DM + c];
      float mx = fmaxf(fmaxf(v0, v1), fmaxf(v2, v3));
      float e0 = expf(v0 - mx), e1 = expf(v1 - mx), e2 = expf(v2 - mx), e3 = expf(v3 - mx);
      p.lbv[c] = e1 / (e0 + e1 + e2 + e3);
    }
    for (int i = tid; i < 8 * 128; i += 512) {
      int h = i >> 7, n = i & 127, bucket;
      if (n < 16) bucket = n;
      else { float nf = (float)n; int lg = 16 + (int)(logf(nf / 16.f) / 2.0794415416798357f * 16.f); bucket = lg < 31 ? lg : 31; }
      p.biastab[i] = p.rel_bias[h * 32 + bucket] * LOG2E;
    }
  }
  float* tl = (float*)shm;
  for (int t = bid; t < kap->total_wtiles; t += G) {
    int wi = 0;
    while (wi + 1 < kap->nwd && kap->wd[wi + 1].tile0 <= t) ++wi;
    const float* src = kap->wd[wi].src; u16* dst = kap->wd[wi].dst; const float* gain = kap->wd[wi].gain;
    int K = kap->wd[wi].K, N = kap->wd[wi].N, perm = kap->wd[wi].perm;
    int lt = t - kap->wd[wi].tile0, nNt = N >> 6;
    int k0 = (lt / nNt) * 64, n0 = (lt % nNt) * 64;
    {
      int kk = tid >> 3, seg = (tid & 7) * 8;
      const float4* s4 = (const float4*)(src + (long)(k0 + kk) * N + n0 + seg);
      float4 a = s4[0], b = s4[1]; float g = gain ? gain[k0 + kk] : 1.f;
      float* d = tl + kk * 65 + seg;
      d[0] = a.x * g; d[1] = a.y * g; d[2] = a.z * g; d[3] = a.w * g; d[4] = b.x * g; d[5] = b.y * g; d[6] = b.z * g; d[7] = b.w * g;
    }
    __syncthreads();
    {
      int nn = tid >> 3, seg = (tid & 7) * 8;
      int n = n0 + nn, drow = n;
      if (perm) { int part = n / DFF, idx = n % DFF; drow = (idx >> 7) * 256 + part * 128 + (idx & 127); }
      float v[8]; _Pragma("unroll") for (int i = 0; i < 8; ++i) v[i] = tl[(seg + i) * 65 + nn];
      uint4 o; uint2 lo = pack4(v[0], v[1], v[2], v[3]), hi = pack4(v[4], v[5], v[6], v[7]);
      o.x = lo.x; o.y = lo.y; o.z = hi.x; o.w = hi.y;
      *(uint4*)&dst[(long)drow * K + k0 + seg] = o;
    }
    __syncthreads();
  }
}

template <int NC, int DQK, int DV, bool CAUSAL, bool PF>
__device__ __forceinline__ void flash_item(const u16* __restrict__ Qg, int q_stride, const u16* __restrict__ Kg, int k_stride,
                                           const u16* __restrict__ VTg, int vt_stride, int nkt, int q0, float scale_log2,
                                           const float* btab, float lam, const float* subln_g, float outscale,
                                           u16* __restrict__ Og, int o_stride, char* shm, int wv) {
  constexpr int KW = NC * DQK, KLD = KW + 8, VLD = 72;
  constexpr int KBUF = 64 * KLD, VBUF = DV * VLD;
  constexpr int KCH = KW / 8, KPT = 64 * KCH / 512, VPT = DV * 8 / 512;
  constexpr int NKS = DQK / 32, NVT = DV / 16;
  u16* Ks = (u16*)shm; u16* Vs = Ks + 2 * KBUF;
  int tid = opaque_tid(wv), wid = tid >> 6, lane = tid & 63, fr = lane & 15, fq = lane >> 4;
  int qw0 = q0 + wid * 16, qpos = qw0 + fr;

  bf16x8 qf[NC][NKS];
  _Pragma("unroll") for (int c = 0; c < NC; ++c) _Pragma("unroll") for (int ks = 0; ks < NKS; ++ks)
    qf[c][ks] = *(const bf16x8*)&Qg[(long)(wid * 16 + fr) * q_stride + c * DQK + ks * 32 + fq * 8];
  f32x4 O[NC][NVT];
  _Pragma("unroll") for (int c = 0; c < NC; ++c) _Pragma("unroll") for (int v = 0; v < NVT; ++v) O[c][v] = f32x4{0.f, 0.f, 0.f, 0.f};
  float mrun[NC], lsum[NC];
  _Pragma("unroll") for (int c = 0; c < NC; ++c) { mrun[c] = -1e30f; lsum[c] = 0.f; }

  u32x4 kreg[KPT], vreg[VPT];
#define FA_PREFETCH(kt_) do { int k0_ = (kt_) * 64; \
    _Pragma("unroll") for (int i = 0; i < KPT; ++i) { int id = tid + i * 512, row = id / KCH, cc = id % KCH; kreg[i] = *(const u32x4*)&Kg[(long)(k0_ + row) * k_stride + cc * 8]; } \
    _Pragma("unroll") for (int i = 0; i < VPT; ++i) { int id = tid + i * 512, row = id >> 3, cc = id & 7; vreg[i] = *(const u32x4*)&VTg[(long)row * vt_stride + k0_ + cc * 8]; } } while (0)
  if (PF) FA_PREFETCH(0);
  for (int kt = 0; kt < nkt; ++kt) {
    if (!PF) FA_PREFETCH(kt);
    u16* Kb = Ks + (kt & 1) * KBUF; u16* Vb = Vs + (kt & 1) * VBUF;
    _Pragma("unroll") for (int i = 0; i < KPT; ++i) { int id = tid + i * 512, row = id / KCH, cc = id % KCH; *(u32x4*)&Kb[row * KLD + cc * 8] = kreg[i]; }
    _Pragma("unroll") for (int i = 0; i < VPT; ++i) { int id = tid + i * 512, row = id >> 3, cc = id & 7; *(u32x4*)&Vb[row * VLD + cc * 8] = vreg[i]; }
    __syncthreads();
    if (PF && kt + 1 < nkt) FA_PREFETCH(kt + 1);
    int k0 = kt * 64;
    if (CAUSAL && k0 > qw0 + 15) continue;
    bf16x8 pf[NC][2];
    _Pragma("unroll") for (int c = 0; c < NC; ++c) {
      f32x4 s[4];
      _Pragma("unroll") for (int m = 0; m < 4; ++m) s[m] = f32x4{0.f, 0.f, 0.f, 0.f};
      _Pragma("unroll") for (int ks = 0; ks < NKS; ++ks) _Pragma("unroll") for (int m = 0; m < 4; ++m) {
        bf16x8 a = *(const bf16x8*)&Kb[(16 * m + fr) * KLD + c * DQK + ks * 32 + fq * 8];
        s[m] = __builtin_amdgcn_mfma_f32_16x16x32_bf16(a, qf[c][ks], s[m], 0, 0, 0);
      }
      bool general = false; float bb = 0.f;
      if (CAUSAL) { general = (qw0 - (k0 + 63)) < 128; bb = btab[127]; }
      float mnew, alpha, psum = 0.f;
      if (general) {
        bool diag = (k0 + 63) > qw0; float tmax = -1e30f;
        _Pragma("unroll") for (int m = 0; m < 4; ++m) _Pragma("unroll") for (int j = 0; j < 4; ++j) {
          int dist = qpos - (k0 + 16 * m + fq * 4 + j);
          int di = dist < 0 ? 0 : (dist > 127 ? 127 : dist);
          float v = s[m][j] * scale_log2 + btab[di];
          if (diag && dist < 0) v = -1e30f;
          s[m][j] = v; tmax = fmaxf(tmax, v);
        }
        tmax = fmaxf(tmax, sx<16>(tmax, lane)); tmax = fmaxf(tmax, sx<32>(tmax, lane));
        mnew = fmaxf(mrun[c], tmax);
        _Pragma("unroll") for (int m = 0; m < 4; ++m) _Pragma("unroll") for (int j = 0; j < 4; ++j) { float pv = __builtin_amdgcn_exp2f(s[m][j] - mnew); s[m][j] = pv; psum += pv; }
      } else {
        float rmax = fmaxf(fmaxf(s[0][0], s[0][1]), fmaxf(s[0][2], s[0][3]));
        _Pragma("unroll") for (int m = 1; m < 4; ++m) rmax = fmaxf(rmax, fmaxf(fmaxf(s[m][0], s[m][1]), fmaxf(s[m][2], s[m][3])));
        rmax = fmaxf(rmax, sx<16>(rmax, lane)); rmax = fmaxf(rmax, sx<32>(rmax, lane));
        mnew = fmaxf(mrun[c], rmax * scale_log2 + bb);
        float cc = bb - mnew;
        _Pragma("unroll") for (int m = 0; m < 4; ++m) _Pragma("unroll") for (int j = 0; j < 4; ++j) { float pv = __builtin_amdgcn_exp2f(s[m][j] * scale_log2 + cc); s[m][j] = pv; psum += pv; }
      }
      alpha = __builtin_amdgcn_exp2f(mrun[c] - mnew);
      mrun[c] = mnew;
      lsum[c] = lsum[c] * alpha + psum;
      if (__builtin_amdgcn_ballot_w64(alpha != 1.f) != 0ull) {
        _Pragma("unroll") for (int v = 0; v < NVT; ++v) _Pragma("unroll") for (int j = 0; j < 4; ++j) O[c][v][j] *= alpha;
      }
      _Pragma("unroll") for (int k2 = 0; k2 < 2; ++k2) {
        uint2 lo = pack4(s[2 * k2][0], s[2 * k2][1], s[2 * k2][2], s[2 * k2][3]);
        uint2 hi = pack4(s[2 * k2 + 1][0], s[2 * k2 + 1][1], s[2 * k2 + 1][2], s[2 * k2 + 1][3]);
        uint4 pk; pk.x = lo.x; pk.y = lo.y; pk.z = hi.x; pk.w = hi.y;
        pf[c][k2] = *(bf16x8*)&pk;
      }
    }
    _Pragma("unroll") for (int k2 = 0; k2 < 2; ++k2) _Pragma("unroll") for (int v = 0; v < NVT; ++v) {
      uint2 lo = *(const uint2*)&Vb[(16 * v + fr) * VLD + 32 * k2 + fq * 4];
      uint2 hi = *(const uint2*)&Vb[(16 * v + fr) * VLD + 32 * k2 + 16 + fq * 4];
      uint4 pk; pk.x = lo.x; pk.y = lo.y; pk.z = hi.x; pk.w = hi.y;
      bf16x8 a = *(bf16x8*)&pk;
      _Pragma("unroll") for (int c = 0; c < NC; ++c) O[c][v] = __builtin_amdgcn_mfma_f32_16x16x32_bf16(a, pf[c][k2], O[c][v], 0, 0, 0);
      if ((v & 3) == 3) __builtin_amdgcn_sched_barrier(0);
    }
  }
  float inv[NC];
  _Pragma("unroll") for (int c = 0; c < NC; ++c) { float l = lsum[c]; l += sx<16>(l, lane); l += sx<32>(l, lane); inv[c] = 1.f / l; }
  u16* orow = Og + (long)(wid * 16 + fr) * o_stride;
  if (NC == 2) {
    float ss = 0.f;
    _Pragma("unroll") for (int v = 0; v < NVT; ++v) _Pragma("unroll") for (int j = 0; j < 4; ++j) { float o = O[0][v][j] * inv[0] - lam * O[NC - 1][v][j] * inv[NC - 1]; O[0][v][j] = o; ss += o * o; }
    ss += sx<16>(ss, lane); ss += sx<32>(ss, lane);
    float rs = rsqrtf(ss * (1.f / DV) + EPS) * outscale;
    _Pragma("unroll") for (int v = 0; v < NVT; ++v) {
      float4 g = *(const float4*)&subln_g[16 * v + fq * 4];
      *(uint2*)&orow[16 * v + fq * 4] = pack4(O[0][v][0] * rs * g.x, O[0][v][1] * rs * g.y, O[0][v][2] * rs * g.z, O[0][v][3] * rs * g.w);
    }
  } else {
    _Pragma("unroll") for (int v = 0; v < NVT; ++v)
      *(uint2*)&orow[16 * v + fq * 4] = pack4(O[0][v][0] * inv[0], O[0][v][1] * inv[0], O[0][v][2] * inv[0], O[0][v][3] * inv[0]);
  }
}

__device__ __forceinline__ void diff_attn_phase(const Params& p, int j, int layer_idx, char* shm, int wv) {
  int tid = opaque_tid(wv), lane = tid & 63;
  float* btab = (float*)(shm + LDS_BYTES - 1024);
  float sa = p.da_lq1[j * 64 + lane] * p.da_lk1[j * 64 + lane], sb = p.da_lq2[j * 64 + lane] * p.da_lk2[j * 64 + lane];
  sa = wave_sum(sa, lane); sb = wave_sum(sb, lane);
  float lam_init = 0.8f - 0.6f * expf(-0.3f * (float)layer_idx);
  float lam = expf(sa) - expf(sb) + lam_init;
  const u16 *qb = p.B0, *kb = p.B1, *vT = p.B2; u16* ao = p.B3;
  for (int i = blockIdx.x; i < 2048; i += gridDim.x) {
    int wgl = i & 255, step = i >> 8, xcd = wgl & 7, slot = wgl >> 3;
    int bh = xcd + 8 * (step >> 1), qblk = (step & 1) ? 63 - slot : slot;
    int b = bh >> 3, h = bh & 7, q0 = qblk * 128;
    __syncthreads();
    if (tid < 128) btab[tid] = p.biastab[h * 128 + tid];
    flash_item<2, 64, 128, true, true>(qb + ((long)(b * SEQ + q0)) * DM + h * 128, DM, kb + ((long)b * SEQ) * DM + h * 128, DM,
                                 vT + ((long)(b * DM + h * 128)) * SEQ, SEQ, q0 / 64 + 2, q0, 0.125f * LOG2E, btab, lam,
                                 p.da_subln + j * 128, 1.f - lam_init, ao + ((long)(b * SEQ + q0)) * DM + h * 128, DM, shm, wv);
  }
}

__device__ __forceinline__ void cross_attn_phase(const Params& p, int layer, char* shm, int wv) {
  const u16* caq = p.B0; u16* cao = p.B1;
  const u16* mK = p.memK + (long)layer * NB * MEML * DM; const u16* mVT = p.memVT + (long)layer * NB * DM * MEML;
  for (int i = blockIdx.x; i < 1024; i += gridDim.x) {
    int head = i & 3, blk = i >> 2, b = blk >> 6, qblk = blk & 63;
    __syncthreads();
    flash_item<1, 256, 256, false, true>(caq + ((long)(b * SEQ + qblk * 128)) * DM + head * 256, DM, mK + ((long)b * MEML) * DM + head * 256, DM,
                                   mVT + ((long)(b * DM + head * 256)) * MEML, MEML, 4, 0, 0.0625f * LOG2E, nullptr, 0.f, nullptr, 1.f,
                                   cao + ((long)(b * SEQ + qblk * 128)) * DM + head * 256, DM, shm, wv);
  }
}

constexpr int HLD = 132;
__device__ __forceinline__ long kdt_off(int tok0, int h, int k) {
  return ((long)(tok0 + (k >> 1)) * DM + h * 128) + (k & 1) * 64;
}

__device__ __forceinline__ void hg1_phase(const Params& p, char* shm, int wv) {
  float* L = (float*)shm; float* Gs = L + 64 * HLD; float* Qs = Gs + 64 * HLD; float* R = Qs + 64 * HLD;
  int tid = opaque_tid(wv), wid = tid >> 6, lane = tid & 63, fr = lane & 15, fq = lane >> 4;
  u16* qbuf = p.B0; u16* lfbuf = p.B1; u16* Abuf = p.B4;
  u32x4 plv[2], pqv[2];
#define HG1_PREFETCH(it_) do { int h_ = (it_) & 7, cn_ = ((it_) >> 3) & 127, b_ = (it_) >> 10, tk_ = b_ * SEQ + cn_ * 64; \
    _Pragma("unroll") for (int i = 0; i < 2; ++i) { int id = tid + i * 512, row = id >> 4, cc = id & 15; \
      plv[i] = *(const u32x4*)&lfbuf[(long)(tk_ + row) * DM + h_ * 128 + cc * 8]; pqv[i] = *(const u32x4*)&qbuf[(long)(tk_ + row) * DM + h_ * 128 + cc * 8]; } } while (0)
  if ((int)blockIdx.x < 4096) HG1_PREFETCH((int)blockIdx.x);
  for (int it = blockIdx.x; it < 4096; it += gridDim.x) {
    int h = it & 7, cn = (it >> 3) & 127, b = it >> 10, tok0 = b * SEQ + cn * 64;
    __syncthreads();
    _Pragma("unroll") for (int i = 0; i < 2; ++i) {
      int id = tid + i * 512, row = id >> 4, cc = id & 15;
      _Pragma("unroll") for (int e = 0; e < 4; ++e) {
        unsigned lw = plv[i][e], qw = pqv[i][e];
        L[row * HLD + cc * 8 + 2 * e] = __uint_as_float(lw << 16); L[row * HLD + cc * 8 + 2 * e + 1] = __uint_as_float(lw & 0xffff0000u);
        Qs[row * HLD + cc * 8 + 2 * e] = __uint_as_float(qw << 16); Qs[row * HLD + cc * 8 + 2 * e + 1] = __uint_as_float(qw & 0xffff0000u);
      }
    }
    __syncthreads();
    if (it + (int)gridDim.x < 4096) HG1_PREFETCH(it + (int)gridDim.x);
    {
      int k = tid & 127, qd = tid >> 7; float run = 0.f;
      _Pragma("unroll") for (int i = 0; i < 16; ++i) { run += L[(16 * qd + i) * HLD + k]; Gs[(16 * qd + i) * HLD + k] = run; }
      R[(qd + 1) * 128 + k] = run;
    }
    __syncthreads();
    {
      int k = tid & 127, qd = tid >> 7; float r = 0.f;
      for (int i = 0; i < qd; ++i) r += R[(i + 1) * 128 + k];
      float tot = R[(qd + 1) * 128 + k];
      __syncthreads();
      _Pragma("unroll") for (int i = 0; i < 16; ++i) Gs[(16 * qd + i) * HLD + k] += r;
      R[qd * 128 + k] = r;
      if (qd == 3) R[4 * 128 + k] = r + tot;
    }
    __syncthreads();
    _Pragma("unroll") for (int i = 0; i < 2; ++i) {
      int id = tid + i * 512, row = id >> 4, cc = id & 15; float v[8];
      _Pragma("unroll") for (int e = 0; e < 8; ++e) v[e] = Qs[row * HLD + cc * 8 + e] * __expf(Gs[row * HLD + cc * 8 + e]);
      uint2 lo = pack4(v[0], v[1], v[2], v[3]), hi = pack4(v[4], v[5], v[6], v[7]);
      uint4 o; o.x = lo.x; o.y = lo.y; o.z = hi.x; o.w = hi.y;
      *(uint4*)&qbuf[(long)(tok0 + row) * DM + h * 128 + cc * 8] = o;
    }
    _Pragma("unroll") for (int i = 0; i < 2; ++i) {
      int id = tid + i * 512, k = id & 127, sc = id >> 7; float gl = R[4 * 128 + k]; float v[8];
      _Pragma("unroll") for (int e = 0; e < 8; ++e) { int s = sc * 8 + e; v[e] = (1.f - __expf(L[s * HLD + k])) * __expf(gl - Gs[s * HLD + k]); }
      uint2 lo = pack4(v[0], v[1], v[2], v[3]), hi = pack4(v[4], v[5], v[6], v[7]);
      uint4 o; o.x = lo.x; o.y = lo.y; o.z = hi.x; o.w = hi.y;
      *(uint4*)&lfbuf[kdt_off(tok0, h, k) + sc * 8] = o;
    }
    if (tid < 128) p.dbuf[(long)it * 128 + tid] = __expf(R[4 * 128 + tid]);
    u16* Ait = Abuf + (long)it * 4096;
    for (int blk = wid; blk < 10; blk += 8) {
      int ti = blk < 1 ? 0 : (blk < 3 ? 1 : (blk < 6 ? 2 : 3));
      int sj = blk - (ti * (ti + 1)) / 2;
      f32x4 acc = {0.f, 0.f, 0.f, 0.f};
      _Pragma("unroll") for (int ks = 0; ks < 4; ++ks) {
        float av[8], bv[8];
        _Pragma("unroll") for (int e = 0; e < 8; ++e) {
          int kk = ks * 32 + fq * 8 + e; float rr = R[ti * 128 + kk];
          av[e] = Qs[(16 * ti + fr) * HLD + kk] * __expf(Gs[(16 * ti + fr) * HLD + kk] - rr);
          bv[e] = (1.f - __expf(L[(16 * sj + fr) * HLD + kk])) * __expf(fminf(rr - Gs[(16 * sj + fr) * HLD + kk], 80.f));
        }
        uint2 al = pack4(av[0], av[1], av[2], av[3]), ah = pack4(av[4], av[5], av[6], av[7]);
        uint2 bl = pack4(bv[0], bv[1], bv[2], bv[3]), bh = pack4(bv[4], bv[5], bv[6], bv[7]);
        uint4 a4, b4; a4.x = al.x; a4.y = al.y; a4.z = ah.x; a4.w = ah.y; b4.x = bl.x; b4.y = bl.y; b4.z = bh.x; b4.w = bh.y;
        acc = __builtin_amdgcn_mfma_f32_16x16x32_bf16(*(bf16x8*)&a4, *(bf16x8*)&b4, acc, 0, 0, 0);
      }
      _Pragma("unroll") for (int j = 0; j < 4; ++j) {
        int t = 16 * ti + fq * 4 + j, s = 16 * sj + fr;
        float v = (s <= t) ? acc[j] : 0.f;
        Ait[t * 64 + s] = f2bf(v);
      }
    }
    if (wid < 6) {
      int ti = wid < 3 ? 0 : (wid < 5 ? 1 : 2);
      int sj = wid < 3 ? wid + 1 : (wid < 5 ? wid - 1 : 3);
      _Pragma("unroll") for (int j = 0; j < 4; ++j) Ait[(16 * ti + fq * 4 + j) * 64 + 16 * sj + fr] = 0;
    }
  }
}

template <int MODE>
__device__ __forceinline__ void hg2_phase(const Params& p, char* shm, int wv) {
  constexpr int QLD = 136, KLD = 72;
  constexpr int QB = 64 * QLD, KB = 128 * KLD, AB = 64 * KLD, VB = 128 * KLD;
  constexpr int BUF_EL = QB + KB + AB + VB + 256;
  int tid = opaque_tid(wv), wid = tid >> 6, lane = tid & 63, fr = lane & 15, fq = lane >> 4;
  u16* qbuf = p.B0; const u16* kdbuf = p.B1; const u16* iT = p.B2; const u16* Abuf = p.B4;
  float* Send = p.out; float* Dseg = Send + 32L * 8 * 128 * 128;
  for (int it = blockIdx.x; it < 256; it += gridDim.x) {
    int bh = it >> 3, seg = it & 7, b = bh >> 3, h = bh & 7;
    if (MODE == 0 && seg == 7) continue;
    f32x4 S[8];
    _Pragma("unroll") for (int m = 0; m < 8; ++m) S[m] = f32x4{0.f, 0.f, 0.f, 0.f};
    if (MODE == 1) {
      for (int g = 0; g < seg; ++g) {
        const float* se = Send + ((long)(bh * 8 + g)) * 16384; const float* dg = Dseg + (bh * 8 + g) * 128;
        _Pragma("unroll") for (int m = 0; m < 8; ++m) {
          float4 dv = *(const float4*)&dg[16 * m + fq * 4];
          S[m][0] = S[m][0] * dv.x + se[(16 * m + fq * 4 + 0) * 128 + 16 * wid + fr];
          S[m][1] = S[m][1] * dv.y + se[(16 * m + fq * 4 + 1) * 128 + 16 * wid + fr];
          S[m][2] = S[m][2] * dv.z + se[(16 * m + fq * 4 + 2) * 128 + 16 * wid + fr];
          S[m][3] = S[m][3] * dv.w + se[(16 * m + fq * 4 + 3) * 128 + 16 * wid + fr];
        }
      }
    }
    float dacc = 1.f;
    u32x4 rq[2], rk[2], ra, rv[2]; f32x4 rd = {0.f, 0.f, 0.f, 0.f};
#define HG_PREFETCH(cn_) do { int tok0_ = b * SEQ + (cn_) * 64; long it_ = ((long)(b * 128 + (cn_))) * 8 + h; \
      if (MODE == 1) { _Pragma("unroll") for (int i = 0; i < 2; ++i) { int id = tid + i * 512, row = id >> 4, cc = id & 15; rq[i] = *(const u32x4*)&qbuf[(long)(tok0_ + row) * DM + h * 128 + cc * 8]; } } \
      _Pragma("unroll") for (int i = 0; i < 2; ++i) { int id = tid + i * 512, k = id >> 3, sc = id & 7; rk[i] = *(const u32x4*)&kdbuf[kdt_off(tok0_, h, k) + sc * 8]; } \
      if (MODE == 1) { int t = tid >> 3, sc = tid & 7; ra = *(const u32x4*)&Abuf[it_ * 4096 + t * 64 + sc * 8]; } \
      _Pragma("unroll") for (int i = 0; i < 2; ++i) { int id = tid + i * 512, v = id >> 3, sc = id & 7; rv[i] = *(const u32x4*)&iT[((long)(b * 128 + (cn_)) * DM + h * 128 + v) * 64 + sc * 8]; } \
      if (tid < 32) rd = *(const f32x4*)&p.dbuf[it_ * 128 + tid * 4]; } while (0)
#define HG_STASH(bi_) do { \
      u16* base_ = (u16*)shm + (bi_) * BUF_EL; u16* Qt_ = base_; u16* Kd_ = Qt_ + QB; u16* At_ = Kd_ + KB; u16* Vt_ = At_ + AB; float* dd_ = (float*)(Vt_ + VB); \
      if (MODE == 1) { _Pragma("unroll") for (int i = 0; i < 2; ++i) { int id = tid + i * 512, row = id >> 4, cc = id & 15; *(u32x4*)&Qt_[row * QLD + cc * 8] = rq[i]; } } \
      _Pragma("unroll") for (int i = 0; i < 2; ++i) { int id = tid + i * 512, k = id >> 3, sc = id & 7; *(u32x4*)&Kd_[k * KLD + sc * 8] = rk[i]; } \
      if (MODE == 1) { int t = tid >> 3, sc = tid & 7; *(u32x4*)&At_[t * KLD + sc * 8] = ra; } \
      _Pragma("unroll") for (int i = 0; i < 2; ++i) { int id = tid + i * 512, v = id >> 3, sc = id & 7; *(u32x4*)&Vt_[v * KLD + sc * 8] = rv[i]; } \
      if (tid < 32) *(f32x4*)&dd_[tid * 4] = rd; } while (0)
    __syncthreads();
    HG_PREFETCH(seg * 16); HG_STASH(0);
    for (int c = 0; c < 16; ++c) {
      int cn = seg * 16 + c;
      __syncthreads();
      if (c + 1 < 16) HG_PREFETCH(cn + 1);
      u16* base = (u16*)shm + (c & 1) * BUF_EL; u16* Qt = base; u16* Kd = Qt + QB; u16* At = Kd + KB; u16* Vt = At + AB; float* dd = (float*)(Vt + VB);
      bf16x8 vb[2];
      _Pragma("unroll") for (int k2 = 0; k2 < 2; ++k2) vb[k2] = *(const bf16x8*)&Vt[(16 * wid + fr) * KLD + k2 * 32 + fq * 8];
      if (MODE == 1) {
        bf16x8 Sb[4];
        _Pragma("unroll") for (int ks = 0; ks < 4; ++ks) {
          uint2 lo = pack4(S[2 * ks][0], S[2 * ks][1], S[2 * ks][2], S[2 * ks][3]);
          uint2 hi = pack4(S[2 * ks + 1][0], S[2 * ks + 1][1], S[2 * ks + 1][2], S[2 * ks + 1][3]);
          uint4 pk; pk.x = lo.x; pk.y = lo.y; pk.z = hi.x; pk.w = hi.y; Sb[ks] = *(bf16x8*)&pk;
        }
        int tok0 = b * SEQ + cn * 64;
        _Pragma("unroll") for (int rt = 0; rt < 4; ++rt) {
          f32x4 o = {0.f, 0.f, 0.f, 0.f};
          _Pragma("unroll") for (int ks = 0; ks < 4; ++ks) {
            uint2 lo = *(const uint2*)&Qt[(16 * rt + fr) * QLD + 32 * ks + fq * 4];
            uint2 hi = *(const uint2*)&Qt[(16 * rt + fr) * QLD + 32 * ks + 16 + fq * 4];
            uint4 pk; pk.x = lo.x; pk.y = lo.y; pk.z = hi.x; pk.w = hi.y;
            o = __builtin_amdgcn_mfma_f32_16x16x32_bf16(*(bf16x8*)&pk, Sb[ks], o, 0, 0, 0);
          }
          _Pragma("unroll") for (int k2 = 0; k2 < 2; ++k2) {
            bf16x8 a = *(const bf16x8*)&At[(16 * rt + fr) * KLD + k2 * 32 + fq * 8];
            o = __builtin_amdgcn_mfma_f32_16x16x32_bf16(a, vb[k2], o, 0, 0, 0);
          }
          _Pragma("unroll") for (int j = 0; j < 4; ++j) qbuf[(long)(tok0 + 16 * rt + fq * 4 + j) * DM + h * 128 + 16 * wid + fr] = f2bf(o[j]);
        }
      } else if (tid < 128) dacc *= dd[tid];
      _Pragma("unroll") for (int m = 0; m < 8; ++m) {
        float4 dv = *(const float4*)&dd[16 * m + fq * 4];
        S[m][0] *= dv.x; S[m][1] *= dv.y; S[m][2] *= dv.z; S[m][3] *= dv.w;
        _Pragma("unroll") for (int k2 = 0; k2 < 2; ++k2) {
          bf16x8 a = *(const bf16x8*)&Kd[(16 * m + fr) * KLD + k2 * 32 + fq * 8];
          S[m] = __builtin_amdgcn_mfma_f32_16x16x32_bf16(a, vb[k2], S[m], 0, 0, 0);
        }
      }
      if (c + 1 < 16) HG_STASH((c + 1) & 1);
    }
    if (MODE == 0) {
      float* se = Send + ((long)(bh * 8 + seg)) * 16384;
      _Pragma("unroll") for (int m = 0; m < 8; ++m) _Pragma("unroll") for (int j = 0; j < 4; ++j) se[(16 * m + fq * 4 + j) * 128 + 16 * wid + fr] = S[m][j];
      if (tid < 128) Dseg[(bh * 8 + seg) * 128 + tid] = dacc;
    }
  }
}

__device__ __forceinline__ void hg3_phase(const Params& p, int wv) {
  int tid = opaque_tid(wv); int wid = tid >> 6, lane = tid & 63;
  u16* ob = p.B0; const u16* gb = p.B3;
  for (int row = blockIdx.x * 8 + wid; row < T_TOK; row += gridDim.x * 8) {
    uint4 o0 = *(const uint4*)&ob[(long)row * DM + lane * 16], o1 = *(const uint4*)&ob[(long)row * DM + lane * 16 + 8];
    uint4 g0 = *(const uint4*)&gb[(long)row * DM + lane * 16], g1 = *(const uint4*)&gb[(long)row * DM + lane * 16 + 8];
    float o[16], g[16];
    const u16* po0 = (const u16*)&o0; const u16* po1 = (const u16*)&o1; const u16* pg0 = (const u16*)&g0; const u16* pg1 = (const u16*)&g1;
    _Pragma("unroll") for (int e = 0; e < 8; ++e) { o[e] = bf2f(po0[e]); o[8 + e] = bf2f(po1[e]); g[e] = bf2f(pg0[e]); g[8 + e] = bf2f(pg1[e]); }
    float ss = 0.f; _Pragma("unroll") for (int e = 0; e < 16; ++e) ss += o[e] * o[e];
    ss += sx<1>(ss, lane); ss += sx<2>(ss, lane); ss += sx<4>(ss, lane);
    float rs = rsqrtf(ss * (1.f / 128.f) + EPS);
    int c0 = (lane & 7) * 16; float r[16];
    _Pragma("unroll") for (int e = 0; e < 16; ++e) r[e] = o[e] * rs * p.hg_onorm[c0 + e] * silu_f(g[e]);
    uint2 a = pack4(r[0], r[1], r[2], r[3]), b2 = pack4(r[4], r[5], r[6], r[7]), c = pack4(r[8], r[9], r[10], r[11]), d = pack4(r[12], r[13], r[14], r[15]);
    uint4 w0, w1; w0.x = a.x; w0.y = a.y; w0.z = b2.x; w0.w = b2.y; w1.x = c.x; w1.y = c.y; w1.z = d.x; w1.w = d.y;
    *(uint4*)&ob[(long)row * DM + lane * 16] = w0; *(uint4*)&ob[(long)row * DM + lane * 16 + 8] = w1;
  }
}

__device__ __forceinline__ void sgu_phase(const Params& p, char* shm, int wv) {
  constexpr int WLD = 136;
  u16* Wp = (u16*)shm; float* rsv = (float*)(shm + 128 * WLD * 2);
  int tid = opaque_tid(wv), wid = tid >> 6, lane = tid & 63, fr = lane & 15, fq = lane >> 4;
  const u16* ub = p.B0; const u16* vT = p.B1; u16* ob = p.B2; const float* rowss_v = p.vpart;
  for (int it = blockIdx.x; it < 2048; it += gridDim.x) {
    int g = it & 7, c128 = it >> 3, tok0 = c128 * 128;
    __syncthreads();
    if (tid < 128) rsv[tid] = row_rs(rowss_v, tok0 + tid);
    __syncthreads();
    _Pragma("unroll") for (int i = 0; i < 4; ++i) {
      int id = tid + i * 512, t = id >> 4, sc = id & 15;
      const float4* w4 = (const float4*)(p.sg_w_s + ((long)(g * 128 + t)) * 128 + sc * 8);
      float4 a = w4[0], b = w4[1]; float v[8] = {a.x, a.y, a.z, a.w, b.x, b.y, b.z, b.w};
      _Pragma("unroll") for (int e = 0; e < 8; ++e) { int s = sc * 8 + e; v[e] = (s <= t) ? v[e] * rsv[s] : 0.f; }
      uint2 lo = pack4(v[0], v[1], v[2], v[3]), hi = pack4(v[4], v[5], v[6], v[7]);
      uint4 o; o.x = lo.x; o.y = lo.y; o.z = hi.x; o.w = hi.y;
      *(uint4*)&Wp[t * WLD + sc * 8] = o;
    }
    bf16x8 vb[4];
    int cc = g * 128 + 16 * wid + fr;
    _Pragma("unroll") for (int ks = 0; ks < 4; ++ks) vb[ks] = *(const bf16x8*)&vT[((long)c128 * DM + cc) * 128 + ks * 32 + fq * 8];
    float4 gvn = *(const float4*)&p.sg_vnorm[g * 128 + 16 * wid + fq * 4];
    __syncthreads();
    _Pragma("unroll") for (int mt = 0; mt < 8; ++mt) {
      f32x4 acc = {0.f, 0.f, 0.f, 0.f};
      _Pragma("unroll") for (int ks = 0; ks <= (mt >> 1); ++ks) {
        bf16x8 a = *(const bf16x8*)&Wp[(16 * mt + fr) * WLD + ks * 32 + fq * 8];
        acc = __builtin_amdgcn_mfma_f32_16x16x32_bf16(vb[ks], a, acc, 0, 0, 0);
      }
      int t = 16 * mt + fr; float bs = p.sg_b_s[g * 128 + t];
      long idx = (long)(tok0 + t) * DM + g * 128 + 16 * wid + fq * 4;
      uint2 uv = *(const uint2*)&ub[idx];
      float u0 = __uint_as_float(uv.x << 16), u1 = __uint_as_float(uv.x & 0xffff0000u), u2 = __uint_as_float(uv.y << 16), u3 = __uint_as_float(uv.y & 0xffff0000u);
      *(uint2*)&ob[idx] = pack4(u0 * (acc[0] * gvn.x + bs), u1 * (acc[1] * gvn.y + bs), u2 * (acc[2] * gvn.z + bs), u3 * (acc[3] * gvn.w + bs));
    }
  }
}

__device__ __forceinline__ void final_phase(const Params& p, int wv) {
  int tid = opaque_tid(wv); int wid = tid >> 6, lane = tid & 63;
  for (int row = blockIdx.x * 8 + wid; row < T_TOK; row += gridDim.x * 8) {
    float rs = row_rs(p.rpart, row);
    float4* o4 = (float4*)(p.out + (long)row * DM);
    const uint2* x2 = (const uint2*)(p.xb + (long)row * DM);
    _Pragma("unroll") for (int i = 0; i < 4; ++i) {
      uint2 xv = x2[i * 64 + lane]; float4 g = ((const float4*)p.norm_final)[i * 64 + lane]; float4 v;
      v.x = __uint_as_float(xv.x << 16) * rs * g.x; v.y = __uint_as_float(xv.x & 0xffff0000u) * rs * g.y;
      v.z = __uint_as_float(xv.y << 16) * rs * g.z; v.w = __uint_as_float(xv.y & 0xffff0000u) * rs * g.w;
      o4[i * 64 + lane] = v;
    }
  }
}

#define XB_TMO      128
#define XB_XCNT(j)  (256  + 64 * (j))
#define XB_XSUB(j)  (1280 + 64 * (j))
#define XB_XGEN(j)  (2304 + 64 * (j))
#define XB_TOP      3328
#define XB_TOPGEN   3392
#define XCD_BAR_WORDS 3456
#define XB_SPIN_CAP (1u << 22)
#define LAS __attribute__((address_space(3)))

__device__ __forceinline__ unsigned xb_ld(unsigned* p)              { return __hip_atomic_load(p, __ATOMIC_RELAXED, __HIP_MEMORY_SCOPE_AGENT); }
__device__ __forceinline__ unsigned xb_add(unsigned* p, unsigned v) { return __hip_atomic_fetch_add(p, v, __ATOMIC_RELAXED, __HIP_MEMORY_SCOPE_AGENT); }
__device__ __forceinline__ unsigned xb_xcc_id() { return (unsigned)__builtin_amdgcn_s_getreg((3 << 11) | 20) & 0xFu; }
#define XB_SPIN(cond, bar) do { unsigned _sp = 0; while (cond) { __builtin_amdgcn_s_sleep(1); \
    if ((++_sp & 255u) == 0u) { if (xb_ld(&(bar)[XB_TMO])) break; if (_sp > XB_SPIN_CAP) { atomicAdd(&(bar)[XB_TMO], 1u); break; } } } } while (0)

struct XcdBarrier {
    unsigned* bar; unsigned x;
    volatile LAS unsigned* st;
};

__device__ __forceinline__ XcdBarrier xcd_barrier_post(unsigned* bar, volatile LAS unsigned* st, bool t0) {
    XcdBarrier b; b.bar = bar; b.x = xb_xcc_id(); b.st = st;
    if (t0) (void)xb_add(&bar[XB_XCNT(b.x)], 1u);
    return b;
}
__device__ __forceinline__ void xcd_barrier_complete(unsigned* bar, unsigned x, unsigned& nloc, unsigned& nx) {
    const unsigned G = gridDim.x * gridDim.y * gridDim.z;
    unsigned sum, cnt, mine, sp = 0u;
    for (;;) {
        sum = 0u; cnt = 0u; mine = 0u;
#pragma unroll
        for (unsigned j = 0; j < 16; ++j) { const unsigned c = xb_ld(&bar[XB_XCNT(j)]); sum += c; cnt += (c > 0u) ? 1u : 0u; mine = (j == x) ? c : mine; }
        if (sum == G) break;
        __builtin_amdgcn_s_sleep(1);
        if ((++sp & 255u) == 0u) { if (xb_ld(&bar[XB_TMO])) break; if (sp > XB_SPIN_CAP) { atomicAdd(&bar[XB_TMO], 1u); break; } }
    }
    nloc = mine > 0u ? mine : 1u; nx = cnt > 0u ? cnt : 1u;
}

__device__ __forceinline__ void xcd_barrier(const XcdBarrier& b, bool t0) {
    asm volatile("s_waitcnt vmcnt(0)" ::: "memory");
    __syncthreads();
    if (t0) {
        unsigned* bar = b.bar;
        __builtin_amdgcn_s_waitcnt(0);
        unsigned nloc = b.st[0], nx = b.st[1];
        if (nloc == 0u) { xcd_barrier_complete(bar, b.x, nloc, nx); b.st[0] = nloc; b.st[1] = nx; }
        const unsigned old = xb_add(&bar[XB_XSUB(b.x)], 1u);
        const unsigned gen = old / nloc;
        if (old + 1u == (gen + 1u) * nloc) {
            __builtin_amdgcn_fence(__ATOMIC_RELEASE, "agent");
            asm volatile("s_waitcnt vmcnt(0)" ::: "memory");
            const unsigned og = xb_add(&bar[XB_TOP], 1u);
            const unsigned tg = og / nx;
            if (og + 1u == (tg + 1u) * nx) xb_add(&bar[XB_TOPGEN], 1u);
            else XB_SPIN(xb_ld(&bar[XB_TOPGEN]) == tg, bar);
            __builtin_amdgcn_fence(__ATOMIC_ACQUIRE, "agent");
            xb_add(&bar[XB_XGEN(b.x)], 1u);
            asm volatile("s_waitcnt vmcnt(0)" ::: "memory");
        } else {
            XB_SPIN(xb_ld(&bar[XB_XGEN(b.x)]) == gen, bar);
            __builtin_amdgcn_fence(__ATOMIC_ACQUIRE, "agent");
            asm volatile("s_waitcnt vmcnt(0)" ::: "memory");
        }
    }
    __syncthreads();
}


#define SEL4(arr, i) ((i) == 0 ? (arr)[0] : ((i) == 1 ? (arr)[1] : ((i) == 2 ? (arr)[2] : (arr)[3])))
__global__ void __launch_bounds__(512, 2) fwd_megakernel(KArgs ka_unused) {
  extern __shared__ __attribute__((aligned(16))) char shm[];
  const int wv = __builtin_amdgcn_readfirstlane((int)(threadIdx.x >> 6));
  int ph = 0;
#define BARRIER_WS ((unsigned*)(kargs_ptr()->ws + OFF_BAR))
#if MULTI_LAUNCH
#define PHASE_BEGIN if (ph >= kargs_ptr()->phase_lo && ph < kargs_ptr()->phase_hi) { const Params p = make_params(*kargs_ptr());
#define PHASE_END } ++ph;
#else
  cg::grid_group grid = cg::this_grid();
#define PHASE_BEGIN { const Params p = make_params(*kargs_ptr());
#define PHASE_END } ++ph; { XcdBarrier xb_; xb_.bar = BARRIER_WS; xb_.x = xb_xcc_id(); xb_.st = (volatile LAS unsigned*)(shm + LDS_BYTES - 16); xcd_barrier(xb_, opaque_tid(wv) == 0); }
#endif
#define LAYER_VARS \
    const float* xin = (i == 0) ? p.x : p.out; float* rs_mix = p.rpart; float* rs_cross = p.rpart; float* rs_ffn = p.rpart; float* rs_next = p.rpart; \
    const u16* w_mix_in = p.wbase + layer_woff(i); const u16* w_mix_out = w_mix_in + mixin_elems(i); const u16* w_caq = w_mix_out + 1048576L; \
    const u16* w_cao = w_caq + 3145728L; const u16* w_gu = w_cao + 1048576L; const u16* w_down = w_gu + 5767168L; \
    const u16* mix_out_A = kind == 0 ? p.B3 : (kind == 1 ? p.B0 : p.B2); \
    (void)xin; (void)rs_mix; (void)rs_cross; (void)rs_ffn; (void)rs_next; (void)w_mix_in; (void)w_mix_out; (void)w_caq; (void)w_cao; (void)w_gu; (void)w_down; (void)mix_out_A;
#if MULTI_LAUNCH
  PHASE_BEGIN prep_phase(p, kargs_ptr(), shm, wv); PHASE_END
#else
  { const Params p = make_params(*kargs_ptr()); prep_phase(p, kargs_ptr(), shm, wv); } ++ph;
  grid.sync();
  {
    volatile LAS unsigned* xb_st = (volatile LAS unsigned*)(shm + LDS_BYTES - 16);
    if (opaque_tid(wv) == 0) { xb_st[0] = 0u; xb_st[1] = 0u; }
    __syncthreads();
    (void)xcd_barrier_post(BARRIER_WS, xb_st, opaque_tid(wv) == 0);
  }
#endif
  _Pragma("nounroll") for (int i = 0; i < 4; ++i) {
    int kind = i % 3, j = i / 3;
    if (kind == 0) {
      PHASE_BEGIN LAYER_VARS
        if (i == 0) {
          for (int t = blockIdx.x; t < 128; t += gridDim.x) {
            int l = t >> 5, tt = t & 31, tr0 = (tt & 3) * BM, fc0 = (tt >> 2) * BM;
            EpiMemKV em{p.memK + (long)l * NB * MEML * DM, p.memVT + (long)l * NB * DM * MEML};
            const u16* mA = p.memn; const u16* mB = p.wbase + layer_woff(l) + mixin_elems(l) + 2097152L;
            bool sw = em.swap(fc0);
            gemm_tile(sw ? mB : mA, sw ? mA : mB, DM, sw ? fc0 : tr0, sw ? tr0 : fc0, shm, em, tr0, fc0, sw, false, false, mA, mB, 0, 0, wv);
          }
        }
        EpiDaIn e{rs_mix, p.B0, p.B1, p.B2}; gemm_phase(p.xb, w_mix_in, T_TOK, 3 * DM, DM, shm, e, wv);
      PHASE_END
      PHASE_BEGIN diff_attn_phase(p, j, i, shm, wv); PHASE_END
    } else if (kind == 1) {
      PHASE_BEGIN LAYER_VARS EpiHgIn e{rs_mix, p.lbv, p.B0, p.B1, p.B2, p.B3}; gemm_phase(p.xb, w_mix_in, T_TOK, 4 * DM, DM, shm, e, wv); PHASE_END
      PHASE_BEGIN hg1_phase(p, shm, wv); PHASE_END
      PHASE_BEGIN hg2_phase<0>(p, shm, wv); PHASE_END
      PHASE_BEGIN hg2_phase<1>(p, shm, wv); PHASE_END
      PHASE_BEGIN hg3_phase(p, wv); PHASE_END
    } else {
      PHASE_BEGIN LAYER_VARS EpiSgIn e{rs_mix, p.B0, p.B1, p.vpart}; gemm_phase(p.xb, w_mix_in, T_TOK, 2 * DM, DM, shm, e, wv); PHASE_END
      PHASE_BEGIN sgu_phase(p, shm, wv); PHASE_END
    }
    PHASE_BEGIN LAYER_VARS EpiRes e{p.xb, rs_cross}; gemm_phase(mix_out_A, w_mix_out, T_TOK, DM, DM, shm, e, wv); PHASE_END
    PHASE_BEGIN LAYER_VARS EpiStore e{rs_cross, p.B0, DM}; gemm_phase(p.xb, w_caq, T_TOK, DM, DM, shm, e, wv); PHASE_END
    PHASE_BEGIN cross_attn_phase(p, i, shm, wv); PHASE_END
    PHASE_BEGIN LAYER_VARS EpiRes e{p.xb, rs_ffn}; gemm_phase(p.B1, w_cao, T_TOK, DM, DM, shm, e, wv); PHASE_END
    PHASE_BEGIN LAYER_VARS EpiFfn e{rs_ffn, p.B0}; gemm_phase(p.xb, w_gu, T_TOK, 2 * DFF, DM, shm, e, wv); PHASE_END
    PHASE_BEGIN LAYER_VARS EpiRes e{p.xb, rs_next}; gemm_phase(p.B0, w_down, T_TOK, DM, DFF, shm, e, wv); PHASE_END
  }
#if MULTI_LAUNCH
  PHASE_BEGIN final_phase(p, wv); PHASE_END
#else
  { const Params p = make_params(*kargs_ptr()); final_phase(p, wv); }
#endif
}

extern "C" void kernel_launch(void* const* d_in, const int* in_sizes, int n_in, void* d_out, int out_size, void* d_ws, size_t ws_size,
                              hipStream_t stream) {
  static int grid_blocks = 0;
  if (!grid_blocks) {
    int dev = 0, cus = 0, per_cu = 0;
    hipGetDevice(&dev);
    hipDeviceGetAttribute(&cus, hipDeviceAttributeMultiprocessorCount, dev);
    if (hipFuncSetAttribute((const void*)fwd_megakernel, hipFuncAttributeMaxDynamicSharedMemorySize, LDS_BYTES) != hipSuccess)
      fprintf(stderr, "hipFuncSetAttribute failed\n");
    hipOccupancyMaxActiveBlocksPerMultiprocessor(&per_cu, (const void*)fwd_megakernel, 512, LDS_BYTES);
    if (per_cu < 1) { fprintf(stderr, "occupancy query returned %d\n", per_cu); per_cu = 1; }
    grid_blocks = cus * per_cu;
    (void)hipGetLastError();
  }
  KArgs p;
  memset(&p, 0, sizeof(p));
  const float* const* in = (const float* const*)d_in;
  p.x = in[0]; p.mem = in[1]; p.rel_bias = in[2];
  const float *norm_mix = in[3], *norm_cross = in[4], *norm_ffn = in[5];
  p.norm_mem = in[6]; p.norm_final = in[7];
  const float *da_w_in = in[8], *da_w_out = in[9];
  p.da_lq1 = in[10]; p.da_lk1 = in[11]; p.da_lq2 = in[12]; p.da_lk2 = in[13]; p.da_subln = in[14];
  const float *hg_w_in = in[15], *hg_w_out = in[16];
  p.hg_lb = in[17]; p.hg_onorm = in[18];
  const float *sg_w_in = in[19], *sg_w_out = in[20];
  p.sg_vnorm = in[21]; p.sg_w_s = in[22]; p.sg_b_s = in[23];
  const float *ca_w_q = in[24], *ca_w_kv = in[25], *ca_w_o = in[26], *ffn_w_gu = in[27], *ffn_w_down = in[28];
  p.out = (float*)d_out; p.ws = (char*)d_ws;
  if (WS_END > ws_size) { fprintf(stderr, "workspace too small: need %zu have %zu\n", (size_t)WS_END, ws_size); return; }
  int nwd = 0, tiles = 0;
  u16* wcur = (u16*)((char*)d_ws + OFF_W);
  auto addw = [&](const float* src, int K, int N, const float* gain, int perm) {
    WDesc& w = p.wd[nwd++]; w.src = src; w.dst = wcur; w.gain = gain; w.K = K; w.N = N; w.perm = perm; w.tile0 = tiles;
    tiles += (K / 64) * (N / 64); wcur += (size_t)K * N;
  };
  for (int i = 0; i < 4; ++i) {
    int kind = i % 3, j = i / 3;
    if (wcur != (u16*)((char*)d_ws + OFF_W) + layer_woff(i)) fprintf(stderr, "weight layout mismatch at layer %d\n", i);
    if (kind == 0) { addw(da_w_in + (size_t)j * DM * 3 * DM, DM, 3 * DM, norm_mix + i * DM, 0); addw(da_w_out + (size_t)j * DM * DM, DM, DM, nullptr, 0); }
    else if (kind == 1) { addw(hg_w_in + (size_t)j * DM * 4 * DM, DM, 4 * DM, norm_mix + i * DM, 0); addw(hg_w_out + (size_t)j * DM * DM, DM, DM, nullptr, 0); }
    else { addw(sg_w_in + (size_t)j * DM * 2 * DM, DM, 2 * DM, norm_mix + i * DM, 0); addw(sg_w_out + (size_t)j * DM * DM, DM, DM, nullptr, 0); }
    addw(ca_w_q + (size_t)i * DM * DM, DM, DM, norm_cross + i * DM, 0);
    addw(ca_w_kv + (size_t)i * DM * 2 * DM, DM, 2 * DM, nullptr, 0);
    addw(ca_w_o + (size_t)i * DM * DM, DM, DM, nullptr, 0);
    addw(ffn_w_gu + (size_t)i * DM * 2 * DFF, DM, 2 * DFF, norm_ffn + i * DM, 1);
    addw(ffn_w_down + (size_t)i * DFF * DM, DFF, DM, nullptr, 0);
  }
  p.nwd = nwd; p.total_wtiles = tiles;
#if MULTI_LAUNCH
  _Pragma("unroll") for (int ph = 0; ph < 64; ++ph) {
    p.phase_lo = ph; p.phase_hi = ph + 1;
    hipLaunchKernelGGL(fwd_megakernel, dim3(grid_blocks), dim3(512), LDS_BYTES, stream, p);
  }
#else
  p.phase_lo = 0; p.phase_hi = 1 << 30;
  void* args[] = {&p};
  hipError_t e = hipLaunchCooperativeKernel((void*)fwd_megakernel, dim3(grid_blocks), dim3(512), args, LDS_BYTES, stream);
  if (e != hipSuccess) fprintf(stderr, "cooperative launch failed: %s (grid %d)\n", hipGetErrorString(e), grid_blocks);
#endif
}
```

```cpp
#include <hip/hip_runtime.h>
#include <hip/hip_cooperative_groups.h>
#include <cstdio>
#include <cmath>
#include <cstring>
namespace cg = cooperative_groups;

typedef unsigned short u16;
using bf16x8 = __attribute__((ext_vector_type(8))) short;
using bf16x4 = __attribute__((ext_vector_type(4))) short;
using f32x4 = __attribute__((ext_vector_type(4))) float;
using u32x4 = __attribute__((ext_vector_type(4))) unsigned;

#ifndef MULTI_LAUNCH
#define MULTI_LAUNCH 0
#endif

constexpr int T_TOK = 32768, DM = 1024, SEQ = 8192, NB = 4, DFF = 2816, MEML = 256;
constexpr float EPS = 1e-6f;
constexpr int LDS_BYTES = 147456;
constexpr float LOG2E = 1.4426950408889634f;

typedef __attribute__((ext_vector_type(2))) float f32x2;
typedef __attribute__((ext_vector_type(2))) __bf16 bf16x2_t;
__device__ __forceinline__ unsigned pk2(float a, float b) { f32x2 v = {a, b}; bf16x2_t r = __builtin_convertvector(v, bf16x2_t); return *(unsigned*)&r; }
__device__ __forceinline__ u16 f2bf(float f) { return (u16)(pk2(f, 0.f) & 0xffffu); }
__device__ __forceinline__ float bf2f(u16 h) { return __uint_as_float(((unsigned)h) << 16); }
__device__ __forceinline__ float sigmoid_f(float x) { return __builtin_amdgcn_rcpf(1.f + __builtin_amdgcn_exp2f(-x * LOG2E)); }
__device__ __forceinline__ float silu_f(float x) { return x * sigmoid_f(x); }

__device__ __forceinline__ int opaque_tid(int wv) { unsigned ones = ~0u; asm volatile("" : "+s"(ones)); int lane = __builtin_amdgcn_mbcnt_hi(ones, __builtin_amdgcn_mbcnt_lo(ones, 0u)); int t = (wv << 6) | lane; asm volatile("" : "+v"(t)); return t; }

template <int M> __device__ __forceinline__ float sx(float v, int lane) {
  if (M < 32) return __int_as_float(__builtin_amdgcn_ds_swizzle(__float_as_int(v), (M << 10) | 0x1f));
  else return __int_as_float(__builtin_amdgcn_ds_bpermute((lane ^ M) << 2, __float_as_int(v)));
}
__device__ __forceinline__ float wave_sum(float v, int lane) {
  v += sx<1>(v, lane); v += sx<2>(v, lane); v += sx<4>(v, lane); v += sx<8>(v, lane); v += sx<16>(v, lane); v += sx<32>(v, lane); return v;
}

struct WDesc { const float* src; u16* dst; const float* gain; int K; int N; int perm; int tile0; };

struct KArgs {
  const float *x, *mem, *rel_bias, *norm_mem, *norm_final;
  const float *da_lq1, *da_lk1, *da_lq2, *da_lk2, *da_subln;
  const float *hg_lb, *hg_onorm;
  const float *sg_vnorm, *sg_w_s, *sg_b_s;
  float* out; char* ws;
  WDesc wd[28];
  int nwd; int total_wtiles;
  int phase_lo, phase_hi;
};

constexpr size_t MIB = 1u << 20;
constexpr size_t OFF_XB = 0, OFF_RPART = OFF_XB + 64 * MIB, OFF_VPART = OFF_RPART + 2 * MIB, OFF_MEMN = OFF_VPART + 2 * MIB,
                 OFF_MEMK = OFF_MEMN + 2 * MIB, OFF_MEMVT = OFF_MEMK + 8 * MIB, OFF_LBV = OFF_MEMVT + 8 * MIB, OFF_BIAS = OFF_LBV + 4096,
                 OFF_B0 = OFF_BIAS + 4096, OFF_B1 = OFF_B0 + 64 * MIB, OFF_B2 = OFF_B1 + 64 * MIB, OFF_B3 = OFF_B2 + 64 * MIB,
                 OFF_B4 = OFF_B3 + 64 * MIB, OFF_DBUF = OFF_B4 + 32 * MIB, OFF_W = OFF_DBUF + 2 * MIB, OFF_BAR = OFF_W + 130 * MIB, WS_END = OFF_BAR + 16384;
__host__ __device__ __forceinline__ long layer_woff(int i) { return i == 0 ? 0L : (i == 1 ? 17039360L : (i == 2 ? 35127296L : 51118080L)); }
__host__ __device__ __forceinline__ long mixin_elems(int i) { int kind = i % 3; return kind == 0 ? 3145728L : (kind == 1 ? 4194304L : 2097152L); }

struct Params {
  const float *x, *mem, *rel_bias, *norm_mem, *norm_final;
  const float *da_lq1, *da_lk1, *da_lq2, *da_lk2, *da_subln;
  const float *hg_lb, *hg_onorm;
  const float *sg_vnorm, *sg_w_s, *sg_b_s;
  float* out;
  u16* xb; float* rpart; float* vpart; u16* memn; u16* memK; u16* memVT; float* lbv; float* biastab;
  u16 *B0, *B1, *B2, *B3, *B4; float* dbuf; u16* wbase;
};
typedef const KArgs __attribute__((address_space(4)))* KArgsP;
__device__ __forceinline__ KArgsP kargs_ptr() {
  KArgsP kp = (KArgsP)__builtin_amdgcn_kernarg_segment_ptr();
  asm volatile("" : "+s"(kp));
  return kp;
}
template <class KA>
__device__ __forceinline__ Params make_params(const KA& k) {
  Params p;
  p.x = k.x; p.mem = k.mem; p.rel_bias = k.rel_bias; p.norm_mem = k.norm_mem; p.norm_final = k.norm_final;
  p.da_lq1 = k.da_lq1; p.da_lk1 = k.da_lk1; p.da_lq2 = k.da_lq2; p.da_lk2 = k.da_lk2; p.da_subln = k.da_subln;
  p.hg_lb = k.hg_lb; p.hg_onorm = k.hg_onorm; p.sg_vnorm = k.sg_vnorm; p.sg_w_s = k.sg_w_s; p.sg_b_s = k.sg_b_s; p.out = k.out;
  char* ws = k.ws;
  p.xb = (u16*)(ws + OFF_XB); p.rpart = (float*)(ws + OFF_RPART); p.vpart = (float*)(ws + OFF_VPART); p.memn = (u16*)(ws + OFF_MEMN);
  p.memK = (u16*)(ws + OFF_MEMK); p.memVT = (u16*)(ws + OFF_MEMVT); p.lbv = (float*)(ws + OFF_LBV); p.biastab = (float*)(ws + OFF_BIAS);
  p.B0 = (u16*)(ws + OFF_B0); p.B1 = (u16*)(ws + OFF_B1); p.B2 = (u16*)(ws + OFF_B2); p.B3 = (u16*)(ws + OFF_B3); p.B4 = (u16*)(ws + OFF_B4);
  p.dbuf = (float*)(ws + OFF_DBUF); p.wbase = (u16*)(ws + OFF_W);
  return p;
}


constexpr int BM = 256, BK = 64, HALF = 128, HT = HALF * BK;

__device__ __forceinline__ int lds_byte(int r, int c) {
  int st = (r >> 4) * 2 + (c >> 5), rr = r & 15, cc = c & 31, ob = rr * 64 + cc * 2;
  return st * 1024 + (ob ^ (((ob >> 9) & 1) << 5));
}
__device__ __forceinline__ void stage_rc(int b, int& R, int& C) {
  int st = b / 1024, sb = b % 1024, swz = sb ^ (((sb >> 9) & 1) << 5);
  R = (st >> 1) * 16 + swz / 64; C = (st & 1) * 32 + (swz % 64) / 2;
}

template <class Epi>
__device__ __forceinline__ void gemm_tile(const u16* __restrict__ A, const u16* __restrict__ Bt, int K, int brow, int bcol,
                                          char* shmc, Epi& epi, int tr0, int fc0, bool sw, bool pre, bool has_next,
                                          const u16* __restrict__ nA, const u16* __restrict__ nBt, int nbrow, int nbcol, int wv) {
  u16* shm = (u16*)shmc;
  const int tx = opaque_tid(wv);
#define SA(b, h) (shm + ((b) * 2 + (h)) * HT)
#define SB(b, h) (shm + (4 + (b) * 2 + (h)) * HT)
#define STAGE(P, BASE, br, kt) do { int _so = ((br) * K + (kt) * BK) * 2; \
    __builtin_amdgcn_raw_ptr_buffer_load_lds(rs_##BASE, (__attribute__((address_space(3))) void*)((char*)(P) + tx * 16), 16, voff0, _so, 0, 0); \
    __builtin_amdgcn_raw_ptr_buffer_load_lds(rs_##BASE, (__attribute__((address_space(3))) void*)((char*)(P) + tx * 16 + 8192), 16, voff1, _so, 0, 0); } while (0)
#define LDA(dst, b, h) _Pragma("unroll") for (int m = 0; m < 4; ++m) _Pragma("unroll") for (int k = 0; k < 2; ++k) \
    dst[m][k] = *reinterpret_cast<const bf16x8*>((char*)SA(b, h) + lds_byte(wr * 64 + m * 16 + fr, k * 32 + fq * 8))
#define LDB(dst, b, h) _Pragma("unroll") for (int n = 0; n < 2; ++n) _Pragma("unroll") for (int k = 0; k < 2; ++k) \
    dst[n][k] = *reinterpret_cast<const bf16x8*>((char*)SB(b, h) + lds_byte(wc * 32 + n * 16 + fr, k * 32 + fq * 8))
#define MMA(ai, bj, At, Bt_) do { __builtin_amdgcn_s_setprio(1); \
    _Pragma("unroll") for (int m = 0; m < 4; ++m) _Pragma("unroll") for (int n = 0; n < 2; ++n) _Pragma("unroll") for (int k = 0; k < 2; ++k) \
      acc[ai][bj][m][n] = __builtin_amdgcn_mfma_f32_16x16x32_bf16(At[m][k], Bt_[n][k], acc[ai][bj][m][n], 0, 0, 0); \
    __builtin_amdgcn_s_setprio(0); } while (0)
#define WAIT_V(n) asm volatile("s_waitcnt vmcnt(" #n ")" ::: "memory")
#define WAIT_L(n) asm volatile("s_waitcnt lgkmcnt(" #n ")" ::: "memory")
#define BAR __builtin_amdgcn_s_barrier()
#define SCHED __builtin_amdgcn_sched_barrier(0)

  int wid = tx >> 6, lane = tx & 63, wr = wid >> 2, wc = wid & 3, fr = lane & 15, fq = lane >> 4;
  f32x4 acc[2][2][4][2] = {};
  bf16x8 At[4][2], B0[2][2], B1[2][2];
  int nt = K / BK;
  int voff0, voff1;
  { int _r, _c; stage_rc(tx * 16, _r, _c); voff0 = (_r * K + _c) * 2; stage_rc(tx * 16 + 8192, _r, _c); voff1 = (_r * K + _c) * 2; }
  __amdgpu_buffer_rsrc_t rs_A = __builtin_amdgcn_make_buffer_rsrc((void*)A, 0, 0x7fffffff, 0x00020000);
  __amdgpu_buffer_rsrc_t rs_Bt = __builtin_amdgcn_make_buffer_rsrc((void*)Bt, 0, 0x7fffffff, 0x00020000);
  if (!pre) {
    STAGE(SB(0, 0), Bt, bcol, 0); STAGE(SA(0, 0), A, brow, 0);
    STAGE(SB(0, 1), Bt, bcol + HALF, 0); STAGE(SA(0, 1), A, brow + HALF, 0);
  }
  if (wr == 1) BAR;
  if (pre) { WAIT_V(0); } else { WAIT_V(4); }
  BAR;
  STAGE(SB(1, 0), Bt, bcol, 1); STAGE(SA(1, 0), A, brow, 1); STAGE(SB(1, 1), Bt, bcol + HALF, 1);
  WAIT_V(6); BAR;
  for (int t = 0; t < nt - 2; t += 2) {
    LDB(B0, 0, 0); SCHED; LDA(At, 0, 0); STAGE(SA(1, 1), A, brow + HALF, t + 1);
    WAIT_L(8); BAR; WAIT_L(0); MMA(0, 0, At, B0); BAR; SCHED;
    LDB(B1, 0, 1); STAGE(SB(0, 0), Bt, bcol, t + 2);
    BAR; WAIT_L(0); MMA(0, 1, At, B1); BAR;
    LDA(At, 0, 1); STAGE(SA(0, 0), A, brow, t + 2);
    BAR; WAIT_L(0); MMA(1, 0, At, B0); BAR; SCHED;
    STAGE(SB(0, 1), Bt, bcol + HALF, t + 2);
    WAIT_V(6); BAR; MMA(1, 1, At, B1); BAR;
    LDB(B0, 1, 0); SCHED; LDA(At, 1, 0); STAGE(SA(0, 1), A, brow + HALF, t + 2);
    WAIT_L(8); BAR; WAIT_L(0); MMA(0, 0, At, B0); BAR; SCHED;
    LDB(B1, 1, 1); STAGE(SB(1, 0), Bt, bcol, t + 3);
    BAR; WAIT_L(0); MMA(0, 1, At, B1); BAR;
    LDA(At, 1, 1); STAGE(SA(1, 0), A, brow, t + 3);
    BAR; WAIT_L(0); MMA(1, 0, At, B0); BAR; SCHED;
    STAGE(SB(1, 1), Bt, bcol + HALF, t + 3);
    WAIT_V(6); BAR; MMA(1, 1, At, B1); BAR;
  }
  { LDB(B0, 0, 0); LDA(At, 0, 0); STAGE(SA(1, 1), A, brow + HALF, nt - 1);
    BAR; WAIT_L(0); MMA(0, 0, At, B0); BAR;
    LDB(B1, 0, 1); BAR; WAIT_L(0); MMA(0, 1, At, B1); BAR;
    LDA(At, 0, 1); WAIT_V(4); BAR; WAIT_L(0); MMA(1, 0, At, B0); MMA(1, 1, At, B1); BAR; }
  { LDB(B0, 1, 0); LDA(At, 1, 0); WAIT_V(2); BAR; WAIT_L(0); MMA(0, 0, At, B0); BAR;
    LDB(B1, 1, 1); WAIT_V(0); BAR; WAIT_L(0); MMA(0, 1, At, B1); BAR;
    LDA(At, 1, 1); BAR; WAIT_L(0); MMA(1, 0, At, B0); MMA(1, 1, At, B1); BAR; }
  if (wr == 0) BAR;
  if (has_next) {
    __amdgpu_buffer_rsrc_t rs_nA = __builtin_amdgcn_make_buffer_rsrc((void*)nA, 0, 0x7fffffff, 0x00020000);
    __amdgpu_buffer_rsrc_t rs_nBt = __builtin_amdgcn_make_buffer_rsrc((void*)nBt, 0, 0x7fffffff, 0x00020000);
    STAGE(SB(0, 0), nBt, nbcol, 0); STAGE(SA(0, 0), nA, nbrow, 0);
    STAGE(SB(0, 1), nBt, nbcol + HALF, 0); STAGE(SA(0, 1), nA, nbrow + HALF, 0);
  }
  {
    const int tx2 = opaque_tid(wv); const int wid2 = tx2 >> 6, lane2 = tx2 & 63;
    epi(acc, tr0, fc0, sw, wid2 >> 2, wid2 & 3, lane2 & 15, lane2 >> 4);
  }
  __syncthreads();
#undef SA
#undef SB
#undef STAGE
#undef LDA
#undef LDB
#undef MMA
}

template <class Epi>
__device__ __forceinline__ void gemm_phase(const u16* A, const u16* Bt, int M, int N, int K, char* shm, Epi& epi, int wv) {
  int nM = M / BM, nN = N / BM;
  int G = gridDim.x, bid = blockIdx.x;
  bool xmap = ((G & 7) == 0 && (nM & 63) == 0);
  int xcd = bid & 7, slot = bid >> 3, nslots = G >> 3, gpx = nM / 64;
  int first = xmap ? slot : bid, step = xmap ? nslots : G, total = xmap ? gpx * 8 * nN : nM * nN;
  auto coords = [&](int L, int& tr0, int& fc0) {
    if (xmap) { int grp = xcd * gpx + L / (8 * nN), within = L % (8 * nN); tr0 = (grp * 8 + (within & 7)) * BM; fc0 = (within >> 3) * BM; }
    else { tr0 = (L % nM) * BM; fc0 = (L / nM) * BM; }
  };
  bool pre = false;
  for (int L = first; L < total; L += step) {
    int tr0, fc0, ntr0 = 0, nfc0 = 0;
    coords(L, tr0, fc0);
    bool hn = (L + step) < total;
    if (hn) coords(L + step, ntr0, nfc0);
    bool sw = epi.swap(fc0), nsw = epi.swap(nfc0);
    gemm_tile(sw ? Bt : A, sw ? A : Bt, K, sw ? fc0 : tr0, sw ? tr0 : fc0, shm, epi, tr0, fc0, sw, pre, hn,
              nsw ? Bt : A, nsw ? A : Bt, nsw ? nfc0 : ntr0, nsw ? ntr0 : nfc0, wv);
    pre = hn;
  }
}

__device__ __forceinline__ float row_rs(const float* part, int row) {
  const float4* q = (const float4*)(part + (long)row * 16);
  float4 a = q[0], b = q[1], c = q[2], d = q[3];
  float s = ((a.x + a.y) + (a.z + a.w)) + ((b.x + b.y) + (b.z + b.w)) + ((c.x + c.y) + (c.z + c.w)) + ((d.x + d.y) + (d.z + d.w));
  return rsqrtf(s * (1.f / DM) + EPS);
}
#define EPI_ARGS f32x4 (&acc)[2][2][4][2], int tr0, int fc0, bool sw, int wr, int wc, int fr, int fq
#define S_FEAT(ai, m) (fc0 + (ai) * 128 + wr * 64 + (m) * 16 + fq * 4)
#define S_TOK(bj, n) (tr0 + (bj) * 128 + wc * 32 + (n) * 16 + fr)
#define U_TOK(ai, m) (tr0 + (ai) * 128 + wr * 64 + (m) * 16 + fq * 4)
#define U_FEAT(bj, n) (fc0 + (bj) * 128 + wc * 32 + (n) * 16 + fr)

__device__ __forceinline__ uint2 pack4(float a, float b, float c, float d) { uint2 r; r.x = pk2(a, b); r.y = pk2(c, d); return r; }

struct EpiRes {
  u16* xb; float* part;
  __device__ __forceinline__ bool swap(int) const { return true; }
  __device__ __forceinline__ void operator()(EPI_ARGS) {
    _Pragma("unroll") for (int bj = 0; bj < 2; ++bj) _Pragma("unroll") for (int n = 0; n < 2; ++n) {
      int t = S_TOK(bj, n); float ss = 0.f;
      u16* xbp = xb + (long)t * DM;
      _Pragma("unroll") for (int ai = 0; ai < 2; ++ai) _Pragma("unroll") for (int m = 0; m < 4; ++m) {
        int f = S_FEAT(ai, m); f32x4 a = acc[ai][bj][m][n];
        uint2 xv = *(const uint2*)(xbp + f);
        float v0 = __uint_as_float(xv.x << 16) + a[0], v1 = __uint_as_float(xv.x & 0xffff0000u) + a[1];
        float v2 = __uint_as_float(xv.y << 16) + a[2], v3 = __uint_as_float(xv.y & 0xffff0000u) + a[3];
        *(uint2*)(xbp + f) = pack4(v0, v1, v2, v3);
        ss += v0 * v0 + v1 * v1 + v2 * v2 + v3 * v3;
      }
      ss += sx<16>(ss, fq * 16 + fr); ss += sx<32>(ss, fq * 16 + fr);
      if (fq == 0) part[(long)t * 16 + (fc0 >> 8) * 4 + wr] = ss;
      __builtin_amdgcn_sched_barrier(0);
    }
  }
};

struct EpiDaIn {
  const float* rowss; u16 *q, *k, *vT;
  __device__ __forceinline__ bool swap(int fc0) const { return (fc0 >> 10) < 2; }
  __device__ __forceinline__ void operator()(EPI_ARGS) {
    int sect = fc0 >> 10, cb = fc0 & 1023;
    if (sw) {
      u16* dst = sect ? k : q;
      _Pragma("unroll") for (int bj = 0; bj < 2; ++bj) _Pragma("unroll") for (int n = 0; n < 2; ++n) {
        int t = S_TOK(bj, n); float rs = row_rs(rowss, t); u16* d = dst + (long)t * DM + (cb - fc0);
        _Pragma("unroll") for (int ai = 0; ai < 2; ++ai) _Pragma("unroll") for (int m = 0; m < 4; ++m) {
          f32x4 a = acc[ai][bj][m][n]; *(uint2*)(d + S_FEAT(ai, m)) = pack4(a[0] * rs, a[1] * rs, a[2] * rs, a[3] * rs);
        }
      }
    } else {
      _Pragma("unroll") for (int ai = 0; ai < 2; ++ai) _Pragma("unroll") for (int m = 0; m < 4; ++m) {
        int r0 = U_TOK(ai, m); float rs[4];
        _Pragma("unroll") for (int j = 0; j < 4; ++j) rs[j] = row_rs(rowss, r0 + j);
        int b = r0 / SEQ, s0 = r0 % SEQ;
        _Pragma("unroll") for (int bj = 0; bj < 2; ++bj) _Pragma("unroll") for (int n = 0; n < 2; ++n) {
          int c = U_FEAT(bj, n) - fc0 + cb; f32x4 a = acc[ai][bj][m][n];
          *(uint2*)&vT[((long)(b * DM + c)) * SEQ + s0] = pack4(a[0] * rs[0], a[1] * rs[1], a[2] * rs[2], a[3] * rs[3]);
        }
        __builtin_amdgcn_sched_barrier(0);
      }
    }
  }
};

struct EpiHgIn {
  const float* rowss; const float* lbv; u16 *q, *logf_, *iT, *g;
  __device__ __forceinline__ bool swap(int fc0) const { return (fc0 >> 10) != 2; }
  __device__ __forceinline__ void operator()(EPI_ARGS) {
    int sect = fc0 >> 10, cb = fc0 & 1023;
    if (sw) {
      u16* dst = q + (long)sect * (32L << 20);
      _Pragma("unroll") for (int bj = 0; bj < 2; ++bj) _Pragma("unroll") for (int n = 0; n < 2; ++n) {
        int t = S_TOK(bj, n); float rs = row_rs(rowss, t); u16* d = dst + (long)t * DM + (cb - fc0);
        _Pragma("unroll") for (int ai = 0; ai < 2; ++ai) _Pragma("unroll") for (int m = 0; m < 4; ++m) {
          int f = S_FEAT(ai, m); f32x4 a = acc[ai][bj][m][n]; float v[4];
          if (sect == 0) { _Pragma("unroll") for (int j = 0; j < 4; ++j) v[j] = silu_f(a[j] * rs); }
          else if (sect == 1) {
            float4 lb = *(const float4*)&lbv[f - fc0 + cb]; float lbs[4] = {lb.x, lb.y, lb.z, lb.w};
            _Pragma("unroll") for (int j = 0; j < 4; ++j) v[j] = __logf(lbs[j] + (1.f - lbs[j]) * sigmoid_f(a[j] * rs));
          } else { _Pragma("unroll") for (int j = 0; j < 4; ++j) v[j] = a[j] * rs; }
          *(uint2*)(d + f) = pack4(v[0], v[1], v[2], v[3]);
        }
      }
    } else {
      _Pragma("unroll") for (int ai = 0; ai < 2; ++ai) _Pragma("unroll") for (int m = 0; m < 4; ++m) {
        int r0 = U_TOK(ai, m); float rs[4];
        _Pragma("unroll") for (int j = 0; j < 4; ++j) rs[j] = row_rs(rowss, r0 + j);
        _Pragma("unroll") for (int bj = 0; bj < 2; ++bj) _Pragma("unroll") for (int n = 0; n < 2; ++n) {
          int c = U_FEAT(bj, n) - fc0 + cb; f32x4 a = acc[ai][bj][m][n];
          *(uint2*)&iT[((long)(r0 >> 6) * DM + c) * 64 + (r0 & 63)] = pack4(a[0] * rs[0], a[1] * rs[1], a[2] * rs[2], a[3] * rs[3]);
        }
        __builtin_amdgcn_sched_barrier(0);
      }
    }
  }
};

__device__ __forceinline__ float gelu_f(float x) { return 0.5f * x * (1.f + erff(x * 0.70710678118654752f)); }

struct EpiSgIn {
  const float* rowss; u16 *u, *vT; float* rowss_v;
  __device__ __forceinline__ bool swap(int fc0) const { return (fc0 >> 10) == 0; }
  __device__ __forceinline__ void operator()(EPI_ARGS) {
    int cb = fc0 & 1023;
    if (sw) {
      _Pragma("unroll") for (int bj = 0; bj < 2; ++bj) _Pragma("unroll") for (int n = 0; n < 2; ++n) {
        int t = S_TOK(bj, n); float rs = row_rs(rowss, t); u16* d = u + (long)t * DM;
        _Pragma("unroll") for (int ai = 0; ai < 2; ++ai) _Pragma("unroll") for (int m = 0; m < 4; ++m) {
          f32x4 a = acc[ai][bj][m][n];
          *(uint2*)(d + S_FEAT(ai, m)) = pack4(gelu_f(a[0] * rs), gelu_f(a[1] * rs), gelu_f(a[2] * rs), gelu_f(a[3] * rs));
        }
      }
    } else {
      _Pragma("unroll") for (int ai = 0; ai < 2; ++ai) _Pragma("unroll") for (int m = 0; m < 4; ++m) {
        int r0 = U_TOK(ai, m); float rs[4], ss[4] = {0.f, 0.f, 0.f, 0.f};
        _Pragma("unroll") for (int j = 0; j < 4; ++j) rs[j] = row_rs(rowss, r0 + j);
        _Pragma("unroll") for (int bj = 0; bj < 2; ++bj) _Pragma("unroll") for (int n = 0; n < 2; ++n) {
          int c = U_FEAT(bj, n) - fc0 + cb; f32x4 a = acc[ai][bj][m][n];
          float gv[4]; _Pragma("unroll") for (int j = 0; j < 4; ++j) gv[j] = gelu_f(a[j] * rs[j]);
          *(uint2*)&vT[((long)(r0 >> 7) * DM + c) * 128 + (r0 & 127)] = pack4(gv[0], gv[1], gv[2], gv[3]);
          _Pragma("unroll") for (int j = 0; j < 4; ++j) ss[j] += gv[j] * gv[j];
        }
        _Pragma("unroll") for (int j = 0; j < 4; ++j) {
          float s = ss[j]; s += sx<1>(s, 0); s += sx<2>(s, 0); s += sx<4>(s, 0); s += sx<8>(s, 0);
          if (fr == 0) rowss_v[(long)(r0 + j) * 16 + (cb >> 8) * 4 + wc] = s;
        }
        __builtin_amdgcn_sched_barrier(0);
      }
    }
  }
};

struct EpiStore {
  const float* rowss; u16* dst; int ld;
  __device__ __forceinline__ bool swap(int) const { return true; }
  __device__ __forceinline__ void operator()(EPI_ARGS) {
    _Pragma("unroll") for (int bj = 0; bj < 2; ++bj) _Pragma("unroll") for (int n = 0; n < 2; ++n) {
      int t = S_TOK(bj, n); float rs = rowss ? row_rs(rowss, t) : 1.f; u16* d = dst + (long)t * ld;
      _Pragma("unroll") for (int ai = 0; ai < 2; ++ai) _Pragma("unroll") for (int m = 0; m < 4; ++m) {
        f32x4 a = acc[ai][bj][m][n]; *(uint2*)(d + S_FEAT(ai, m)) = pack4(a[0] * rs, a[1] * rs, a[2] * rs, a[3] * rs);
      }
    }
  }
};

struct EpiFfn {
  const float* rowss; u16* act;
  __device__ __forceinline__ bool swap(int) const { return true; }
  __device__ __forceinline__ void operator()(EPI_ARGS) {
    int tile = fc0 >> 8;
    _Pragma("unroll") for (int bj = 0; bj < 2; ++bj) _Pragma("unroll") for (int n = 0; n < 2; ++n) {
      int t = S_TOK(bj, n); float rs = row_rs(rowss, t); u16* d = act + (long)t * DFF + tile * 128 + wr * 64 + fq * 4;
      _Pragma("unroll") for (int m = 0; m < 4; ++m) {
        f32x4 g = acc[0][bj][m][n], u = acc[1][bj][m][n]; float v[4];
        _Pragma("unroll") for (int j = 0; j < 4; ++j) v[j] = silu_f(g[j] * rs) * (u[j] * rs);
        *(uint2*)(d + m * 16) = pack4(v[0], v[1], v[2], v[3]);
      }
    }
  }
};

struct EpiMemKV {
  u16 *K, *VT;
  __device__ __forceinline__ bool swap(int fc0) const { return (fc0 >> 10) == 0; }
  __device__ __forceinline__ void operator()(EPI_ARGS) {
    int cb = fc0 & 1023;
    if (sw) {
      _Pragma("unroll") for (int bj = 0; bj < 2; ++bj) _Pragma("unroll") for (int n = 0; n < 2; ++n) {
        int t = S_TOK(bj, n); u16* d = K + (long)t * DM;
        _Pragma("unroll") for (int ai = 0; ai < 2; ++ai) _Pragma("unroll") for (int m = 0; m < 4; ++m) {
          f32x4 a = acc[ai][bj][m][n]; *(uint2*)(d + S_FEAT(ai, m)) = pack4(a[0], a[1], a[2], a[3]);
        }
      }
    } else {
      _Pragma("unroll") for (int ai = 0; ai < 2; ++ai) _Pragma("unroll") for (int m = 0; m < 4; ++m) {
        int r0 = U_TOK(ai, m);
        _Pragma("unroll") for (int bj = 0; bj < 2; ++bj) _Pragma("unroll") for (int n = 0; n < 2; ++n) {
          int c = U_FEAT(bj, n) - fc0 + cb; f32x4 a = acc[ai][bj][m][n];
          *(uint2*)&VT[((long)((r0 >> 8) * DM + c)) * MEML + (r0 & 255)] = pack4(a[0], a[1], a[2], a[3]);
        }
      }
    }
  }
};

__device__ __forceinline__ void prep_phase(const Params& p, KArgsP kap, char* shm, int wv) {
  int tid = opaque_tid(wv), bid = blockIdx.x, G = gridDim.x;
  int lane = tid & 63, wid = tid >> 6;
  for (int row = bid * 8 + wid; row < T_TOK; row += G * 8) {
    const float4* src = (const float4*)(p.x + (long)row * DM);
    float ss = 0.f;
    _Pragma("unroll") for (int i = 0; i < 4; ++i) {
      float4 v = src[i * 64 + lane];
      ss += v.x * v.x + v.y * v.y + v.z * v.z + v.w * v.w;
      *(uint2*)&p.xb[(long)row * DM + (i * 64 + lane) * 4] = pack4(v.x, v.y, v.z, v.w);
    }
    ss = wave_sum(ss, lane);
    if (lane < 16) p.rpart[(long)row * 16 + lane] = (lane == 0) ? ss : 0.f;
  }
  for (int row = bid * 8 + wid; row < NB * MEML; row += G * 8) {
    const float4* src = (const float4*)(p.mem + (long)row * DM);
    float4 v[4]; float ss = 0.f;
    _Pragma("unroll") for (int i = 0; i < 4; ++i) { v[i] = src[i * 64 + lane]; ss += v[i].x * v[i].x + v[i].y * v[i].y + v[i].z * v[i].z + v[i].w * v[i].w; }
    ss = wave_sum(ss, lane);
    float rs = rsqrtf(ss * (1.f / DM) + EPS);
    _Pragma("unroll") for (int i = 0; i < 4; ++i) {
      float4 g = ((const float4*)p.norm_mem)[i * 64 + lane];
      *(uint2*)&p.memn[(long)row * DM + (i * 64 + lane) * 4] = pack4(v[i].x * rs * g.x, v[i].y * rs * g.y, v[i].z * rs * g.z, v[i].w * rs * g.w);
    }
  }
  if (bid == 0) {
    for (int i = tid; i < 3456; i += 512) ((unsigned*)((char*)p.xb - OFF_XB + OFF_BAR))[i] = 0u;
    for (int c = tid; c < DM; c += 512) {
      float v0 = p.hg_lb[c], v1 = p.hg_lb[DM + c], v2 = p.hg_lb[2 * DM + c], v3 = p.hg_lb[3 * DM + c];
      float mx = fmaxf(fmaxf(v0, v1), fmaxf(v2, v3));
      float e0 = expf(v0 - mx), e1 = expf(v1 - mx), e2 = expf(v2 - mx), e3 = expf(v3 - mx);
      p.lbv[c] = e1 / (e0 + e1 + e2 + e3);
    }
    for (int i = tid; i < 8 * 128; i += 512) {
      int h = i >> 7, n = i & 127, bucket;
      if (n < 16) bucket = n;
      else { float nf = (float)n; int lg = 16 + (int)(logf(nf / 16.f) / 2.0794415416798357f * 16.f); bucket = lg < 31 ? lg : 31; }
      p.biastab[i] = p.rel_bias[h * 32 + bucket] * LOG2E;
    }
  }
  float* tl = (float*)shm;
  for (int t = bid; t < kap->total_wtiles; t += G) {
    int wi = 0;
    while (wi + 1 < kap->nwd && kap->wd[wi + 1].tile0 <= t) ++wi;
    const float* src = kap->wd[wi].src; u16* dst = kap->wd[wi].dst; const float* gain = kap->wd[wi].gain;
    int K = kap->wd[wi].K, N = kap->wd[wi].N, perm = kap->wd[wi].perm;
    int lt = t - kap->wd[wi].tile0, nNt = N >> 6;
    int k0 = (lt / nNt) * 64, n0 = (lt % nNt) * 64;
    {
      int kk = tid >> 3, seg = (tid & 7) * 8;
      const float4* s4 = (const float4*)(src + (long)(k0 + kk) * N + n0 + seg);
      float4 a = s4[0], b = s4[1]; float g = gain ? gain[k0 + kk] : 1.f;
      float* d = tl + kk * 65 + seg;
      d[0] = a.x * g; d[1] = a.y * g; d[2] = a.z * g; d[3] = a.w * g; d[4] = b.x * g; d[5] = b.y * g; d[6] = b.z * g; d[7] = b.w * g;
    }
    __syncthreads();
    {
      int nn = tid >> 3, seg = (tid & 7) * 8;
      int n = n0 + nn, drow = n;
      if (perm) { int part = n / DFF, idx = n % DFF; drow = (idx >> 7) * 256 + part * 128 + (idx & 127); }
      float v[8]; _Pragma("unroll") for (int i = 0; i < 8; ++i) v[i] = tl[(seg + i) * 65 + nn];
      uint4 o; uint2 lo = pack4(v[0], v[1], v[2], v[3]), hi = pack4(v[4], v[5], v[6], v[7]);
      o.x = lo.x; o.y = lo.y; o.z = hi.x; o.w = hi.y;
      *(uint4*)&dst[(long)drow * K + k0 + seg] = o;
    }
    __syncthreads();
  }
}

template <int NC, int DQK, int DV, bool CAUSAL, bool PF>
__device__ __forceinline__ void flash_item(const u16* __restrict__ Qg, int q_stride, const u16* __restrict__ Kg, int k_stride,
                                           const u16* __restrict__ VTg, int vt_stride, int nkt, int q0, float scale_log2,
                                           const float* btab, float lam, const float* subln_g, float outscale,
                                           u16* __restrict__ Og, int o_stride, char* shm, int wv) {
  constexpr int KW = NC * DQK, KLD = KW + 8, VLD = 72;
  constexpr int KBUF = 64 * KLD, VBUF = DV * VLD;
  constexpr int KCH = KW / 8, KPT = 64 * KCH / 512, VPT = DV * 8 / 512;
  constexpr int NKS = DQK / 32, NVT = DV / 16;
  u16* Ks = (u16*)shm; u16* Vs = Ks + 2 * KBUF;
  int tid = opaque_tid(wv), wid = tid >> 6, lane = tid & 63, fr = lane & 15, fq = lane >> 4;
  int qw0 = q0 + wid * 16, qpos = qw0 + fr;

  bf16x8 qf[NC][NKS];
  _Pragma("unroll") for (int c = 0; c < NC; ++c) _Pragma("unroll") for (int ks = 0; ks < NKS; ++ks)
    qf[c][ks] = *(const bf16x8*)&Qg[(long)(wid * 16 + fr) * q_stride + c * DQK + ks * 32 + fq * 8];
  f32x4 O[NC][NVT];
  _Pragma("unroll") for (int c = 0; c < NC; ++c) _Pragma("unroll") for (int v = 0; v < NVT; ++v) O[c][v] = f32x4{0.f, 0.f, 0.f, 0.f};
  float mrun[NC], lsum[NC];
  _Pragma("unroll") for (int c = 0; c < NC; ++c) { mrun[c] = -1e30f; lsum[c] = 0.f; }

  u32x4 kreg[KPT], vreg[VPT];
#define FA_PREFETCH(kt_) do { int k0_ = (kt_) * 64; \
    _Pragma("unroll") for (int i = 0; i < KPT; ++i) { int id = tid + i * 512, row = id / KCH, cc = id % KCH; kreg[i] = *(const u32x4*)&Kg[(long)(k0_ + row) * k_stride + cc * 8]; } \
    _Pragma("unroll") for (int i = 0; i < VPT; ++i) { int id = tid + i * 512, row = id >> 3, cc = id & 7; vreg[i] = *(const u32x4*)&VTg[(long)row * vt_stride + k0_ + cc * 8]; } } while (0)
  if (PF) FA_PREFETCH(0);
  for (int kt = 0; kt < nkt; ++kt) {
    if (!PF) FA_PREFETCH(kt);
    u16* Kb = Ks + (kt & 1) * KBUF; u16* Vb = Vs + (kt & 1) * VBUF;
    _Pragma("unroll") for (int i = 0; i < KPT; ++i) { int id = tid + i * 512, row = id / KCH, cc = id % KCH; *(u32x4*)&Kb[row * KLD + cc * 8] = kreg[i]; }
    _Pragma("unroll") for (int i = 0; i < VPT; ++i) {
      int id = tid + i * 512, row = id >> 3, cc = id & 7;
      int pos = 32 * (cc >> 2) + 16 * (cc & 1) + 4 * ((cc >> 1) & 1);
      uint2 lo2, hi2; lo2.x = vreg[i][0]; lo2.y = vreg[i][1]; hi2.x = vreg[i][2]; hi2.y = vreg[i][3];
      *(uint2*)&Vb[row * VLD + pos] = lo2; *(uint2*)&Vb[row * VLD + pos + 8] = hi2;
    }
    __syncthreads();
    if (PF && kt + 1 < nkt) FA_PREFETCH(kt + 1);
    int k0 = kt * 64;
    if (CAUSAL && k0 > qw0 + 15) continue;
    bf16x8 pf[NC][2];
    _Pragma("unroll") for (int c = 0; c < NC; ++c) {
      f32x4 s[4];
      _Pragma("unroll") for (int m = 0; m < 4; ++m) s[m] = f32x4{0.f, 0.f, 0.f, 0.f};
      _Pragma("unroll") for (int ks = 0; ks < NKS; ++ks) _Pragma("unroll") for (int m = 0; m < 4; ++m) {
        bf16x8 a = *(const bf16x8*)&Kb[(16 * m + fr) * KLD + c * DQK + ks * 32 + fq * 8];
        s[m] = __builtin_amdgcn_mfma_f32_16x16x32_bf16(a, qf[c][ks], s[m], 0, 0, 0);
      }
      bool general = false; float bb = 0.f;
      if (CAUSAL) { general = (qw0 - (k0 + 63)) < 128; bb = btab[127]; }
      float mnew, alpha, psum = 0.f;
      if (general) {
        bool diag = (k0 + 63) > qw0; float tmax = -1e30f;
        _Pragma("unroll") for (int m = 0; m < 4; ++m) _Pragma("unroll") for (int j = 0; j < 4; ++j) {
          int dist = qpos - (k0 + 16 * m + fq * 4 + j);
          int di = dist < 0 ? 0 : (dist > 127 ? 127 : dist);
          float v = s[m][j] * scale_log2 + btab[di];
          if (diag && dist < 0) v = -1e30f;
          s[m][j] = v; tmax = fmaxf(tmax, v);
        }
        tmax = fmaxf(tmax, sx<16>(tmax, lane)); tmax = fmaxf(tmax, sx<32>(tmax, lane));
        mnew = fmaxf(mrun[c], tmax);
        _Pragma("unroll") for (int m = 0; m < 4; ++m) _Pragma("unroll") for (int j = 0; j < 4; ++j) { float pv = __builtin_amdgcn_exp2f(s[m][j] - mnew); s[m][j] = pv; psum += pv; }
      } else {
        float rmax = fmaxf(fmaxf(s[0][0], s[0][1]), fmaxf(s[0][2], s[0][3]));
        _Pragma("unroll") for (int m = 1; m < 4; ++m) rmax = fmaxf(rmax, fmaxf(fmaxf(s[m][0], s[m][1]), fmaxf(s[m][2], s[m][3])));
        rmax = fmaxf(rmax, sx<16>(rmax, lane)); rmax = fmaxf(rmax, sx<32>(rmax, lane));
        mnew = fmaxf(mrun[c], rmax * scale_log2 + bb);
        float cc = bb - mnew;
        _Pragma("unroll") for (int m = 0; m < 4; ++m) _Pragma("unroll") for (int j = 0; j < 4; ++j) { float pv = __builtin_amdgcn_exp2f(s[m][j] * scale_log2 + cc); s[m][j] = pv; psum += pv; }
      }
      alpha = __builtin_amdgcn_exp2f(mrun[c] - mnew);
      mrun[c] = mnew;
      lsum[c] = lsum[c] * alpha + psum;
      if (__builtin_amdgcn_ballot_w64(alpha != 1.f) != 0ull) {
        _Pragma("unroll") for (int v = 0; v < NVT; ++v) _Pragma("unroll") for (int j = 0; j < 4; ++j) O[c][v][j] *= alpha;
      }
      _Pragma("unroll") for (int k2 = 0; k2 < 2; ++k2) {
        uint2 lo = pack4(s[2 * k2][0], s[2 * k2][1], s[2 * k2][2], s[2 * k2][3]);
        uint2 hi = pack4(s[2 * k2 + 1][0], s[2 * k2 + 1][1], s[2 * k2 + 1][2], s[2 * k2 + 1][3]);
        uint4 pk; pk.x = lo.x; pk.y = lo.y; pk.z = hi.x; pk.w = hi.y;
        pf[c][k2] = *(bf16x8*)&pk;
      }
    }
    _Pragma("unroll") for (int k2 = 0; k2 < 2; ++k2) _Pragma("unroll") for (int v = 0; v < NVT; ++v) {
      bf16x8 a = *(const bf16x8*)&Vb[(16 * v + fr) * VLD + 32 * k2 + fq * 8];
      _Pragma("unroll") for (int c = 0; c < NC; ++c) O[c][v] = __builtin_amdgcn_mfma_f32_16x16x32_bf16(a, pf[c][k2], O[c][v], 0, 0, 0);
      if ((v & 3) == 3) __builtin_amdgcn_sched_barrier(0);
    }
  }
  float inv[NC];
  _Pragma("unroll") for (int c = 0; c < NC; ++c) { float l = lsum[c]; l += sx<16>(l, lane); l += sx<32>(l, lane); inv[c] = 1.f / l; }
  u16* orow = Og + (long)(wid * 16 + fr) * o_stride;
  if (NC == 2) {
    float ss = 0.f;
    _Pragma("unroll") for (int v = 0; v < NVT; ++v) _Pragma("unroll") for (int j = 0; j < 4; ++j) { float o = O[0][v][j] * inv[0] - lam * O[NC - 1][v][j] * inv[NC - 1]; O[0][v][j] = o; ss += o * o; }
    ss += sx<16>(ss, lane); ss += sx<32>(ss, lane);
    float rs = rsqrtf(ss * (1.f / DV) + EPS) * outscale;
    _Pragma("unroll") for (int v = 0; v < NVT; ++v) {
      float4 g = *(const float4*)&subln_g[16 * v + fq * 4];
      *(uint2*)&orow[16 * v + fq * 4] = pack4(O[0][v][0] * rs * g.x, O[0][v][1] * rs * g.y, O[0][v][2] * rs * g.z, O[0][v][3] * rs * g.w);
    }
  } else {
    _Pragma("unroll") for (int v = 0; v < NVT; ++v)
      *(uint2*)&orow[16 * v + fq * 4] = pack4(O[0][v][0] * inv[0], O[0][v][1] * inv[0], O[0][v][2] * inv[0], O[0][v][3] * inv[0]);
  }
}

__device__ __forceinline__ void diff_attn_phase(const Params& p, int j, int layer_idx, char* shm, int wv) {
  int tid = opaque_tid(wv), lane = tid & 63;
  float* btab = (float*)(shm + LDS_BYTES - 1024);
  float sa = p.da_lq1[j * 64 + lane] * p.da_lk1[j * 64 + lane], sb = p.da_lq2[j * 64 + lane] * p.da_lk2[j * 64 + lane];
  sa = wave_sum(sa, lane); sb = wave_sum(sb, lane);
  float lam_init = 0.8f - 0.6f * expf(-0.3f * (float)layer_idx);
  float lam = expf(sa) - expf(sb) + lam_init;
  const u16 *qb = p.B0, *kb = p.B1, *vT = p.B2; u16* ao = p.B3;
  for (int i = blockIdx.x; i < 2048; i += gridDim.x) {
    int wgl = i & 255, step = i >> 8, xcd = wgl & 7, slot = wgl >> 3;
    int bh = xcd + 8 * (step >> 1), qblk = (step & 1) ? 63 - slot : slot;
    int b = bh >> 3, h = bh & 7, q0 = qblk * 128;
    __syncthreads();
    if (tid < 128) btab[tid] = p.biastab[h * 128 + tid];
    flash_item<2, 64, 128, true, true>(qb + ((long)(b * SEQ + q0)) * DM + h * 128, DM, kb + ((long)b * SEQ) * DM + h * 128, DM,
                                 vT + ((long)(b * DM + h * 128)) * SEQ, SEQ, q0 / 64 + 2, q0, 0.125f * LOG2E, btab, lam,
                                 p.da_subln + j * 128, 1.f - lam_init, ao + ((long)(b * SEQ + q0)) * DM + h * 128, DM, shm, wv);
  }
}

__device__ __forceinline__ void cross_attn_phase(const Params& p, int layer, char* shm, int wv) {
  const u16* caq = p.B0; u16* cao = p.B1;
  const u16* mK = p.memK + (long)layer * NB * MEML * DM; const u16* mVT = p.memVT + (long)layer * NB * DM * MEML;
  for (int i = blockIdx.x; i < 1024; i += gridDim.x) {
    int head = i & 3, blk = i >> 2, b = blk >> 6, qblk = blk & 63;
    __syncthreads();
    flash_item<1, 256, 256, false, true>(caq + ((long)(b * SEQ + qblk * 128)) * DM + head * 256, DM, mK + ((long)b * MEML) * DM + head * 256, DM,
                                   mVT + ((long)(b * DM + head * 256)) * MEML, MEML, 4, 0, 0.0625f * LOG2E, nullptr, 0.f, nullptr, 1.f,
                                   cao + ((long)(b * SEQ + qblk * 128)) * DM + head * 256, DM, shm, wv);
  }
}

constexpr int HLD = 132;
__device__ __forceinline__ long kdt_off(int tok0, int h, int k) {
  return ((long)(tok0 + (k >> 1)) * DM + h * 128) + (k & 1) * 64;
}

__device__ __forceinline__ void hg1_phase(const Params& p, char* shm, int wv) {
  float* L = (float*)shm; float* Gs = L + 64 * HLD; float* Qs = Gs + 64 * HLD; float* R = Qs + 64 * HLD;
  int tid = opaque_tid(wv), wid = tid >> 6, lane = tid & 63, fr = lane & 15, fq = lane >> 4;
  u16* qbuf = p.B0; u16* lfbuf = p.B1; u16* Abuf = p.B4;
  u32x4 plv[2], pqv[2];
#define HG1_PREFETCH(it_) do { int h_ = (it_) & 7, cn_ = ((it_) >> 3) & 127, b_ = (it_) >> 10, tk_ = b_ * SEQ + cn_ * 64; \
    _Pragma("unroll") for (int i = 0; i < 2; ++i) { int id = tid + i * 512, row = id >> 4, cc = id & 15; \
      plv[i] = *(const u32x4*)&lfbuf[(long)(tk_ + row) * DM + h_ * 128 + cc * 8]; pqv[i] = *(const u32x4*)&qbuf[(long)(tk_ + row) * DM + h_ * 128 + cc * 8]; } } while (0)
  if ((int)blockIdx.x < 4096) HG1_PREFETCH((int)blockIdx.x);
  for (int it = blockIdx.x; it < 4096; it += gridDim.x) {
    int h = it & 7, cn = (it >> 3) & 127, b = it >> 10, tok0 = b * SEQ + cn * 64;
    __syncthreads();
    _Pragma("unroll") for (int i = 0; i < 2; ++i) {
      int id = tid + i * 512, row = id >> 4, cc = id & 15;
      _Pragma("unroll") for (int e = 0; e < 4; ++e) {
        unsigned lw = plv[i][e], qw = pqv[i][e];
        L[row * HLD + cc * 8 + 2 * e] = __uint_as_float(lw << 16); L[row * HLD + cc * 8 + 2 * e + 1] = __uint_as_float(lw & 0xffff0000u);
        Qs[row * HLD + cc * 8 + 2 * e] = __uint_as_float(qw << 16); Qs[row * HLD + cc * 8 + 2 * e + 1] = __uint_as_float(qw & 0xffff0000u);
      }
    }
    __syncthreads();
    if (it + (int)gridDim.x < 4096) HG1_PREFETCH(it + (int)gridDim.x);
    {
      int k = tid & 127, qd = tid >> 7; float run = 0.f;
      _Pragma("unroll") for (int i = 0; i < 16; ++i) { run += L[(16 * qd + i) * HLD + k]; Gs[(16 * qd + i) * HLD + k] = run; }
      R[(qd + 1) * 128 + k] = run;
    }
    __syncthreads();
    {
      int k = tid & 127, qd = tid >> 7; float r = 0.f;
      for (int i = 0; i < qd; ++i) r += R[(i + 1) * 128 + k];
      float tot = R[(qd + 1) * 128 + k];
      __syncthreads();
      _Pragma("unroll") for (int i = 0; i < 16; ++i) Gs[(16 * qd + i) * HLD + k] += r;
      R[qd * 128 + k] = r;
      if (qd == 3) R[4 * 128 + k] = r + tot;
    }
    __syncthreads();
    _Pragma("unroll") for (int i = 0; i < 2; ++i) {
      int id = tid + i * 512, row = id >> 4, cc = id & 15; float v[8];
      _Pragma("unroll") for (int e = 0; e < 8; ++e) v[e] = Qs[row * HLD + cc * 8 + e] * __expf(Gs[row * HLD + cc * 8 + e]);
      uint2 lo = pack4(v[0], v[1], v[2], v[3]), hi = pack4(v[4], v[5], v[6], v[7]);
      uint4 o; o.x = lo.x; o.y = lo.y; o.z = hi.x; o.w = hi.y;
      *(uint4*)&qbuf[(long)(tok0 + row) * DM + h * 128 + cc * 8] = o;
    }
    _Pragma("unroll") for (int i = 0; i < 2; ++i) {
      int id = tid + i * 512, k = id & 127, sc = id >> 7; float gl = R[4 * 128 + k]; float v[8];
      _Pragma("unroll") for (int e = 0; e < 8; ++e) { int s = sc * 8 + e; v[e] = (1.f - __expf(L[s * HLD + k])) * __expf(gl - Gs[s * HLD + k]); }
      uint2 lo = pack4(v[0], v[1], v[2], v[3]), hi = pack4(v[4], v[5], v[6], v[7]);
      uint4 o; o.x = lo.x; o.y = lo.y; o.z = hi.x; o.w = hi.y;
      *(uint4*)&lfbuf[kdt_off(tok0, h, k) + sc * 8] = o;
    }
    if (tid < 128) p.dbuf[(long)it * 128 + tid] = __expf(R[4 * 128 + tid]);
    u16* Ait = Abuf + (long)it * 4096;
    for (int blk = wid; blk < 10; blk += 8) {
      int ti = blk < 1 ? 0 : (blk < 3 ? 1 : (blk < 6 ? 2 : 3));
      int sj = blk - (ti * (ti + 1)) / 2;
      f32x4 acc = {0.f, 0.f, 0.f, 0.f};
      _Pragma("unroll") for (int ks = 0; ks < 4; ++ks) {
        float av[8], bv[8];
        _Pragma("unroll") for (int e = 0; e < 8; ++e) {
          int kk = ks * 32 + fq * 8 + e; float rr = R[ti * 128 + kk];
          av[e] = Qs[(16 * ti + fr) * HLD + kk] * __expf(Gs[(16 * ti + fr) * HLD + kk] - rr);
          bv[e] = (1.f - __expf(L[(16 * sj + fr) * HLD + kk])) * __expf(fminf(rr - Gs[(16 * sj + fr) * HLD + kk], 80.f));
        }
        uint2 al = pack4(av[0], av[1], av[2], av[3]), ah = pack4(av[4], av[5], av[6], av[7]);
        uint2 bl = pack4(bv[0], bv[1], bv[2], bv[3]), bh = pack4(bv[4], bv[5], bv[6], bv[7]);
        uint4 a4, b4; a4.x = al.x; a4.y = al.y; a4.z = ah.x; a4.w = ah.y; b4.x = bl.x; b4.y = bl.y; b4.z = bh.x; b4.w = bh.y;
        acc = __builtin_amdgcn_mfma_f32_16x16x32_bf16(*(bf16x8*)&a4, *(bf16x8*)&b4, acc, 0, 0, 0);
      }
      _Pragma("unroll") for (int j = 0; j < 4; ++j) {
        int t = 16 * ti + fq * 4 + j, s = 16 * sj + fr;
        float v = (s <= t) ? acc[j] : 0.f;
        Ait[t * 64 + s] = f2bf(v);
      }
    }
    if (wid < 6) {
      int ti = wid < 3 ? 0 : (wid < 5 ? 1 : 2);
      int sj = wid < 3 ? wid + 1 : (wid < 5 ? wid - 1 : 3);
      _Pragma("unroll") for (int j = 0; j < 4; ++j) Ait[(16 * ti + fq * 4 + j) * 64 + 16 * sj + fr] = 0;
    }
  }
}

template <int MODE>
__device__ __forceinline__ void hg2_phase(const Params& p, char* shm, int wv) {
  constexpr int QLD = 136, KLD = 72;
  constexpr int QB = 64 * QLD, KB = 128 * KLD, AB = 64 * KLD, VB = 128 * KLD;
  constexpr int BUF_EL = QB + KB + AB + VB + 256;
  int tid = opaque_tid(wv), wid = tid >> 6, lane = tid & 63, fr = lane & 15, fq = lane >> 4;
  u16* qbuf = p.B0; const u16* kdbuf = p.B1; const u16* iT = p.B2; const u16* Abuf = p.B4;
  float* Send = p.out; float* Dseg = Send + 32L * 8 * 128 * 128;
  for (int it = blockIdx.x; it < 256; it += gridDim.x) {
    int bh = it >> 3, seg = it & 7, b = bh >> 3, h = bh & 7;
    if (MODE == 0 && seg == 7) continue;
    f32x4 S[8];
    _Pragma("unroll") for (int m = 0; m < 8; ++m) S[m] = f32x4{0.f, 0.f, 0.f, 0.f};
    if (MODE == 1) {
      for (int g = 0; g < seg; ++g) {
        const float* se = Send + ((long)(bh * 8 + g)) * 16384; const float* dg = Dseg + (bh * 8 + g) * 128;
        _Pragma("unroll") for (int m = 0; m < 8; ++m) {
          float4 dv = *(const float4*)&dg[16 * m + fq * 4];
          S[m][0] = S[m][0] * dv.x + se[(16 * m + fq * 4 + 0) * 128 + 16 * wid + fr];
          S[m][1] = S[m][1] * dv.y + se[(16 * m + fq * 4 + 1) * 128 + 16 * wid + fr];
          S[m][2] = S[m][2] * dv.z + se[(16 * m + fq * 4 + 2) * 128 + 16 * wid + fr];
          S[m][3] = S[m][3] * dv.w + se[(16 * m + fq * 4 + 3) * 128 + 16 * wid + fr];
        }
      }
    }
    float dacc = 1.f;
    u32x4 rq[2], rk[2], ra, rv[2]; f32x4 rd = {0.f, 0.f, 0.f, 0.f};
#define HG_PREFETCH(cn_) do { int tok0_ = b * SEQ + (cn_) * 64; long it_ = ((long)(b * 128 + (cn_))) * 8 + h; \
      if (MODE == 1) { _Pragma("unroll") for (int i = 0; i < 2; ++i) { int id = tid + i * 512, row = id >> 4, cc = id & 15; rq[i] = *(const u32x4*)&qbuf[(long)(tok0_ + row) * DM + h * 128 + cc * 8]; } } \
      _Pragma("unroll") for (int i = 0; i < 2; ++i) { int id = tid + i * 512, k = id >> 3, sc = id & 7; rk[i] = *(const u32x4*)&kdbuf[kdt_off(tok0_, h, k) + sc * 8]; } \
      if (MODE == 1) { int t = tid >> 3, sc = tid & 7; ra = *(const u32x4*)&Abuf[it_ * 4096 + t * 64 + sc * 8]; } \
      _Pragma("unroll") for (int i = 0; i < 2; ++i) { int id = tid + i * 512, v = id >> 3, sc = id & 7; rv[i] = *(const u32x4*)&iT[((long)(b * 128 + (cn_)) * DM + h * 128 + v) * 64 + sc * 8]; } \
      if (tid < 32) rd = *(const f32x4*)&p.dbuf[it_ * 128 + tid * 4]; } while (0)
#define HG_STASH(bi_) do { \
      u16* base_ = (u16*)shm + (bi_) * BUF_EL; u16* Qt_ = base_; u16* Kd_ = Qt_ + QB; u16* At_ = Kd_ + KB; u16* Vt_ = At_ + AB; float* dd_ = (float*)(Vt_ + VB); \
      if (MODE == 1) { _Pragma("unroll") for (int i = 0; i < 2; ++i) { int id = tid + i * 512, row = id >> 4, cc = id & 15; *(u32x4*)&Qt_[row * QLD + cc * 8] = rq[i]; } } \
      _Pragma("unroll") for (int i = 0; i < 2; ++i) { int id = tid + i * 512, k = id >> 3, sc = id & 7; *(u32x4*)&Kd_[k * KLD + sc * 8] = rk[i]; } \
      if (MODE == 1) { int t = tid >> 3, sc = tid & 7; *(u32x4*)&At_[t * KLD + sc * 8] = ra; } \
      _Pragma("unroll") for (int i = 0; i < 2; ++i) { int id = tid + i * 512, v = id >> 3, sc = id & 7; *(u32x4*)&Vt_[v * KLD + sc * 8] = rv[i]; } \
      if (tid < 32) *(f32x4*)&dd_[tid * 4] = rd; } while (0)
    __syncthreads();
    HG_PREFETCH(seg * 16); HG_STASH(0);
    for (int c = 0; c < 16; ++c) {
      int cn = seg * 16 + c;
      __syncthreads();
      if (c + 1 < 16) HG_PREFETCH(cn + 1);
      u16* base = (u16*)shm + (c & 1) * BUF_EL; u16* Qt = base; u16* Kd = Qt + QB; u16* At = Kd + KB; u16* Vt = At + AB; float* dd = (float*)(Vt + VB);
      bf16x8 vb[2];
      _Pragma("unroll") for (int k2 = 0; k2 < 2; ++k2) vb[k2] = *(const bf16x8*)&Vt[(16 * wid + fr) * KLD + k2 * 32 + fq * 8];
      if (MODE == 1) {
        bf16x8 Sb[4];
        _Pragma("unroll") for (int ks = 0; ks < 4; ++ks) {
          uint2 lo = pack4(S[2 * ks][0], S[2 * ks][1], S[2 * ks][2], S[2 * ks][3]);
          uint2 hi = pack4(S[2 * ks + 1][0], S[2 * ks + 1][1], S[2 * ks + 1][2], S[2 * ks + 1][3]);
          uint4 pk; pk.x = lo.x; pk.y = lo.y; pk.z = hi.x; pk.w = hi.y; Sb[ks] = *(bf16x8*)&pk;
        }
        int tok0 = b * SEQ + cn * 64;
        _Pragma("unroll") for (int rt = 0; rt < 4; ++rt) {
          f32x4 o = {0.f, 0.f, 0.f, 0.f};
          _Pragma("unroll") for (int ks = 0; ks < 4; ++ks) {
            uint2 lo = *(const uint2*)&Qt[(16 * rt + fr) * QLD + 32 * ks + fq * 4];
            uint2 hi = *(const uint2*)&Qt[(16 * rt + fr) * QLD + 32 * ks + 16 + fq * 4];
            uint4 pk; pk.x = lo.x; pk.y = lo.y; pk.z = hi.x; pk.w = hi.y;
            o = __builtin_amdgcn_mfma_f32_16x16x32_bf16(*(bf16x8*)&pk, Sb[ks], o, 0, 0, 0);
          }
          _Pragma("unroll") for (int k2 = 0; k2 < 2; ++k2) {
            bf16x8 a = *(const bf16x8*)&At[(16 * rt + fr) * KLD + k2 * 32 + fq * 8];
            o = __builtin_amdgcn_mfma_f32_16x16x32_bf16(a, vb[k2], o, 0, 0, 0);
          }
          _Pragma("unroll") for (int j = 0; j < 4; ++j) qbuf[(long)(tok0 + 16 * rt + fq * 4 + j) * DM + h * 128 + 16 * wid + fr] = f2bf(o[j]);
        }
      } else if (tid < 128) dacc *= dd[tid];
      _Pragma("unroll") for (int m = 0; m < 8; ++m) {
        float4 dv = *(const float4*)&dd[16 * m + fq * 4];
        S[m][0] *= dv.x; S[m][1] *= dv.y; S[m][2] *= dv.z; S[m][3] *= dv.w;
        _Pragma("unroll") for (int k2 = 0; k2 < 2; ++k2) {
          bf16x8 a = *(const bf16x8*)&Kd[(16 * m + fr) * KLD + k2 * 32 + fq * 8];
          S[m] = __builtin_amdgcn_mfma_f32_16x16x32_bf16(a, vb[k2], S[m], 0, 0, 0);
        }
      }
      if (c + 1 < 16) HG_STASH((c + 1) & 1);
    }
    if (MODE == 0) {
      float* se = Send + ((long)(bh * 8 + seg)) * 16384;
      _Pragma("unroll") for (int m = 0; m < 8; ++m) _Pragma("unroll") for (int j = 0; j < 4; ++j) se[(16 * m + fq * 4 + j) * 128 + 16 * wid + fr] = S[m][j];
      if (tid < 128) Dseg[(bh * 8 + seg) * 128 + tid] = dacc;
    }
  }
}

__device__ __forceinline__ void hg3_phase(const Params& p, int wv) {
  int tid = opaque_tid(wv); int wid = tid >> 6, lane = tid & 63;
  u16* ob = p.B0; const u16* gb = p.B3;
  for (int row = blockIdx.x * 8 + wid; row < T_TOK; row += gridDim.x * 8) {
    uint4 o0 = *(const uint4*)&ob[(long)row * DM + lane * 16], o1 = *(const uint4*)&ob[(long)row * DM + lane * 16 + 8];
    uint4 g0 = *(const uint4*)&gb[(long)row * DM + lane * 16], g1 = *(const uint4*)&gb[(long)row * DM + lane * 16 + 8];
    float o[16], g[16];
    const u16* po0 = (const u16*)&o0; const u16* po1 = (const u16*)&o1; const u16* pg0 = (const u16*)&g0; const u16* pg1 = (const u16*)&g1;
    _Pragma("unroll") for (int e = 0; e < 8; ++e) { o[e] = bf2f(po0[e]); o[8 + e] = bf2f(po1[e]); g[e] = bf2f(pg0[e]); g[8 + e] = bf2f(pg1[e]); }
    float ss = 0.f; _Pragma("unroll") for (int e = 0; e < 16; ++e) ss += o[e] * o[e];
    ss += sx<1>(ss, lane); ss += sx<2>(ss, lane); ss += sx<4>(ss, lane);
    float rs = rsqrtf(ss * (1.f / 128.f) + EPS);
    int c0 = (lane & 7) * 16; float r[16];
    _Pragma("unroll") for (int e = 0; e < 16; ++e) r[e] = o[e] * rs * p.hg_onorm[c0 + e] * silu_f(g[e]);
    uint2 a = pack4(r[0], r[1], r[2], r[3]), b2 = pack4(r[4], r[5], r[6], r[7]), c = pack4(r[8], r[9], r[10], r[11]), d = pack4(r[12], r[13], r[14], r[15]);
    uint4 w0, w1; w0.x = a.x; w0.y = a.y; w0.z = b2.x; w0.w = b2.y; w1.x = c.x; w1.y = c.y; w1.z = d.x; w1.w = d.y;
    *(uint4*)&ob[(long)row * DM + lane * 16] = w0; *(uint4*)&ob[(long)row * DM + lane * 16 + 8] = w1;
  }
}

__device__ __forceinline__ void sgu_phase(const Params& p, char* shm, int wv) {
  constexpr int WLD = 136;
  u16* Wp = (u16*)shm; float* rsv = (float*)(shm + 128 * WLD * 2);
  int tid = opaque_tid(wv), wid = tid >> 6, lane = tid & 63, fr = lane & 15, fq = lane >> 4;
  const u16* ub = p.B0; const u16* vT = p.B1; u16* ob = p.B2; const float* rowss_v = p.vpart;
  for (int it = blockIdx.x; it < 2048; it += gridDim.x) {
    int g = it & 7, c128 = it >> 3, tok0 = c128 * 128;
    __syncthreads();
    if (tid < 128) rsv[tid] = row_rs(rowss_v, tok0 + tid);
    __syncthreads();
    _Pragma("unroll") for (int i = 0; i < 4; ++i) {
      int id = tid + i * 512, t = id >> 4, sc = id & 15;
      const float4* w4 = (const float4*)(p.sg_w_s + ((long)(g * 128 + t)) * 128 + sc * 8);
      float4 a = w4[0], b = w4[1]; float v[8] = {a.x, a.y, a.z, a.w, b.x, b.y, b.z, b.w};
      _Pragma("unroll") for (int e = 0; e < 8; ++e) { int s = sc * 8 + e; v[e] = (s <= t) ? v[e] * rsv[s] : 0.f; }
      uint2 lo = pack4(v[0], v[1], v[2], v[3]), hi = pack4(v[4], v[5], v[6], v[7]);
      uint4 o; o.x = lo.x; o.y = lo.y; o.z = hi.x; o.w = hi.y;
      *(uint4*)&Wp[t * WLD + sc * 8] = o;
    }
    bf16x8 vb[4];
    int cc = g * 128 + 16 * wid + fr;
    _Pragma("unroll") for (int ks = 0; ks < 4; ++ks) vb[ks] = *(const bf16x8*)&vT[((long)c128 * DM + cc) * 128 + ks * 32 + fq * 8];
    float4 gvn = *(const float4*)&p.sg_vnorm[g * 128 + 16 * wid + fq * 4];
    __syncthreads();
    _Pragma("unroll") for (int mt = 0; mt < 8; ++mt) {
      f32x4 acc = {0.f, 0.f, 0.f, 0.f};
      _Pragma("unroll") for (int ks = 0; ks <= (mt >> 1); ++ks) {
        bf16x8 a = *(const bf16x8*)&Wp[(16 * mt + fr) * WLD + ks * 32 + fq * 8];
        acc = __builtin_amdgcn_mfma_f32_16x16x32_bf16(vb[ks], a, acc, 0, 0, 0);
      }
      int t = 16 * mt + fr; float bs = p.sg_b_s[g * 128 + t];
      long idx = (long)(tok0 + t) * DM + g * 128 + 16 * wid + fq * 4;
      uint2 uv = *(const uint2*)&ub[idx];
      float u0 = __uint_as_float(uv.x << 16), u1 = __uint_as_float(uv.x & 0xffff0000u), u2 = __uint_as_float(uv.y << 16), u3 = __uint_as_float(uv.y & 0xffff0000u);
      *(uint2*)&ob[idx] = pack4(u0 * (acc[0] * gvn.x + bs), u1 * (acc[1] * gvn.y + bs), u2 * (acc[2] * gvn.z + bs), u3 * (acc[3] * gvn.w + bs));
    }
  }
}

__device__ __forceinline__ void final_phase(const Params& p, int wv) {
  int tid = opaque_tid(wv); int wid = tid >> 6, lane = tid & 63;
  for (int row = blockIdx.x * 8 + wid; row < T_TOK; row += gridDim.x * 8) {
    float rs = row_rs(p.rpart, row);
    float4* o4 = (float4*)(p.out + (long)row * DM);
    const uint2* x2 = (const uint2*)(p.xb + (long)row * DM);
    _Pragma("unroll") for (int i = 0; i < 4; ++i) {
      uint2 xv = x2[i * 64 + lane]; float4 g = ((const float4*)p.norm_final)[i * 64 + lane]; float4 v;
      v.x = __uint_as_float(xv.x << 16) * rs * g.x; v.y = __uint_as_float(xv.x & 0xffff0000u) * rs * g.y;
      v.z = __uint_as_float(xv.y << 16) * rs * g.z; v.w = __uint_as_float(xv.y & 0xffff0000u) * rs * g.w;
      o4[i * 64 + lane] = v;
    }
  }
}

#define XB_TMO      128
#define XB_XCNT(j)  (256  + 64 * (j))
#define XB_XSUB(j)  (1280 + 64 * (j))
#define XB_XGEN(j)  (2304 + 64 * (j))
#define XB_TOP      3328
#define XB_TOPGEN   3392
#define XCD_BAR_WORDS 3456
#define XB_SPIN_CAP (1u << 22)
#define LAS __attribute__((address_space(3)))

__device__ __forceinline__ unsigned xb_ld(unsigned* p)              { return __hip_atomic_load(p, __ATOMIC_RELAXED, __HIP_MEMORY_SCOPE_AGENT); }
__device__ __forceinline__ unsigned xb_add(unsigned* p, unsigned v) { return __hip_atomic_fetch_add(p, v, __ATOMIC_RELAXED, __HIP_MEMORY_SCOPE_AGENT); }
__device__ __forceinline__ unsigned xb_xcc_id() { return (unsigned)__builtin_amdgcn_s_getreg((3 << 11) | 20) & 0xFu; }
#define XB_SPIN(cond, bar) do { unsigned _sp = 0; while (cond) { __builtin_amdgcn_s_sleep(1); \
    if ((++_sp & 255u) == 0u) { if (xb_ld(&(bar)[XB_TMO])) break; if (_sp > XB_SPIN_CAP) { atomicAdd(&(bar)[XB_TMO], 1u); break; } } } } while (0)

struct XcdBarrier {
    unsigned* bar; unsigned x;
    volatile LAS unsigned* st;
};

__device__ __forceinline__ XcdBarrier xcd_barrier_post(unsigned* bar, volatile LAS unsigned* st, bool t0) {
    XcdBarrier b; b.bar = bar; b.x = xb_xcc_id(); b.st = st;
    if (t0) (void)xb_add(&bar[XB_XCNT(b.x)], 1u);
    return b;
}
__device__ __forceinline__ void xcd_barrier_complete(unsigned* bar, unsigned x, unsigned& nloc, unsigned& nx) {
    const unsigned G = gridDim.x * gridDim.y * gridDim.z;
    unsigned sum, cnt, mine, sp = 0u;
    for (;;) {
        sum = 0u; cnt = 0u; mine = 0u;
#pragma unroll
        for (unsigned j = 0; j < 16; ++j) { const unsigned c = xb_ld(&bar[XB_XCNT(j)]); sum += c; cnt += (c > 0u) ? 1u : 0u; mine = (j == x) ? c : mine; }
        if (sum == G) break;
        __builtin_amdgcn_s_sleep(1);
        if ((++sp & 255u) == 0u) { if (xb_ld(&bar[XB_TMO])) break; if (sp > XB_SPIN_CAP) { atomicAdd(&bar[XB_TMO], 1u); break; } }
    }
    nloc = mine > 0u ? mine : 1u; nx = cnt > 0u ? cnt : 1u;
}

__device__ __forceinline__ void xcd_barrier(const XcdBarrier& b, bool t0) {
    asm volatile("s_waitcnt vmcnt(0)" ::: "memory");
    __syncthreads();
    if (t0) {
        unsigned* bar = b.bar;
        __builtin_amdgcn_s_waitcnt(0);
        unsigned nloc = b.st[0], nx = b.st[1];
        if (nloc == 0u) { xcd_barrier_complete(bar, b.x, nloc, nx); b.st[0] = nloc; b.st[1] = nx; }
        const unsigned old = xb_add(&bar[XB_XSUB(b.x)], 1u);
        const unsigned gen = old / nloc;
        if (old + 1u == (gen + 1u) * nloc) {
            __builtin_amdgcn_fence(__ATOMIC_RELEASE, "agent");
            asm volatile("s_waitcnt vmcnt(0)" ::: "memory");
            const unsigned og = xb_add(&bar[XB_TOP], 1u);
            const unsigned tg = og / nx;
            if (og + 1u == (tg + 1u) * nx) xb_add(&bar[XB_TOPGEN], 1u);
            else XB_SPIN(xb_ld(&bar[XB_TOPGEN]) == tg, bar);
            __builtin_amdgcn_fence(__ATOMIC_ACQUIRE, "agent");
            xb_add(&bar[XB_XGEN(b.x)], 1u);
            asm volatile("s_waitcnt vmcnt(0)" ::: "memory");
        } else {
            XB_SPIN(xb_ld(&bar[XB_XGEN(b.x)]) == gen, bar);
            __builtin_amdgcn_fence(__ATOMIC_ACQUIRE, "agent");
            asm volatile("s_waitcnt vmcnt(0)" ::: "memory");
        }
    }
    __syncthreads();
}


#define SEL4(arr, i) ((i) == 0 ? (arr)[0] : ((i) == 1 ? (arr)[1] : ((i) == 2 ? (arr)[2] : (arr)[3])))
__global__ void __launch_bounds__(512, 2) fwd_megakernel(KArgs ka_unused) {
  extern __shared__ __attribute__((aligned(16))) char shm[];
  const int wv = __builtin_amdgcn_readfirstlane((int)(threadIdx.x >> 6));
  int ph = 0;
#define BARRIER_WS ((unsigned*)(kargs_ptr()->ws + OFF_BAR))
#if MULTI_LAUNCH
#define PHASE_BEGIN if (ph >= kargs_ptr()->phase_lo && ph < kargs_ptr()->phase_hi) { const Params p = make_params(*kargs_ptr());
#define PHASE_END } ++ph;
#else
  cg::grid_group grid = cg::this_grid();
#define PHASE_BEGIN { const Params p = make_params(*kargs_ptr());
#define PHASE_END } ++ph; { XcdBarrier xb_; xb_.bar = BARRIER_WS; xb_.x = xb_xcc_id(); xb_.st = (volatile LAS unsigned*)(shm + LDS_BYTES - 16); xcd_barrier(xb_, opaque_tid(wv) == 0); }
#endif
#define LAYER_VARS \
    const float* xin = (i == 0) ? p.x : p.out; float* rs_mix = p.rpart; float* rs_cross = p.rpart; float* rs_ffn = p.rpart; float* rs_next = p.rpart; \
    const u16* w_mix_in = p.wbase + layer_woff(i); const u16* w_mix_out = w_mix_in + mixin_elems(i); const u16* w_caq = w_mix_out + 1048576L; \
    const u16* w_cao = w_caq + 3145728L; const u16* w_gu = w_cao + 1048576L; const u16* w_down = w_gu + 5767168L; \
    const u16* mix_out_A = kind == 0 ? p.B3 : (kind == 1 ? p.B0 : p.B2); \
    (void)xin; (void)rs_mix; (void)rs_cross; (void)rs_ffn; (void)rs_next; (void)w_mix_in; (void)w_mix_out; (void)w_caq; (void)w_cao; (void)w_gu; (void)w_down; (void)mix_out_A;
#if MULTI_LAUNCH
  PHASE_BEGIN prep_phase(p, kargs_ptr(), shm, wv); PHASE_END
#else
  { const Params p = make_params(*kargs_ptr()); prep_phase(p, kargs_ptr(), shm, wv); } ++ph;
  grid.sync();
  {
    volatile LAS unsigned* xb_st = (volatile LAS unsigned*)(shm + LDS_BYTES - 16);
    if (opaque_tid(wv) == 0) { xb_st[0] = 0u; xb_st[1] = 0u; }
    __syncthreads();
    (void)xcd_barrier_post(BARRIER_WS, xb_st, opaque_tid(wv) == 0);
  }
#endif
  _Pragma("nounroll") for (int i = 0; i < 4; ++i) {
    int kind = i % 3, j = i / 3;
    if (kind == 0) {
      PHASE_BEGIN LAYER_VARS
        if (i == 0) {
          for (int t = blockIdx.x; t < 128; t += gridDim.x) {
            int l = t >> 5, tt = t & 31, tr0 = (tt & 3) * BM, fc0 = (tt >> 2) * BM;
            EpiMemKV em{p.memK + (long)l * NB * MEML * DM, p.memVT + (long)l * NB * DM * MEML};
            const u16* mA = p.memn; const u16* mB = p.wbase + layer_woff(l) + mixin_elems(l) + 2097152L;
            bool sw = em.swap(fc0);
            gemm_tile(sw ? mB : mA, sw ? mA : mB, DM, sw ? fc0 : tr0, sw ? tr0 : fc0, shm, em, tr0, fc0, sw, false, false, mA, mB, 0, 0, wv);
          }
        }
        EpiDaIn e{rs_mix, p.B0, p.B1, p.B2}; gemm_phase(p.xb, w_mix_in, T_TOK, 3 * DM, DM, shm, e, wv);
      PHASE_END
      PHASE_BEGIN diff_attn_phase(p, j, i, shm, wv); PHASE_END
    } else if (kind == 1) {
      PHASE_BEGIN LAYER_VARS EpiHgIn e{rs_mix, p.lbv, p.B0, p.B1, p.B2, p.B3}; gemm_phase(p.xb, w_mix_in, T_TOK, 4 * DM, DM, shm, e, wv); PHASE_END
      PHASE_BEGIN hg1_phase(p, shm, wv); PHASE_END
      PHASE_BEGIN hg2_phase<0>(p, shm, wv); PHASE_END
      PHASE_BEGIN hg2_phase<1>(p, shm, wv); PHASE_END
      PHASE_BEGIN hg3_phase(p, wv); PHASE_END
    } else {
      PHASE_BEGIN LAYER_VARS EpiSgIn e{rs_mix, p.B0, p.B1, p.vpart}; gemm_phase(p.xb, w_mix_in, T_TOK, 2 * DM, DM, shm, e, wv); PHASE_END
      PHASE_BEGIN sgu_phase(p, shm, wv); PHASE_END
    }
    PHASE_BEGIN LAYER_VARS EpiRes e{p.xb, rs_cross}; gemm_phase(mix_out_A, w_mix_out, T_TOK, DM, DM, shm, e, wv); PHASE_END
    PHASE_BEGIN LAYER_VARS EpiStore e{rs_cross, p.B0, DM}; gemm_phase(p.xb, w_caq, T_TOK, DM, DM, shm, e, wv); PHASE_END
    PHASE_BEGIN cross_attn_phase(p, i, shm, wv); PHASE_END
    PHASE_BEGIN LAYER_VARS EpiRes e{p.xb, rs_ffn}; gemm_phase(p.B1, w_cao, T_TOK, DM, DM, shm, e, wv); PHASE_END
    PHASE_BEGIN LAYER_VARS EpiFfn e{rs_ffn, p.B0}; gemm_phase(p.xb, w_gu, T_TOK, 2 * DFF, DM, shm, e, wv); PHASE_END
    PHASE_BEGIN LAYER_VARS EpiRes e{p.xb, rs_next}; gemm_phase(p.B0, w_down, T_TOK, DM, DFF, shm, e, wv); PHASE_END
  }
#if MULTI_LAUNCH
  PHASE_BEGIN final_phase(p, wv); PHASE_END
#else
  { const Params p = make_params(*kargs_ptr()); final_phase(p, wv); }
#endif
}

extern "C" void kernel_launch(void* const* d_in, const int* in_sizes, int n_in, void* d_out, int out_size, void* d_ws, size_t ws_size,
                              hipStream_t stream) {
  static int grid_blocks = 0;
  if (!grid_blocks) {
    int dev = 0, cus = 0, per_cu = 0;
    hipGetDevice(&dev);
    hipDeviceGetAttribute(&cus, hipDeviceAttributeMultiprocessorCount, dev);
    if (hipFuncSetAttribute((const void*)fwd_megakernel, hipFuncAttributeMaxDynamicSharedMemorySize, LDS_BYTES) != hipSuccess)
      fprintf(stderr, "hipFuncSetAttribute failed\n");
    hipOccupancyMaxActiveBlocksPerMultiprocessor(&per_cu, (const void*)fwd_megakernel, 512, LDS_BYTES);
    if (per_cu < 1) { fprintf(stderr, "occupancy query returned %d\n", per_cu); per_cu = 1; }
    grid_blocks = cus * per_cu;
    (void)hipGetLastError();
  }
  KArgs p;
  memset(&p, 0, sizeof(p));
  const float* const* in = (const float* const*)d_in;
  p.x = in[0]; p.mem = in[1]; p.rel_bias = in[2];
  const float *norm_mix = in[3], *norm_cross = in[4], *norm_ffn = in[5];
  p.norm_mem = in[6]; p.norm_final = in[7];
  const float *da_w_in = in[8], *da_w_out = in[9];
  p.da_lq1 = in[10]; p.da_lk1 = in[11]; p.da_lq2 = in[12]; p.da_lk2 = in[13]; p.da_subln = in[14];
  const float *hg_w_in = in[15], *hg_w_out = in[16];
  p.hg_lb = in[17]; p.hg_onorm = in[18];
  const float *sg_w_in = in[19], *sg_w_out = in[20];
  p.sg_vnorm = in[21]; p.sg_w_s = in[22]; p.sg_b_s = in[23];
  const float *ca_w_q = in[24], *ca_w_kv = in[25], *ca_w_o = in[26], *ffn_w_gu = in[27], *ffn_w_down = in[28];
  p.out = (float*)d_out; p.ws = (char*)d_ws;
  if (WS_END > ws_size) { fprintf(stderr, "workspace too small: need %zu have %zu\n", (size_t)WS_END, ws_size); return; }
  int nwd = 0, tiles = 0;
  u16* wcur = (u16*)((char*)d_ws + OFF_W);
  auto addw = [&](const float* src, int K, int N, const float* gain, int perm) {
    WDesc& w = p.wd[nwd++]; w.src = src; w.dst = wcur; w.gain = gain; w.K = K; w.N = N; w.perm = perm; w.tile0 = tiles;
    tiles += (K / 64) * (N / 64); wcur += (size_t)K * N;
  };
  for (int i = 0; i < 4; ++i) {
    int kind = i % 3, j = i / 3;
    if (wcur != (u16*)((char*)d_ws + OFF_W) + layer_woff(i)) fprintf(stderr, "weight layout mismatch at layer %d\n", i);
    if (kind == 0) { addw(da_w_in + (size_t)j * DM * 3 * DM, DM, 3 * DM, norm_mix + i * DM, 0); addw(da_w_out + (size_t)j * DM * DM, DM, DM, nullptr, 0); }
    else if (kind == 1) { addw(hg_w_in + (size_t)j * DM * 4 * DM, DM, 4 * DM, norm_mix + i * DM, 0); addw(hg_w_out + (size_t)j * DM * DM, DM, DM, nullptr, 0); }
    else { addw(sg_w_in + (size_t)j * DM * 2 * DM, DM, 2 * DM, norm_mix + i * DM, 0); addw(sg_w_out + (size_t)j * DM * DM, DM, DM, nullptr, 0); }
    addw(ca_w_q + (size_t)i * DM * DM, DM, DM, norm_cross + i * DM, 0);
    addw(ca_w_kv + (size_t)i * DM * 2 * DM, DM, 2 * DM, nullptr, 0);
    addw(ca_w_o + (size_t)i * DM * DM, DM, DM, nullptr, 0);
    addw(ffn_w_gu + (size_t)i * DM * 2 * DFF, DM, 2 * DFF, norm_ffn + i * DM, 1);
    addw(ffn_w_down + (size_t)i * DFF * DM, DFF, DM, nullptr, 0);
  }
  p.nwd = nwd; p.total_wtiles = tiles;
#if MULTI_LAUNCH
  _Pragma("unroll") for (int ph = 0; ph < 64; ++ph) {
    p.phase_lo = ph; p.phase_hi = ph + 1;
    hipLaunchKernelGGL(fwd_megakernel, dim3(grid_blocks), dim3(512), LDS_BYTES, stream, p);
  }
#else
  p.phase_lo = 0; p.phase_hi = 1 << 30;
  void* args[] = {&p};
  hipError_t e = hipLaunchCooperativeKernel((void*)fwd_megakernel, dim3(grid_blocks), dim3(512), args, LDS_BYTES, stream);
  if (e != hipSuccess) fprintf(stderr, "cooperative launch failed: %s (grid %d)\n", hipGetErrorString(e), grid_blocks);
#endif
}
```

```cpp
#include <hip/hip_runtime.h>
#include <hip/hip_cooperative_groups.h>
#include <cstdio>
#include <cmath>
#include <cstring>
namespace cg = cooperative_groups;

typedef unsigned short u16;
using bf16x8 = __attribute__((ext_vector_type(8))) short;
using bf16x4 = __attribute__((ext_vector_type(4))) short;
using f32x4 = __attribute__((ext_vector_type(4))) float;
using u32x4 = __attribute__((ext_vector_type(4))) unsigned;

#ifndef MULTI_LAUNCH
#define MULTI_LAUNCH 0
#endif

constexpr int T_TOK = 32768, DM = 1024, SEQ = 8192, NB = 4, DFF = 2816, MEML = 256;
constexpr float EPS = 1e-6f;
constexpr int LDS_BYTES = 147456;
constexpr float LOG2E = 1.4426950408889634f;

typedef __attribute__((ext_vector_type(2))) float f32x2;
typedef __attribute__((ext_vector_type(2))) __bf16 bf16x2_t;
__device__ __forceinline__ unsigned pk2(float a, float b) { f32x2 v = {a, b}; bf16x2_t r = __builtin_convertvector(v, bf16x2_t); return *(unsigned*)&r; }
__device__ __forceinline__ u16 f2bf(float f) { return (u16)(pk2(f, 0.f) & 0xffffu); }
__device__ __forceinline__ float bf2f(u16 h) { return __uint_as_float(((unsigned)h) << 16); }
__device__ __forceinline__ float sigmoid_f(float x) { return __builtin_amdgcn_rcpf(1.f + __builtin_amdgcn_exp2f(-x * LOG2E)); }
__device__ __forceinline__ float silu_f(float x) { return x * sigmoid_f(x); }

__device__ __forceinline__ int opaque_tid(int wv) { unsigned ones = ~0u; asm volatile("" : "+s"(ones)); int lane = __builtin_amdgcn_mbcnt_hi(ones, __builtin_amdgcn_mbcnt_lo(ones, 0u)); int t = (wv << 6) | lane; asm volatile("" : "+v"(t)); return t; }

template <int M> __device__ __forceinline__ float sx(float v, int lane) {
  if (M < 32) return __int_as_float(__builtin_amdgcn_ds_swizzle(__float_as_int(v), (M << 10) | 0x1f));
  else return __int_as_float(__builtin_amdgcn_ds_bpermute((lane ^ M) << 2, __float_as_int(v)));
}
__device__ __forceinline__ float wave_sum(float v, int lane) {
  v += sx<1>(v, lane); v += sx<2>(v, lane); v += sx<4>(v, lane); v += sx<8>(v, lane); v += sx<16>(v, lane); v += sx<32>(v, lane); return v;
}

struct WDesc { const float* src; u16* dst; const float* gain; int K; int N; int perm; int tile0; };

struct KArgs {
  const float *x, *mem, *rel_bias, *norm_mem, *norm_final;
  const float *da_lq1, *da_lk1, *da_lq2, *da_lk2, *da_subln;
  const float *hg_lb, *hg_onorm;
  const float *sg_vnorm, *sg_w_s, *sg_b_s;
  float* out; char* ws;
  WDesc wd[28];
  int nwd; int total_wtiles;
  int phase_lo, phase_hi;
};

constexpr size_t MIB = 1u << 20;
constexpr size_t OFF_XB = 0, OFF_RPART = OFF_XB + 64 * MIB, OFF_VPART = OFF_RPART + 2 * MIB, OFF_MEMN = OFF_VPART + 2 * MIB,
                 OFF_MEMK = OFF_MEMN + 2 * MIB, OFF_MEMVT = OFF_MEMK + 8 * MIB, OFF_LBV = OFF_MEMVT + 8 * MIB, OFF_BIAS = OFF_LBV + 4096,
                 OFF_B0 = OFF_BIAS + 4096, OFF_B1 = OFF_B0 + 64 * MIB, OFF_B2 = OFF_B1 + 64 * MIB, OFF_B3 = OFF_B2 + 64 * MIB,
                 OFF_B4 = OFF_B3 + 64 * MIB, OFF_DBUF = OFF_B4 + 32 * MIB, OFF_W = OFF_DBUF + 2 * MIB, OFF_BAR = OFF_W + 130 * MIB, WS_END = OFF_BAR + 16384;
__host__ __device__ __forceinline__ long layer_woff(int i) { return i == 0 ? 0L : (i == 1 ? 17039360L : (i == 2 ? 35127296L : 51118080L)); }
__host__ __device__ __forceinline__ long mixin_elems(int i) { int kind = i % 3; return kind == 0 ? 3145728L : (kind == 1 ? 4194304L : 2097152L); }

struct Params {
  const float *x, *mem, *rel_bias, *norm_mem, *norm_final;
  const float *da_lq1, *da_lk1, *da_lq2, *da_lk2, *da_subln;
  const float *hg_lb, *hg_onorm;
  const float *sg_vnorm, *sg_w_s, *sg_b_s;
  float* out;
  u16* xb; float* rpart; float* vpart; u16* memn; u16* memK; u16* memVT; float* lbv; float* biastab;
  u16 *B0, *B1, *B2, *B3, *B4; float* dbuf; u16* wbase;
};
typedef const KArgs __attribute__((address_space(4)))* KArgsP;
__device__ __forceinline__ KArgsP kargs_ptr() {
  KArgsP kp = (KArgsP)__builtin_amdgcn_kernarg_segment_ptr();
  asm volatile("" : "+s"(kp));
  return kp;
}
template <class KA>
__device__ __forceinline__ Params make_params(const KA& k) {
  Params p;
  p.x = k.x; p.mem = k.mem; p.rel_bias = k.rel_bias; p.norm_mem = k.norm_mem; p.norm_final = k.norm_final;
  p.da_lq1 = k.da_lq1; p.da_lk1 = k.da_lk1; p.da_lq2 = k.da_lq2; p.da_lk2 = k.da_lk2; p.da_subln = k.da_subln;
  p.hg_lb = k.hg_lb; p.hg_onorm = k.hg_onorm; p.sg_vnorm = k.sg_vnorm; p.sg_w_s = k.sg_w_s; p.sg_b_s = k.sg_b_s; p.out = k.out;
  char* ws = k.ws;
  p.xb = (u16*)(ws + OFF_XB); p.rpart = (float*)(ws + OFF_RPART); p.vpart = (float*)(ws + OFF_VPART); p.memn = (u16*)(ws + OFF_MEMN);
  p.memK = (u16*)(ws + OFF_MEMK); p.memVT = (u16*)(ws + OFF_MEMVT); p.lbv = (float*)(ws + OFF_LBV); p.biastab = (float*)(ws + OFF_BIAS);
  p.B0 = (u16*)(ws + OFF_B0); p.B1 = (u16*)(ws + OFF_B1); p.B2 = (u16*)(ws + OFF_B2); p.B3 = (u16*)(ws + OFF_B3); p.B4 = (u16*)(ws + OFF_B4);
  p.dbuf = (float*)(ws + OFF_DBUF); p.wbase = (u16*)(ws + OFF_W);
  return p;
}


constexpr int BM = 256, BK = 64, HALF = 128, HT = HALF * BK;

__device__ __forceinline__ int lds_byte(int r, int c) {
  int st = (r >> 4) * 2 + (c >> 5), rr = r & 15, cc = c & 31, ob = rr * 64 + cc * 2;
  return st * 1024 + (ob ^ (((ob >> 9) & 1) << 5));
}
__device__ __forceinline__ void stage_rc(int b, int& R, int& C) {
  int st = b / 1024, sb = b % 1024, swz = sb ^ (((sb >> 9) & 1) << 5);
  R = (st >> 1) * 16 + swz / 64; C = (st & 1) * 32 + (swz % 64) / 2;
}

template <class Epi>
__device__ __forceinline__ void gemm_tile(const u16* __restrict__ A, const u16* __restrict__ Bt, int K, int brow, int bcol,
                                          char* shmc, Epi& epi, int tr0, int fc0, bool sw, bool pre, bool has_next,
                                          const u16* __restrict__ nA, const u16* __restrict__ nBt, int nbrow, int nbcol, int wv) {
  u16* shm = (u16*)shmc;
  const int tx = opaque_tid(wv);
#define SA(b, h) (shm + ((b) * 2 + (h)) * HT)
#define SB(b, h) (shm + (4 + (b) * 2 + (h)) * HT)
#define STAGE(P, BASE, br, kt) do { int _so = ((br) * K + (kt) * BK) * 2; \
    __builtin_amdgcn_raw_ptr_buffer_load_lds(rs_##BASE, (__attribute__((address_space(3))) void*)((char*)(P) + tx * 16), 16, voff0, _so, 0, 0); \
    __builtin_amdgcn_raw_ptr_buffer_load_lds(rs_##BASE, (__attribute__((address_space(3))) void*)((char*)(P) + tx * 16 + 8192), 16, voff1, _so, 0, 0); } while (0)
#define LDA(dst, b, h) _Pragma("unroll") for (int m = 0; m < 4; ++m) _Pragma("unroll") for (int k = 0; k < 2; ++k) \
    dst[m][k] = *reinterpret_cast<const bf16x8*>((char*)SA(b, h) + lds_byte(wr * 64 + m * 16 + fr, k * 32 + fq * 8))
#define LDB(dst, b, h) _Pragma("unroll") for (int n = 0; n < 2; ++n) _Pragma("unroll") for (int k = 0; k < 2; ++k) \
    dst[n][k] = *reinterpret_cast<const bf16x8*>((char*)SB(b, h) + lds_byte(wc * 32 + n * 16 + fr, k * 32 + fq * 8))
#define MMA(ai, bj, At, Bt_) do { __builtin_amdgcn_s_setprio(1); \
    _Pragma("unroll") for (int m = 0; m < 4; ++m) _Pragma("unroll") for (int n = 0; n < 2; ++n) _Pragma("unroll") for (int k = 0; k < 2; ++k) \
      acc[ai][bj][m][n] = __builtin_amdgcn_mfma_f32_16x16x32_bf16(At[m][k], Bt_[n][k], acc[ai][bj][m][n], 0, 0, 0); \
    __builtin_amdgcn_s_setprio(0); } while (0)
#define WAIT_V(n) asm volatile("s_waitcnt vmcnt(" #n ")" ::: "memory")
#define WAIT_L(n) asm volatile("s_waitcnt lgkmcnt(" #n ")" ::: "memory")
#define BAR __builtin_amdgcn_s_barrier()
#define SCHED __builtin_amdgcn_sched_barrier(0)

  int wid = tx >> 6, lane = tx & 63, wr = wid >> 2, wc = wid & 3, fr = lane & 15, fq = lane >> 4;
  f32x4 acc[2][2][4][2] = {};
  bf16x8 At[4][2], B0[2][2], B1[2][2];
  int nt = K / BK;
  int voff0, voff1;
  { int _r, _c; stage_rc(tx * 16, _r, _c); voff0 = (_r * K + _c) * 2; stage_rc(tx * 16 + 8192, _r, _c); voff1 = (_r * K + _c) * 2; }
  __amdgpu_buffer_rsrc_t rs_A = __builtin_amdgcn_make_buffer_rsrc((void*)A, 0, 0x7fffffff, 0x00020000);
  __amdgpu_buffer_rsrc_t rs_Bt = __builtin_amdgcn_make_buffer_rsrc((void*)Bt, 0, 0x7fffffff, 0x00020000);
  if (!pre) {
    STAGE(SB(0, 0), Bt, bcol, 0); STAGE(SA(0, 0), A, brow, 0);
    STAGE(SB(0, 1), Bt, bcol + HALF, 0); STAGE(SA(0, 1), A, brow + HALF, 0);
  }
  if (wr == 1) BAR;
  if (pre) { WAIT_V(0); } else { WAIT_V(4); }
  BAR;
  STAGE(SB(1, 0), Bt, bcol, 1); STAGE(SA(1, 0), A, brow, 1); STAGE(SB(1, 1), Bt, bcol + HALF, 1);
  WAIT_V(6); BAR;
  for (int t = 0; t < nt - 2; t += 2) {
    LDB(B0, 0, 0); SCHED; LDA(At, 0, 0); STAGE(SA(1, 1), A, brow + HALF, t + 1);
    WAIT_L(8); BAR; WAIT_L(0); MMA(0, 0, At, B0); BAR; SCHED;
    LDB(B1, 0, 1); STAGE(SB(0, 0), Bt, bcol, t + 2);
    BAR; WAIT_L(0); MMA(0, 1, At, B1); BAR;
    LDA(At, 0, 1); STAGE(SA(0, 0), A, brow, t + 2);
    BAR; WAIT_L(0); MMA(1, 0, At, B0); BAR; SCHED;
    STAGE(SB(0, 1), Bt, bcol + HALF, t + 2);
    WAIT_V(6); BAR; MMA(1, 1, At, B1); BAR;
    LDB(B0, 1, 0); SCHED; LDA(At, 1, 0); STAGE(SA(0, 1), A, brow + HALF, t + 2);
    WAIT_L(8); BAR; WAIT_L(0); MMA(0, 0, At, B0); BAR; SCHED;
    LDB(B1, 1, 1); STAGE(SB(1, 0), Bt, bcol, t + 3);
    BAR; WAIT_L(0); MMA(0, 1, At, B1); BAR;
    LDA(At, 1, 1); STAGE(SA(1, 0), A, brow, t + 3);
    BAR; WAIT_L(0); MMA(1, 0, At, B0); BAR; SCHED;
    STAGE(SB(1, 1), Bt, bcol + HALF, t + 3);
    WAIT_V(6); BAR; MMA(1, 1, At, B1); BAR;
  }
  { LDB(B0, 0, 0); LDA(At, 0, 0); STAGE(SA(1, 1), A, brow + HALF, nt - 1);
    BAR; WAIT_L(0); MMA(0, 0, At, B0); BAR;
    LDB(B1, 0, 1); BAR; WAIT_L(0); MMA(0, 1, At, B1); BAR;
    LDA(At, 0, 1); WAIT_V(4); BAR; WAIT_L(0); MMA(1, 0, At, B0); MMA(1, 1, At, B1); BAR; }
  { LDB(B0, 1, 0); LDA(At, 1, 0); WAIT_V(2); BAR; WAIT_L(0); MMA(0, 0, At, B0); BAR;
    LDB(B1, 1, 1); WAIT_V(0); BAR; WAIT_L(0); MMA(0, 1, At, B1); BAR;
    LDA(At, 1, 1); BAR; WAIT_L(0); MMA(1, 0, At, B0); MMA(1, 1, At, B1); BAR; }
  if (wr == 0) BAR;
  if (has_next) {
    __amdgpu_buffer_rsrc_t rs_nA = __builtin_amdgcn_make_buffer_rsrc((void*)nA, 0, 0x7fffffff, 0x00020000);
    __amdgpu_buffer_rsrc_t rs_nBt = __builtin_amdgcn_make_buffer_rsrc((void*)nBt, 0, 0x7fffffff, 0x00020000);
    STAGE(SB(0, 0), nBt, nbcol, 0); STAGE(SA(0, 0), nA, nbrow, 0);
    STAGE(SB(0, 1), nBt, nbcol + HALF, 0); STAGE(SA(0, 1), nA, nbrow + HALF, 0);
  }
  {
    const int tx2 = opaque_tid(wv); const int wid2 = tx2 >> 6, lane2 = tx2 & 63;
    epi(acc, tr0, fc0, sw, wid2 >> 2, wid2 & 3, lane2 & 15, lane2 >> 4);
  }
  __syncthreads();
#undef SA
#undef SB
#undef STAGE
#undef LDA
#undef LDB
#undef MMA
}

template <class Epi>
__device__ __forceinline__ void gemm_phase(const u16* A, const u16* Bt, int M, int N, int K, char* shm, Epi& epi, int wv) {
  int nM = M / BM, nN = N / BM;
  int G = gridDim.x, bid = blockIdx.x;
  bool xmap = ((G & 7) == 0 && (nM & 63) == 0);
  int xcd = bid & 7, slot = bid >> 3, nslots = G >> 3, gpx = nM / 64;
  int first = xmap ? slot : bid, step = xmap ? nslots : G, total = xmap ? gpx * 8 * nN : nM * nN;
  auto coords = [&](int L, int& tr0, int& fc0) {
    if (xmap) { int grp = xcd * gpx + L / (8 * nN), within = L % (8 * nN); tr0 = (grp * 8 + (within & 7)) * BM; fc0 = (within >> 3) * BM; }
    else { tr0 = (L % nM) * BM; fc0 = (L / nM) * BM; }
  };
  bool pre = false;
  for (int L = first; L < total; L += step) {
    int tr0, fc0, ntr0 = 0, nfc0 = 0;
    coords(L, tr0, fc0);
    bool hn = (L + step) < total;
    if (hn) coords(L + step, ntr0, nfc0);
    bool sw = epi.swap(fc0), nsw = epi.swap(nfc0);
    gemm_tile(sw ? Bt : A, sw ? A : Bt, K, sw ? fc0 : tr0, sw ? tr0 : fc0, shm, epi, tr0, fc0, sw, pre, hn,
              nsw ? Bt : A, nsw ? A : Bt, nsw ? nfc0 : ntr0, nsw ? ntr0 : nfc0, wv);
    pre = hn;
  }
}

__device__ __forceinline__ float row_rs(const float* part, int row) {
  const float4* q = (const float4*)(part + (long)row * 16);
  float4 a = q[0], b = q[1], c = q[2], d = q[3];
  float s = ((a.x + a.y) + (a.z + a.w)) + ((b.x + b.y) + (b.z + b.w)) + ((c.x + c.y) + (c.z + c.w)) + ((d.x + d.y) + (d.z + d.w));
  return rsqrtf(s * (1.f / DM) + EPS);
}
#define EPI_ARGS f32x4 (&acc)[2][2][4][2], int tr0, int fc0, bool sw, int wr, int wc, int fr, int fq
#define S_FEAT(ai, m) (fc0 + (ai) * 128 + wr * 64 + (m) * 16 + fq * 4)
#define S_TOK(bj, n) (tr0 + (bj) * 128 + wc * 32 + (n) * 16 + fr)
#define U_TOK(ai, m) (tr0 + (ai) * 128 + wr * 64 + (m) * 16 + fq * 4)
#define U_FEAT(bj, n) (fc0 + (bj) * 128 + wc * 32 + (n) * 16 + fr)

__device__ __forceinline__ uint2 pack4(float a, float b, float c, float d) { uint2 r; r.x = pk2(a, b); r.y = pk2(c, d); return r; }

struct EpiRes {
  u16* xb; float* part;
  __device__ __forceinline__ bool swap(int) const { return true; }
  __device__ __forceinline__ void operator()(EPI_ARGS) {
    _Pragma("unroll") for (int bj = 0; bj < 2; ++bj) _Pragma("unroll") for (int n = 0; n < 2; ++n) {
      int t = S_TOK(bj, n); float ss = 0.f;
      u16* xbp = xb + (long)t * DM;
      _Pragma("unroll") for (int ai = 0; ai < 2; ++ai) _Pragma("unroll") for (int m = 0; m < 4; ++m) {
        int f = S_FEAT(ai, m); f32x4 a = acc[ai][bj][m][n];
        uint2 xv = *(const uint2*)(xbp + f);
        float v0 = __uint_as_float(xv.x << 16) + a[0], v1 = __uint_as_float(xv.x & 0xffff0000u) + a[1];
        float v2 = __uint_as_float(xv.y << 16) + a[2], v3 = __uint_as_float(xv.y & 0xffff0000u) + a[3];
        *(uint2*)(xbp + f) = pack4(v0, v1, v2, v3);
        ss += v0 * v0 + v1 * v1 + v2 * v2 + v3 * v3;
      }
      ss += sx<16>(ss, fq * 16 + fr); ss += sx<32>(ss, fq * 16 + fr);
      if (fq == 0) part[(long)t * 16 + (fc0 >> 8) * 4 + wr] = ss;
      __builtin_amdgcn_sched_barrier(0);
    }
  }
};

struct EpiDaIn {
  const float* rowss; u16 *q, *k, *vT;
  __device__ __forceinline__ bool swap(int fc0) const { return (fc0 >> 10) < 2; }
  __device__ __forceinline__ void operator()(EPI_ARGS) {
    int sect = fc0 >> 10, cb = fc0 & 1023;
    if (sw) {
      u16* dst = sect ? k : q;
      _Pragma("unroll") for (int bj = 0; bj < 2; ++bj) _Pragma("unroll") for (int n = 0; n < 2; ++n) {
        int t = S_TOK(bj, n); float rs = row_rs(rowss, t); u16* d = dst + (long)t * DM + (cb - fc0);
        _Pragma("unroll") for (int ai = 0; ai < 2; ++ai) _Pragma("unroll") for (int m = 0; m < 4; ++m) {
          f32x4 a = acc[ai][bj][m][n]; *(uint2*)(d + S_FEAT(ai, m)) = pack4(a[0] * rs, a[1] * rs, a[2] * rs, a[3] * rs);
        }
      }
    } else {
      _Pragma("unroll") for (int ai = 0; ai < 2; ++ai) _Pragma("unroll") for (int m = 0; m < 4; ++m) {
        int r0 = U_TOK(ai, m); float rs[4];
        _Pragma("unroll") for (int j = 0; j < 4; ++j) rs[j] = row_rs(rowss, r0 + j);
        int b = r0 / SEQ, s0 = r0 % SEQ;
        _Pragma("unroll") for (int bj = 0; bj < 2; ++bj) _Pragma("unroll") for (int n = 0; n < 2; ++n) {
          int c = U_FEAT(bj, n) - fc0 + cb; f32x4 a = acc[ai][bj][m][n];
          *(uint2*)&vT[((long)(b * DM + c)) * SEQ + s0] = pack4(a[0] * rs[0], a[1] * rs[1], a[2] * rs[2], a[3] * rs[3]);
        }
        __builtin_amdgcn_sched_barrier(0);
      }
    }
  }
};

struct EpiHgIn {
  const float* rowss; const float* lbv; u16 *q, *logf_, *iT, *g;
  __device__ __forceinline__ bool swap(int fc0) const { return (fc0 >> 10) != 2; }
  __device__ __forceinline__ void operator()(EPI_ARGS) {
    int sect = fc0 >> 10, cb = fc0 & 1023;
    if (sw) {
      u16* dst = q + (long)sect * (32L << 20);
      _Pragma("unroll") for (int bj = 0; bj < 2; ++bj) _Pragma("unroll") for (int n = 0; n < 2; ++n) {
        int t = S_TOK(bj, n); float rs = row_rs(rowss, t); u16* d = dst + (long)t * DM + (cb - fc0);
        _Pragma("unroll") for (int ai = 0; ai < 2; ++ai) _Pragma("unroll") for (int m = 0; m < 4; ++m) {
          int f = S_FEAT(ai, m); f32x4 a = acc[ai][bj][m][n]; float v[4];
          if (sect == 0) { _Pragma("unroll") for (int j = 0; j < 4; ++j) v[j] = silu_f(a[j] * rs); }
          else if (sect == 1) {
            float4 lb = *(const float4*)&lbv[f - fc0 + cb]; float lbs[4] = {lb.x, lb.y, lb.z, lb.w};
            _Pragma("unroll") for (int j = 0; j < 4; ++j) v[j] = __logf(lbs[j] + (1.f - lbs[j]) * sigmoid_f(a[j] * rs));
          } else { _Pragma("unroll") for (int j = 0; j < 4; ++j) v[j] = a[j] * rs; }
          *(uint2*)(d + f) = pack4(v[0], v[1], v[2], v[3]);
        }
      }
    } else {
      _Pragma("unroll") for (int ai = 0; ai < 2; ++ai) _Pragma("unroll") for (int m = 0; m < 4; ++m) {
        int r0 = U_TOK(ai, m); float rs[4];
        _Pragma("unroll") for (int j = 0; j < 4; ++j) rs[j] = row_rs(rowss, r0 + j);
        _Pragma("unroll") for (int bj = 0; bj < 2; ++bj) _Pragma("unroll") for (int n = 0; n < 2; ++n) {
          int c = U_FEAT(bj, n) - fc0 + cb; f32x4 a = acc[ai][bj][m][n];
          *(uint2*)&iT[((long)(r0 >> 6) * DM + c) * 64 + (r0 & 63)] = pack4(a[0] * rs[0], a[1] * rs[1], a[2] * rs[2], a[3] * rs[3]);
        }
        __builtin_amdgcn_sched_barrier(0);
      }
    }
  }
};

__device__ __forceinline__ float gelu_f(float x) { return 0.5f * x * (1.f + erff(x * 0.70710678118654752f)); }

struct EpiSgIn {
  const float* rowss; u16 *u, *vT; float* rowss_v;
  __device__ __forceinline__ bool swap(int fc0) const { return (fc0 >> 10) == 0; }
  __device__ __forceinline__ void operator()(EPI_ARGS) {
    int cb = fc0 & 1023;
    if (sw) {
      _Pragma("unroll") for (int bj = 0; bj < 2; ++bj) _Pragma("unroll") for (int n = 0; n < 2; ++n) {
        int t = S_TOK(bj, n); float rs = row_rs(rowss, t); u16* d = u + (long)t * DM;
        _Pragma("unroll") for (int ai = 0; ai < 2; ++ai) _Pragma("unroll") for (int m = 0; m < 4; ++m) {
          f32x4 a = acc[ai][bj][m][n];
          *(uint2*)(d + S_FEAT(ai, m)) = pack4(gelu_f(a[0] * rs), gelu_f(a[1] * rs), gelu_f(a[2] * rs), gelu_f(a[3] * rs));
        }
      }
    } else {
      _Pragma("unroll") for (int ai = 0; ai < 2; ++ai) _Pragma("unroll") for (int m = 0; m < 4; ++m) {
        int r0 = U_TOK(ai, m); float rs[4], ss[4] = {0.f, 0.f, 0.f, 0.f};
        _Pragma("unroll") for (int j = 0; j < 4; ++j) rs[j] = row_rs(rowss, r0 + j);
        _Pragma("unroll") for (int bj = 0; bj < 2; ++bj) _Pragma("unroll") for (int n = 0; n < 2; ++n) {
          int c = U_FEAT(bj, n) - fc0 + cb; f32x4 a = acc[ai][bj][m][n];
          float gv[4]; _Pragma("unroll") for (int j = 0; j < 4; ++j) gv[j] = gelu_f(a[j] * rs[j]);
          *(uint2*)&vT[((long)(r0 >> 7) * DM + c) * 128 + (r0 & 127)] = pack4(gv[0], gv[1], gv[2], gv[3]);
          _Pragma("unroll") for (int j = 0; j < 4; ++j) ss[j] += gv[j] * gv[j];
        }
        _Pragma("unroll") for (int j = 0; j < 4; ++j) {
          float s = ss[j]; s += sx<1>(s, 0); s += sx<2>(s, 0); s += sx<4>(s, 0); s += sx<8>(s, 0);
          if (fr == 0) rowss_v[(long)(r0 + j) * 16 + (cb >> 8) * 4 + wc] = s;
        }
        __builtin_amdgcn_sched_barrier(0);
      }
    }
  }
};

struct EpiStore {
  const float* rowss; u16* dst; int ld;
  __device__ __forceinline__ bool swap(int) const { return true; }
  __device__ __forceinline__ void operator()(EPI_ARGS) {
    _Pragma("unroll") for (int bj = 0; bj < 2; ++bj) _Pragma("unroll") for (int n = 0; n < 2; ++n) {
      int t = S_TOK(bj, n); float rs = rowss ? row_rs(rowss, t) : 1.f; u16* d = dst + (long)t * ld;
      _Pragma("unroll") for (int ai = 0; ai < 2; ++ai) _Pragma("unroll") for (int m = 0; m < 4; ++m) {
        f32x4 a = acc[ai][bj][m][n]; *(uint2*)(d + S_FEAT(ai, m)) = pack4(a[0] * rs, a[1] * rs, a[2] * rs, a[3] * rs);
      }
    }
  }
};

struct EpiFfn {
  const float* rowss; u16* act;
  __device__ __forceinline__ bool swap(int) const { return true; }
  __device__ __forceinline__ void operator()(EPI_ARGS) {
    int tile = fc0 >> 8;
    _Pragma("unroll") for (int bj = 0; bj < 2; ++bj) _Pragma("unroll") for (int n = 0; n < 2; ++n) {
      int t = S_TOK(bj, n); float rs = row_rs(rowss, t); u16* d = act + (long)t * DFF + tile * 128 + wr * 64 + fq * 4;
      _Pragma("unroll") for (int m = 0; m < 4; ++m) {
        f32x4 g = acc[0][bj][m][n], u = acc[1][bj][m][n]; float v[4];
        _Pragma("unroll") for (int j = 0; j < 4; ++j) v[j] = silu_f(g[j] * rs) * (u[j] * rs);
        *(uint2*)(d + m * 16) = pack4(v[0], v[1], v[2], v[3]);
      }
    }
  }
};

struct EpiMemKV {
  u16 *K, *VT;
  __device__ __forceinline__ bool swap(int fc0) const { return (fc0 >> 10) == 0; }
  __device__ __forceinline__ void operator()(EPI_ARGS) {
    int cb = fc0 & 1023;
    if (sw) {
      _Pragma("unroll") for (int bj = 0; bj < 2; ++bj) _Pragma("unroll") for (int n = 0; n < 2; ++n) {
        int t = S_TOK(bj, n); u16* d = K + (long)t * DM;
        _Pragma("unroll") for (int ai = 0; ai < 2; ++ai) _Pragma("unroll") for (int m = 0; m < 4; ++m) {
          f32x4 a = acc[ai][bj][m][n]; *(uint2*)(d + S_FEAT(ai, m)) = pack4(a[0], a[1], a[2], a[3]);
        }
      }
    } else {
      _Pragma("unroll") for (int ai = 0; ai < 2; ++ai) _Pragma("unroll") for (int m = 0; m < 4; ++m) {
        int r0 = U_TOK(ai, m);
        _Pragma("unroll") for (int bj = 0; bj < 2; ++bj) _Pragma("unroll") for (int n = 0; n < 2; ++n) {
          int c = U_FEAT(bj, n) - fc0 + cb; f32x4 a = acc[ai][bj][m][n];
          *(uint2*)&VT[((long)((r0 >> 8) * DM + c)) * MEML + (r0 & 255)] = pack4(a[0], a[1], a[2], a[3]);
        }
      }
    }
  }
};

__device__ __forceinline__ void prep_phase(const Params& p, KArgsP kap, char* shm, int wv) {
  int tid = opaque_tid(wv), bid = blockIdx.x, G = gridDim.x;
  int lane = tid & 63, wid = tid >> 6;
  for (int row = bid * 8 + wid; row < T_TOK; row += G * 8) {
    const float4* src = (const float4*)(p.x + (long)row * DM);
    float ss = 0.f;
    _Pragma("unroll") for (int i = 0; i < 4; ++i) {
      float4 v = src[i * 64 + lane];
      ss += v.x * v.x + v.y * v.y + v.z * v.z + v.w * v.w;
      *(uint2*)&p.xb[(long)row * DM + (i * 64 + lane) * 4] = pack4(v.x, v.y, v.z, v.w);
    }
    ss = wave_sum(ss, lane);
    if (lane < 16) p.rpart[(long)row * 16 + lane] = (lane == 0) ? ss : 0.f;
  }
  for (int row = bid * 8 + wid; row < NB * MEML; row += G * 8) {
    const float4* src = (const float4*)(p.mem + (long)row * DM);
    float4 v[4]; float ss = 0.f;
    _Pragma("unroll") for (int i = 0; i < 4; ++i) { v[i] = src[i * 64 + lane]; ss += v[i].x * v[i].x + v[i].y * v[i].y + v[i].z * v[i].z + v[i].w * v[i].w; }
    ss = wave_sum(ss, lane);
    float rs = rsqrtf(ss * (1.f / DM) + EPS);
    _Pragma("unroll") for (int i = 0; i < 4; ++i) {
      float4 g = ((const float4*)p.norm_mem)[i * 64 + lane];
      *(uint2*)&p.memn[(long)row * DM + (i * 64 + lane) * 4] = pack4(v[i].x * rs * g.x, v[i].y * rs * g.y, v[i].z * rs * g.z, v[i].w * rs * g.w);
    }
  }
  if (bid == 0) {
    for (int i = tid; i < 3456; i += 512) ((unsigned*)((char*)p.xb - OFF_XB + OFF_BAR))[i] = 0u;
    for (int c = tid; c < DM; c += 512) {
      float v0 = p.hg_lb[c], v1 = p.hg_lb[DM + c], v2 = p.hg_lb[2 * DM + c], v3 = p.hg_lb[3 * DM + c];
      float mx = fmaxf(fmaxf(v0, v1), fmaxf(v2, v3));
      float e0 = expf(v0 - mx), e1 = expf(v1 - mx), e2 = expf(v2 - mx), e3 = expf(v3 - mx);
      p.lbv[c] = e1 / (e0 + e1 + e2 + e3);
    }
    for (int i = tid; i < 8 * 128; i += 512) {
      int h = i >> 7, n = i & 127, bucket;
      if (n < 16) bucket = n;
      else { float nf = (float)n; int lg = 16 + (int)(logf(nf / 16.f) / 2.0794415416798357f * 16.f); bucket = lg < 31 ? lg : 31; }
      p.biastab[i] = p.rel_bias[h * 32 + bucket] * LOG2E;
    }
  }
  float* tl = (float*)shm;
  for (int t = bid; t < kap->total_wtiles; t += G) {
    int wi = 0;
    while (wi + 1 < kap->nwd && kap->wd[wi + 1].tile0 <= t) ++wi;
    const float* src = kap->wd[wi].src; u16* dst = kap->wd[wi].dst; const float* gain = kap->wd[wi].gain;
    int K = kap->wd[wi].K, N = kap->wd[wi].N, perm = kap->wd[wi].perm;
    int lt = t - kap->wd[wi].tile0, nNt = N >> 6;
    int k0 = (lt / nNt) * 64, n0 = (lt % nNt) * 64;
    {
      int kk = tid >> 3, seg = (tid & 7) * 8;
      const float4* s4 = (const float4*)(src + (long)(k0 + kk) * N + n0 + seg);
      float4 a = s4[0], b = s4[1]; float g = gain ? gain[k0 + kk] : 1.f;
      float* d = tl + kk * 65 + seg;
      d[0] = a.x * g; d[1] = a.y * g; d[2] = a.z * g; d[3] = a.w * g; d[4] = b.x * g; d[5] = b.y * g; d[6] = b.z * g; d[7] = b.w * g;
    }
    __syncthreads();
    {
      int nn = tid >> 3, seg = (tid & 7) * 8;
      int n = n0 + nn, drow = n;
      if (perm) { int part = n / DFF, idx = n % DFF; drow = (idx >> 7) * 256 + part * 128 + (idx & 127); }
      float v[8]; _Pragma("unroll") for (int i = 0; i < 8; ++i) v[i] = tl[(seg + i) * 65 + nn];
      uint4 o; uint2 lo = pack4(v[0], v[1], v[2], v[3]), hi = pack4(v[4], v[5], v[6], v[7]);
      o.x = lo.x; o.y = lo.y; o.z = hi.x; o.w = hi.y;
      *(uint4*)&dst[(long)drow * K + k0 + seg] = o;
    }
    __syncthreads();
  }
}

template <int NC, int DQK, int DV, bool CAUSAL, bool PF>
__device__ __forceinline__ void flash_item(const u16* __restrict__ Qg, int q_stride, const u16* __restrict__ Kg, int k_stride,
                                           const u16* __restrict__ VTg, int vt_stride, int nkt, int q0, float scale_log2,
                                           const float* btab, float lam, const float* subln_g, float outscale,
                                           u16* __restrict__ Og, int o_stride, char* shm, int wv) {
  constexpr int KW = NC * DQK, KLD = KW + 8, VLD = 72;
  constexpr int KBUF = 64 * KLD, VBUF = DV * VLD;
  constexpr int KCH = KW / 8, KPT = 64 * KCH / 512, VPT = DV * 8 / 512;
  constexpr int NKS = DQK / 32, NVT = DV / 16;
  u16* Ks = (u16*)shm; u16* Vs = Ks + 2 * KBUF;
  int tid = opaque_tid(wv), wid = tid >> 6, lane = tid & 63, fr = lane & 15, fq = lane >> 4;
  int qw0 = q0 + wid * 16, qpos = qw0 + fr;

  bf16x8 qf[NC][NKS];
  _Pragma("unroll") for (int c = 0; c < NC; ++c) _Pragma("unroll") for (int ks = 0; ks < NKS; ++ks)
    qf[c][ks] = *(const bf16x8*)&Qg[(long)(wid * 16 + fr) * q_stride + c * DQK + ks * 32 + fq * 8];
  f32x4 O[NC][NVT];
  _Pragma("unroll") for (int c = 0; c < NC; ++c) _Pragma("unroll") for (int v = 0; v < NVT; ++v) O[c][v] = f32x4{0.f, 0.f, 0.f, 0.f};
  float mrun[NC], lsum[NC];
  _Pragma("unroll") for (int c = 0; c < NC; ++c) { mrun[c] = -1e30f; lsum[c] = 0.f; }

  u32x4 kreg[KPT], vreg[VPT];
#define FA_PREFETCH(kt_) do { int k0_ = (kt_) * 64; \
    _Pragma("unroll") for (int i = 0; i < KPT; ++i) { int id = tid + i * 512, row = id / KCH, cc = id % KCH; kreg[i] = *(const u32x4*)&Kg[(long)(k0_ + row) * k_stride + cc * 8]; } \
    _Pragma("unroll") for (int i = 0; i < VPT; ++i) { int id = tid + i * 512, row = id >> 3, cc = id & 7; vreg[i] = *(const u32x4*)&VTg[(long)row * vt_stride + k0_ + cc * 8]; } } while (0)
  if (PF) FA_PREFETCH(0);
  for (int kt = 0; kt < nkt; ++kt) {
    if (!PF) FA_PREFETCH(kt);
    u16* Kb = Ks + (kt & 1) * KBUF; u16* Vb = Vs + (kt & 1) * VBUF;
    _Pragma("unroll") for (int i = 0; i < KPT; ++i) { int id = tid + i * 512, row = id / KCH, cc = id % KCH; *(u32x4*)&Kb[row * KLD + cc * 8] = kreg[i]; }
    _Pragma("unroll") for (int i = 0; i < VPT; ++i) {
      int id = tid + i * 512, row = id >> 3, cc = id & 7;
      int pos = 32 * (cc >> 2) + 16 * (cc & 1) + 4 * ((cc >> 1) & 1);
      uint2 lo2, hi2; lo2.x = vreg[i][0]; lo2.y = vreg[i][1]; hi2.x = vreg[i][2]; hi2.y = vreg[i][3];
      *(uint2*)&Vb[row * VLD + pos] = lo2; *(uint2*)&Vb[row * VLD + pos + 8] = hi2;
    }
    __syncthreads();
    if (PF && kt + 1 < nkt) FA_PREFETCH(kt + 1);
    int k0 = kt * 64;
    if (CAUSAL && k0 > qw0 + 15) continue;
    bf16x8 pf[NC][2];
    _Pragma("unroll") for (int c = 0; c < NC; ++c) {
      f32x4 s[4];
      _Pragma("unroll") for (int m = 0; m < 4; ++m) s[m] = f32x4{0.f, 0.f, 0.f, 0.f};
      _Pragma("unroll") for (int ks = 0; ks < NKS; ++ks) _Pragma("unroll") for (int m = 0; m < 4; ++m) {
        bf16x8 a = *(const bf16x8*)&Kb[(16 * m + fr) * KLD + c * DQK + ks * 32 + fq * 8];
        s[m] = __builtin_amdgcn_mfma_f32_16x16x32_bf16(a, qf[c][ks], s[m], 0, 0, 0);
      }
      bool general = false; float bb = 0.f;
      if (CAUSAL) { general = (qw0 - (k0 + 63)) < 128; bb = btab[127]; }
      constexpr float THR = 8.f;
      float tnew, psum = 0.f;
      if (general) {
        bool diag = (k0 + 63) > qw0; float tmax = -1e30f;
        _Pragma("unroll") for (int m = 0; m < 4; ++m) _Pragma("unroll") for (int j = 0; j < 4; ++j) {
          int dist = qpos - (k0 + 16 * m + fq * 4 + j);
          int di = dist < 0 ? 0 : (dist > 127 ? 127 : dist);
          float v = s[m][j] * scale_log2 + btab[di];
          if (diag && dist < 0) v = -1e30f;
          s[m][j] = v; tmax = fmaxf(tmax, v);
        }
        tmax = fmaxf(tmax, sx<16>(tmax, lane)); tmax = fmaxf(tmax, sx<32>(tmax, lane));
        tnew = tmax;
      } else {
        float rmax = fmaxf(fmaxf(s[0][0], s[0][1]), fmaxf(s[0][2], s[0][3]));
        _Pragma("unroll") for (int m = 1; m < 4; ++m) rmax = fmaxf(rmax, fmaxf(fmaxf(s[m][0], s[m][1]), fmaxf(s[m][2], s[m][3])));
        rmax = fmaxf(rmax, sx<16>(rmax, lane)); rmax = fmaxf(rmax, sx<32>(rmax, lane));
        tnew = rmax * scale_log2 + bb;
      }
      if (__builtin_amdgcn_ballot_w64(tnew - mrun[c] > THR) != 0ull) {
        float mnew = fmaxf(mrun[c], tnew);
        float alpha = __builtin_amdgcn_exp2f(mrun[c] - mnew);
        mrun[c] = mnew; lsum[c] *= alpha;
        _Pragma("unroll") for (int v = 0; v < NVT; ++v) _Pragma("unroll") for (int j = 0; j < 4; ++j) O[c][v][j] *= alpha;
      }
      if (general) {
        float mm = mrun[c];
        _Pragma("unroll") for (int m = 0; m < 4; ++m) _Pragma("unroll") for (int j = 0; j < 4; ++j) { float pv = __builtin_amdgcn_exp2f(s[m][j] - mm); s[m][j] = pv; psum += pv; }
      } else {
        float cc = bb - mrun[c];
        _Pragma("unroll") for (int m = 0; m < 4; ++m) _Pragma("unroll") for (int j = 0; j < 4; ++j) { float pv = __builtin_amdgcn_exp2f(s[m][j] * scale_log2 + cc); s[m][j] = pv; psum += pv; }
      }
      lsum[c] += psum;
      _Pragma("unroll") for (int k2 = 0; k2 < 2; ++k2) {
        uint2 lo = pack4(s[2 * k2][0], s[2 * k2][1], s[2 * k2][2], s[2 * k2][3]);
        uint2 hi = pack4(s[2 * k2 + 1][0], s[2 * k2 + 1][1], s[2 * k2 + 1][2], s[2 * k2 + 1][3]);
        uint4 pk; pk.x = lo.x; pk.y = lo.y; pk.z = hi.x; pk.w = hi.y;
        pf[c][k2] = *(bf16x8*)&pk;
      }
    }
    _Pragma("unroll") for (int k2 = 0; k2 < 2; ++k2) _Pragma("unroll") for (int v = 0; v < NVT; ++v) {
      bf16x8 a = *(const bf16x8*)&Vb[(16 * v + fr) * VLD + 32 * k2 + fq * 8];
      _Pragma("unroll") for (int c = 0; c < NC; ++c) O[c][v] = __builtin_amdgcn_mfma_f32_16x16x32_bf16(a, pf[c][k2], O[c][v], 0, 0, 0);
      if ((v & 3) == 3) __builtin_amdgcn_sched_barrier(0);
    }
  }
  float inv[NC];
  _Pragma("unroll") for (int c = 0; c < NC; ++c) { float l = lsum[c]; l += sx<16>(l, lane); l += sx<32>(l, lane); inv[c] = 1.f / l; }
  u16* orow = Og + (long)(wid * 16 + fr) * o_stride;
  if (NC == 2) {
    float ss = 0.f;
    _Pragma("unroll") for (int v = 0; v < NVT; ++v) _Pragma("unroll") for (int j = 0; j < 4; ++j) { float o = O[0][v][j] * inv[0] - lam * O[NC - 1][v][j] * inv[NC - 1]; O[0][v][j] = o; ss += o * o; }
    ss += sx<16>(ss, lane); ss += sx<32>(ss, lane);
    float rs = rsqrtf(ss * (1.f / DV) + EPS) * outscale;
    _Pragma("unroll") for (int v = 0; v < NVT; ++v) {
      float4 g = *(const float4*)&subln_g[16 * v + fq * 4];
      *(uint2*)&orow[16 * v + fq * 4] = pack4(O[0][v][0] * rs * g.x, O[0][v][1] * rs * g.y, O[0][v][2] * rs * g.z, O[0][v][3] * rs * g.w);
    }
  } else {
    _Pragma("unroll") for (int v = 0; v < NVT; ++v)
      *(uint2*)&orow[16 * v + fq * 4] = pack4(O[0][v][0] * inv[0], O[0][v][1] * inv[0], O[0][v][2] * inv[0], O[0][v][3] * inv[0]);
  }
}

__device__ __forceinline__ void diff_attn_phase(const Params& p, int j, int layer_idx, char* shm, int wv) {
  int tid = opaque_tid(wv), lane = tid & 63;
  float* btab = (float*)(shm + LDS_BYTES - 1024);
  float sa = p.da_lq1[j * 64 + lane] * p.da_lk1[j * 64 + lane], sb = p.da_lq2[j * 64 + lane] * p.da_lk2[j * 64 + lane];
  sa = wave_sum(sa, lane); sb = wave_sum(sb, lane);
  float lam_init = 0.8f - 0.6f * expf(-0.3f * (float)layer_idx);
  float lam = expf(sa) - expf(sb) + lam_init;
  const u16 *qb = p.B0, *kb = p.B1, *vT = p.B2; u16* ao = p.B3;
  for (int i = blockIdx.x; i < 2048; i += gridDim.x) {
    int wgl = i & 255, step = i >> 8, xcd = wgl & 7, slot = wgl >> 3;
    int bh = xcd + 8 * (step >> 1), qblk = (step & 1) ? 63 - slot : slot;
    int b = bh >> 3, h = bh & 7, q0 = qblk * 128;
    __syncthreads();
    if (tid < 128) btab[tid] = p.biastab[h * 128 + tid];
    flash_item<2, 64, 128, true, true>(qb + ((long)(b * SEQ + q0)) * DM + h * 128, DM, kb + ((long)b * SEQ) * DM + h * 128, DM,
                                 vT + ((long)(b * DM + h * 128)) * SEQ, SEQ, q0 / 64 + 2, q0, 0.125f * LOG2E, btab, lam,
                                 p.da_subln + j * 128, 1.f - lam_init, ao + ((long)(b * SEQ + q0)) * DM + h * 128, DM, shm, wv);
  }
}

__device__ __forceinline__ void cross_attn_phase(const Params& p, int layer, char* shm, int wv) {
  const u16* caq = p.B0; u16* cao = p.B1;
  const u16* mK = p.memK + (long)layer * NB * MEML * DM; const u16* mVT = p.memVT + (long)layer * NB * DM * MEML;
  for (int i = blockIdx.x; i < 1024; i += gridDim.x) {
    int head = i & 3, blk = i >> 2, b = blk >> 6, qblk = blk & 63;
    __syncthreads();
    flash_item<1, 256, 256, false, true>(caq + ((long)(b * SEQ + qblk * 128)) * DM + head * 256, DM, mK + ((long)b * MEML) * DM + head * 256, DM,
                                   mVT + ((long)(b * DM + head * 256)) * MEML, MEML, 4, 0, 0.0625f * LOG2E, nullptr, 0.f, nullptr, 1.f,
                                   cao + ((long)(b * SEQ + qblk * 128)) * DM + head * 256, DM, shm, wv);
  }
}

constexpr int HLD = 132;
__device__ __forceinline__ long kdt_off(int tok0, int h, int k) {
  return ((long)(tok0 + (k >> 1)) * DM + h * 128) + (k & 1) * 64;
}

__device__ __forceinline__ void hg1_phase(const Params& p, char* shm, int wv) {
  float* L = (float*)shm; float* Gs = L + 64 * HLD; float* Qs = Gs + 64 * HLD; float* R = Qs + 64 * HLD;
  int tid = opaque_tid(wv), wid = tid >> 6, lane = tid & 63, fr = lane & 15, fq = lane >> 4;
  u16* qbuf = p.B0; u16* lfbuf = p.B1; u16* Abuf = p.B4;
  u32x4 plv[2], pqv[2];
#define HG1_PREFETCH(it_) do { int h_ = (it_) & 7, cn_ = ((it_) >> 3) & 127, b_ = (it_) >> 10, tk_ = b_ * SEQ + cn_ * 64; \
    _Pragma("unroll") for (int i = 0; i < 2; ++i) { int id = tid + i * 512, row = id >> 4, cc = id & 15; \
      plv[i] = *(const u32x4*)&lfbuf[(long)(tk_ + row) * DM + h_ * 128 + cc * 8]; pqv[i] = *(const u32x4*)&qbuf[(long)(tk_ + row) * DM + h_ * 128 + cc * 8]; } } while (0)
  if ((int)blockIdx.x < 4096) HG1_PREFETCH((int)blockIdx.x);
  for (int it = blockIdx.x; it < 4096; it += gridDim.x) {
    int h = it & 7, cn = (it >> 3) & 127, b = it >> 10, tok0 = b * SEQ + cn * 64;
    __syncthreads();
    _Pragma("unroll") for (int i = 0; i < 2; ++i) {
      int id = tid + i * 512, row = id >> 4, cc = id & 15;
      _Pragma("unroll") for (int e = 0; e < 4; ++e) {
        unsigned lw = plv[i][e], qw = pqv[i][e];
        L[row * HLD + cc * 8 + 2 * e] = __uint_as_float(lw << 16); L[row * HLD + cc * 8 + 2 * e + 1] = __uint_as_float(lw & 0xffff0000u);
        Qs[row * HLD + cc * 8 + 2 * e] = __uint_as_float(qw << 16); Qs[row * HLD + cc * 8 + 2 * e + 1] = __uint_as_float(qw & 0xffff0000u);
      }
    }
    __syncthreads();
    if (it + (int)gridDim.x < 4096) HG1_PREFETCH(it + (int)gridDim.x);
    {
      int k = tid & 127, qd = tid >> 7; float run = 0.f;
      _Pragma("unroll") for (int i = 0; i < 16; ++i) { run += L[(16 * qd + i) * HLD + k]; Gs[(16 * qd + i) * HLD + k] = run; }
      R[(qd + 1) * 128 + k] = run;
    }
    __syncthreads();
    {
      int k = tid & 127, qd = tid >> 7; float r = 0.f;
      for (int i = 0; i < qd; ++i) r += R[(i + 1) * 128 + k];
      float tot = R[(qd + 1) * 128 + k];
      __syncthreads();
      _Pragma("unroll") for (int i = 0; i < 16; ++i) Gs[(16 * qd + i) * HLD + k] += r;
      R[qd * 128 + k] = r;
      if (qd == 3) R[4 * 128 + k] = r + tot;
    }
    __syncthreads();
    _Pragma("unroll") for (int i = 0; i < 2; ++i) {
      int id = tid + i * 512, row = id >> 4, cc = id & 15; float v[8];
      _Pragma("unroll") for (int e = 0; e < 8; ++e) v[e] = Qs[row * HLD + cc * 8 + e] * __expf(Gs[row * HLD + cc * 8 + e]);
      uint2 lo = pack4(v[0], v[1], v[2], v[3]), hi = pack4(v[4], v[5], v[6], v[7]);
      uint4 o; o.x = lo.x; o.y = lo.y; o.z = hi.x; o.w = hi.y;
      *(uint4*)&qbuf[(long)(tok0 + row) * DM + h * 128 + cc * 8] = o;
    }
    _Pragma("unroll") for (int i = 0; i < 2; ++i) {
      int id = tid + i * 512, k = id & 127, sc = id >> 7; float gl = R[4 * 128 + k]; float v[8];
      _Pragma("unroll") for (int e = 0; e < 8; ++e) { int s = sc * 8 + e; v[e] = (1.f - __expf(L[s * HLD + k])) * __expf(gl - Gs[s * HLD + k]); }
      uint2 lo = pack4(v[0], v[1], v[2], v[3]), hi = pack4(v[4], v[5], v[6], v[7]);
      uint4 o; o.x = lo.x; o.y = lo.y; o.z = hi.x; o.w = hi.y;
      *(uint4*)&lfbuf[kdt_off(tok0, h, k) + sc * 8] = o;
    }
    if (tid < 128) p.dbuf[(long)it * 128 + tid] = __expf(R[4 * 128 + tid]);
    u16* Ait = Abuf + (long)it * 4096;
    for (int blk = wid; blk < 10; blk += 8) {
      int ti = blk < 1 ? 0 : (blk < 3 ? 1 : (blk < 6 ? 2 : 3));
      int sj = blk - (ti * (ti + 1)) / 2;
      f32x4 acc = {0.f, 0.f, 0.f, 0.f};
      _Pragma("unroll") for (int ks = 0; ks < 4; ++ks) {
        float av[8], bv[8];
        _Pragma("unroll") for (int e = 0; e < 8; ++e) {
          int kk = ks * 32 + fq * 8 + e; float rr = R[ti * 128 + kk];
          av[e] = Qs[(16 * ti + fr) * HLD + kk] * __expf(Gs[(16 * ti + fr) * HLD + kk] - rr);
          bv[e] = (1.f - __expf(L[(16 * sj + fr) * HLD + kk])) * __expf(fminf(rr - Gs[(16 * sj + fr) * HLD + kk], 80.f));
        }
        uint2 al = pack4(av[0], av[1], av[2], av[3]), ah = pack4(av[4], av[5], av[6], av[7]);
        uint2 bl = pack4(bv[0], bv[1], bv[2], bv[3]), bh = pack4(bv[4], bv[5], bv[6], bv[7]);
        uint4 a4, b4; a4.x = al.x; a4.y = al.y; a4.z = ah.x; a4.w = ah.y; b4.x = bl.x; b4.y = bl.y; b4.z = bh.x; b4.w = bh.y;
        acc = __builtin_amdgcn_mfma_f32_16x16x32_bf16(*(bf16x8*)&a4, *(bf16x8*)&b4, acc, 0, 0, 0);
      }
      _Pragma("unroll") for (int j = 0; j < 4; ++j) {
        int t = 16 * ti + fq * 4 + j, s = 16 * sj + fr;
        float v = (s <= t) ? acc[j] : 0.f;
        Ait[t * 64 + s] = f2bf(v);
      }
    }
    if (wid < 6) {
      int ti = wid < 3 ? 0 : (wid < 5 ? 1 : 2);
      int sj = wid < 3 ? wid + 1 : (wid < 5 ? wid - 1 : 3);
      _Pragma("unroll") for (int j = 0; j < 4; ++j) Ait[(16 * ti + fq * 4 + j) * 64 + 16 * sj + fr] = 0;
    }
  }
}

template <int MODE>
__device__ __forceinline__ void hg2_phase(const Params& p, char* shm, int wv) {
  constexpr int QLD = 136, KLD = 72;
  constexpr int QB = 64 * QLD, KB = 128 * KLD, AB = 64 * KLD, VB = 128 * KLD;
  constexpr int BUF_EL = QB + KB + AB + VB + 256;
  int tid = opaque_tid(wv), wid = tid >> 6, lane = tid & 63, fr = lane & 15, fq = lane >> 4;
  u16* qbuf = p.B0; const u16* kdbuf = p.B1; const u16* iT = p.B2; const u16* Abuf = p.B4;
  float* Send = p.out; float* Dseg = Send + 32L * 8 * 128 * 128;
  for (int it = blockIdx.x; it < 256; it += gridDim.x) {
    int bh = it >> 3, seg = it & 7, b = bh >> 3, h = bh & 7;
    if (MODE == 0 && seg == 7) continue;
    f32x4 S[8];
    _Pragma("unroll") for (int m = 0; m < 8; ++m) S[m] = f32x4{0.f, 0.f, 0.f, 0.f};
    if (MODE == 1) {
      for (int g = 0; g < seg; ++g) {
        const float* se = Send + ((long)(bh * 8 + g)) * 16384; const float* dg = Dseg + (bh * 8 + g) * 128;
        _Pragma("unroll") for (int m = 0; m < 8; ++m) {
          float4 dv = *(const float4*)&dg[16 * m + fq * 4];
          S[m][0] = S[m][0] * dv.x + se[(16 * m + fq * 4 + 0) * 128 + 16 * wid + fr];
          S[m][1] = S[m][1] * dv.y + se[(16 * m + fq * 4 + 1) * 128 + 16 * wid + fr];
          S[m][2] = S[m][2] * dv.z + se[(16 * m + fq * 4 + 2) * 128 + 16 * wid + fr];
          S[m][3] = S[m][3] * dv.w + se[(16 * m + fq * 4 + 3) * 128 + 16 * wid + fr];
        }
      }
    }
    float dacc = 1.f;
    u32x4 rq[2], rk[2], ra, rv[2]; f32x4 rd = {0.f, 0.f, 0.f, 0.f};
#define HG_PREFETCH(cn_) do { int tok0_ = b * SEQ + (cn_) * 64; long it_ = ((long)(b * 128 + (cn_))) * 8 + h; \
      if (MODE == 1) { _Pragma("unroll") for (int i = 0; i < 2; ++i) { int id = tid + i * 512, row = id >> 4, cc = id & 15; rq[i] = *(const u32x4*)&qbuf[(long)(tok0_ + row) * DM + h * 128 + cc * 8]; } } \
      _Pragma("unroll") for (int i = 0; i < 2; ++i) { int id = tid + i * 512, k = id >> 3, sc = id & 7; rk[i] = *(const u32x4*)&kdbuf[kdt_off(tok0_, h, k) + sc * 8]; } \
      if (MODE == 1) { int t = tid >> 3, sc = tid & 7; ra = *(const u32x4*)&Abuf[it_ * 4096 + t * 64 + sc * 8]; } \
      _Pragma("unroll") for (int i = 0; i < 2; ++i) { int id = tid + i * 512, v = id >> 3, sc = id & 7; rv[i] = *(const u32x4*)&iT[((long)(b * 128 + (cn_)) * DM + h * 128 + v) * 64 + sc * 8]; } \
      if (tid < 32) rd = *(const f32x4*)&p.dbuf[it_ * 128 + tid * 4]; } while (0)
#define HG_STASH(bi_) do { \
      u16* base_ = (u16*)shm + (bi_) * BUF_EL; u16* Qt_ = base_; u16* Kd_ = Qt_ + QB; u16* At_ = Kd_ + KB; u16* Vt_ = At_ + AB; float* dd_ = (float*)(Vt_ + VB); \
      if (MODE == 1) { _Pragma("unroll") for (int i = 0; i < 2; ++i) { int id = tid + i * 512, row = id >> 4, cc = id & 15; *(u32x4*)&Qt_[row * QLD + cc * 8] = rq[i]; } } \
      _Pragma("unroll") for (int i = 0; i < 2; ++i) { int id = tid + i * 512, k = id >> 3, sc = id & 7; *(u32x4*)&Kd_[k * KLD + sc * 8] = rk[i]; } \
      if (MODE == 1) { int t = tid >> 3, sc = tid & 7; *(u32x4*)&At_[t * KLD + sc * 8] = ra; } \
      _Pragma("unroll") for (int i = 0; i < 2; ++i) { int id = tid + i * 512, v = id >> 3, sc = id & 7; *(u32x4*)&Vt_[v * KLD + sc * 8] = rv[i]; } \
      if (tid < 32) *(f32x4*)&dd_[tid * 4] = rd; } while (0)
    __syncthreads();
    HG_PREFETCH(seg * 16); HG_STASH(0);
    for (int c = 0; c < 16; ++c) {
      int cn = seg * 16 + c;
      __syncthreads();
      if (c + 1 < 16) HG_PREFETCH(cn + 1);
      u16* base = (u16*)shm + (c & 1) * BUF_EL; u16* Qt = base; u16* Kd = Qt + QB; u16* At = Kd + KB; u16* Vt = At + AB; float* dd = (float*)(Vt + VB);
      bf16x8 vb[2];
      _Pragma("unroll") for (int k2 = 0; k2 < 2; ++k2) vb[k2] = *(const bf16x8*)&Vt[(16 * wid + fr) * KLD + k2 * 32 + fq * 8];
      if (MODE == 1) {
        bf16x8 Sb[4];
        _Pragma("unroll") for (int ks = 0; ks < 4; ++ks) {
          uint2 lo = pack4(S[2 * ks][0], S[2 * ks][1], S[2 * ks][2], S[2 * ks][3]);
          uint2 hi = pack4(S[2 * ks + 1][0], S[2 * ks + 1][1], S[2 * ks + 1][2], S[2 * ks + 1][3]);
          uint4 pk; pk.x = lo.x; pk.y = lo.y; pk.z = hi.x; pk.w = hi.y; Sb[ks] = *(bf16x8*)&pk;
        }
        int tok0 = b * SEQ + cn * 64;
        _Pragma("unroll") for (int rt = 0; rt < 4; ++rt) {
          f32x4 o = {0.f, 0.f, 0.f, 0.f};
          _Pragma("unroll") for (int ks = 0; ks < 4; ++ks) {
            uint2 lo = *(const uint2*)&Qt[(16 * rt + fr) * QLD + 32 * ks + fq * 4];
            uint2 hi = *(const uint2*)&Qt[(16 * rt + fr) * QLD + 32 * ks + 16 + fq * 4];
            uint4 pk; pk.x = lo.x; pk.y = lo.y; pk.z = hi.x; pk.w = hi.y;
            o = __builtin_amdgcn_mfma_f32_16x16x32_bf16(*(bf16x8*)&pk, Sb[ks], o, 0, 0, 0);
          }
          _Pragma("unroll") for (int k2 = 0; k2 < 2; ++k2) {
            bf16x8 a = *(const bf16x8*)&At[(16 * rt + fr) * KLD + k2 * 32 + fq * 8];
            o = __builtin_amdgcn_mfma_f32_16x16x32_bf16(a, vb[k2], o, 0, 0, 0);
          }
          _Pragma("unroll") for (int j = 0; j < 4; ++j) qbuf[(long)(tok0 + 16 * rt + fq * 4 + j) * DM + h * 128 + 16 * wid + fr] = f2bf(o[j]);
        }
      } else if (tid < 128) dacc *= dd[tid];
      _Pragma("unroll") for (int m = 0; m < 8; ++m) {
        float4 dv = *(const float4*)&dd[16 * m + fq * 4];
        S[m][0] *= dv.x; S[m][1] *= dv.y; S[m][2] *= dv.z; S[m][3] *= dv.w;
        _Pragma("unroll") for (int k2 = 0; k2 < 2; ++k2) {
          bf16x8 a = *(const bf16x8*)&Kd[(16 * m + fr) * KLD + k2 * 32 + fq * 8];
          S[m] = __builtin_amdgcn_mfma_f32_16x16x32_bf16(a, vb[k2], S[m], 0, 0, 0);
        }
      }
      if (c + 1 < 16) HG_STASH((c + 1) & 1);
    }
    if (MODE == 0) {
      float* se = Send + ((long)(bh * 8 + seg)) * 16384;
      _Pragma("unroll") for (int m = 0; m < 8; ++m) _Pragma("unroll") for (int j = 0; j < 4; ++j) se[(16 * m + fq * 4 + j) * 128 + 16 * wid + fr] = S[m][j];
      if (tid < 128) Dseg[(bh * 8 + seg) * 128 + tid] = dacc;
    }
  }
}

__device__ __forceinline__ void hg3_phase(const Params& p, int wv) {
  int tid = opaque_tid(wv); int wid = tid >> 6, lane = tid & 63;
  u16* ob = p.B0; const u16* gb = p.B3;
  for (int row = blockIdx.x * 8 + wid; row < T_TOK; row += gridDim.x * 8) {
    uint4 o0 = *(const uint4*)&ob[(long)row * DM + lane * 16], o1 = *(const uint4*)&ob[(long)row * DM + lane * 16 + 8];
    uint4 g0 = *(const uint4*)&gb[(long)row * DM + lane * 16], g1 = *(const uint4*)&gb[(long)row * DM + lane * 16 + 8];
    float o[16], g[16];
    const u16* po0 = (const u16*)&o0; const u16* po1 = (const u16*)&o1; const u16* pg0 = (const u16*)&g0; const u16* pg1 = (const u16*)&g1;
    _Pragma("unroll") for (int e = 0; e < 8; ++e) { o[e] = bf2f(po0[e]); o[8 + e] = bf2f(po1[e]); g[e] = bf2f(pg0[e]); g[8 + e] = bf2f(pg1[e]); }
    float ss = 0.f; _Pragma("unroll") for (int e = 0; e < 16; ++e) ss += o[e] * o[e];
    ss += sx<1>(ss, lane); ss += sx<2>(ss, lane); ss += sx<4>(ss, lane);
    float rs = rsqrtf(ss * (1.f / 128.f) + EPS);
    int c0 = (lane & 7) * 16; float r[16];
    _Pragma("unroll") for (int e = 0; e < 16; ++e) r[e] = o[e] * rs * p.hg_onorm[c0 + e] * silu_f(g[e]);
    uint2 a = pack4(r[0], r[1], r[2], r[3]), b2 = pack4(r[4], r[5], r[6], r[7]), c = pack4(r[8], r[9], r[10], r[11]), d = pack4(r[12], r[13], r[14], r[15]);
    uint4 w0, w1; w0.x = a.x; w0.y = a.y; w0.z = b2.x; w0.w = b2.y; w1.x = c.x; w1.y = c.y; w1.z = d.x; w1.w = d.y;
    *(uint4*)&ob[(long)row * DM + lane * 16] = w0; *(uint4*)&ob[(long)row * DM + lane * 16 + 8] = w1;
  }
}

__device__ __forceinline__ void sgu_phase(const Params& p, char* shm, int wv) {
  constexpr int WLD = 136;
  u16* Wp = (u16*)shm; float* rsv = (float*)(shm + 128 * WLD * 2);
  int tid = opaque_tid(wv), wid = tid >> 6, lane = tid & 63, fr = lane & 15, fq = lane >> 4;
  const u16* ub = p.B0; const u16* vT = p.B1; u16* ob = p.B2; const float* rowss_v = p.vpart;
  for (int it = blockIdx.x; it < 2048; it += gridDim.x) {
    int g = it & 7, c128 = it >> 3, tok0 = c128 * 128;
    __syncthreads();
    if (tid < 128) rsv[tid] = row_rs(rowss_v, tok0 + tid);
    __syncthreads();
    _Pragma("unroll") for (int i = 0; i < 4; ++i) {
      int id = tid + i * 512, t = id >> 4, sc = id & 15;
      const float4* w4 = (const float4*)(p.sg_w_s + ((long)(g * 128 + t)) * 128 + sc * 8);
      float4 a = w4[0], b = w4[1]; float v[8] = {a.x, a.y, a.z, a.w, b.x, b.y, b.z, b.w};
      _Pragma("unroll") for (int e = 0; e < 8; ++e) { int s = sc * 8 + e; v[e] = (s <= t) ? v[e] * rsv[s] : 0.f; }
      uint2 lo = pack4(v[0], v[1], v[2], v[3]), hi = pack4(v[4], v[5], v[6], v[7]);
      uint4 o; o.x = lo.x; o.y = lo.y; o.z = hi.x; o.w = hi.y;
      *(uint4*)&Wp[t * WLD + sc * 8] = o;
    }
    bf16x8 vb[4];
    int cc = g * 128 + 16 * wid + fr;
    _Pragma("unroll") for (int ks = 0; ks < 4; ++ks) vb[ks] = *(const bf16x8*)&vT[((long)c128 * DM + cc) * 128 + ks * 32 + fq * 8];
    float4 gvn = *(const float4*)&p.sg_vnorm[g * 128 + 16 * wid + fq * 4];
    __syncthreads();
    _Pragma("unroll") for (int mt = 0; mt < 8; ++mt) {
      f32x4 acc = {0.f, 0.f, 0.f, 0.f};
      _Pragma("unroll") for (int ks = 0; ks <= (mt >> 1); ++ks) {
        bf16x8 a = *(const bf16x8*)&Wp[(16 * mt + fr) * WLD + ks * 32 + fq * 8];
        acc = __builtin_amdgcn_mfma_f32_16x16x32_bf16(vb[ks], a, acc, 0, 0, 0);
      }
      int t = 16 * mt + fr; float bs = p.sg_b_s[g * 128 + t];
      long idx = (long)(tok0 + t) * DM + g * 128 + 16 * wid + fq * 4;
      uint2 uv = *(const uint2*)&ub[idx];
      float u0 = __uint_as_float(uv.x << 16), u1 = __uint_as_float(uv.x & 0xffff0000u), u2 = __uint_as_float(uv.y << 16), u3 = __uint_as_float(uv.y & 0xffff0000u);
      *(uint2*)&ob[idx] = pack4(u0 * (acc[0] * gvn.x + bs), u1 * (acc[1] * gvn.y + bs), u2 * (acc[2] * gvn.z + bs), u3 * (acc[3] * gvn.w + bs));
    }
  }
}

__device__ __forceinline__ void final_phase(const Params& p, int wv) {
  int tid = opaque_tid(wv); int wid = tid >> 6, lane = tid & 63;
  for (int row = blockIdx.x * 8 + wid; row < T_TOK; row += gridDim.x * 8) {
    float rs = row_rs(p.rpart, row);
    float4* o4 = (float4*)(p.out + (long)row * DM);
    const uint2* x2 = (const uint2*)(p.xb + (long)row * DM);
    _Pragma("unroll") for (int i = 0; i < 4; ++i) {
      uint2 xv = x2[i * 64 + lane]; float4 g = ((const float4*)p.norm_final)[i * 64 + lane]; float4 v;
      v.x = __uint_as_float(xv.x << 16) * rs * g.x; v.y = __uint_as_float(xv.x & 0xffff0000u) * rs * g.y;
      v.z = __uint_as_float(xv.y << 16) * rs * g.z; v.w = __uint_as_float(xv.y & 0xffff0000u) * rs * g.w;
      o4[i * 64 + lane] = v;
    }
  }
}

#define XB_TMO      128
#define XB_XCNT(j)  (256  + 64 * (j))
#define XB_XSUB(j)  (1280 + 64 * (j))
#define XB_XGEN(j)  (2304 + 64 * (j))
#define XB_TOP      3328
#define XB_TOPGEN   3392
#define XCD_BAR_WORDS 3456
#define XB_SPIN_CAP (1u << 22)
#define LAS __attribute__((address_space(3)))

__device__ __forceinline__ unsigned xb_ld(unsigned* p)              { return __hip_atomic_load(p, __ATOMIC_RELAXED, __HIP_MEMORY_SCOPE_AGENT); }
__device__ __forceinline__ unsigned xb_add(unsigned* p, unsigned v) { return __hip_atomic_fetch_add(p, v, __ATOMIC_RELAXED, __HIP_MEMORY_SCOPE_AGENT); }
__device__ __forceinline__ unsigned xb_xcc_id() { return (unsigned)__builtin_amdgcn_s_getreg((3 << 11) | 20) & 0xFu; }
#define XB_SPIN(cond, bar) do { unsigned _sp = 0; while (cond) { __builtin_amdgcn_s_sleep(1); \
    if ((++_sp & 255u) == 0u) { if (xb_ld(&(bar)[XB_TMO])) break; if (_sp > XB_SPIN_CAP) { atomicAdd(&(bar)[XB_TMO], 1u); break; } } } } while (0)

struct XcdBarrier {
    unsigned* bar; unsigned x;
    volatile LAS unsigned* st;
};

__device__ __forceinline__ XcdBarrier xcd_barrier_post(unsigned* bar, volatile LAS unsigned* st, bool t0) {
    XcdBarrier b; b.bar = bar; b.x = xb_xcc_id(); b.st = st;
    if (t0) (void)xb_add(&bar[XB_XCNT(b.x)], 1u);
    return b;
}
__device__ __forceinline__ void xcd_barrier_complete(unsigned* bar, unsigned x, unsigned& nloc, unsigned& nx) {
    const unsigned G = gridDim.x * gridDim.y * gridDim.z;
    unsigned sum, cnt, mine, sp = 0u;
    for (;;) {
        sum = 0u; cnt = 0u; mine = 0u;
#pragma unroll
        for (unsigned j = 0; j < 16; ++j) { const unsigned c = xb_ld(&bar[XB_XCNT(j)]); sum += c; cnt += (c > 0u) ? 1u : 0u; mine = (j == x) ? c : mine; }
        if (sum == G) break;
        __builtin_amdgcn_s_sleep(1);
        if ((++sp & 255u) == 0u) { if (xb_ld(&bar[XB_TMO])) break; if (sp > XB_SPIN_CAP) { atomicAdd(&bar[XB_TMO], 1u); break; } }
    }
    nloc = mine > 0u ? mine : 1u; nx = cnt > 0u ? cnt : 1u;
}

__device__ __forceinline__ void xcd_barrier(const XcdBarrier& b, bool t0) {
    asm volatile("s_waitcnt vmcnt(0)" ::: "memory");
    __syncthreads();
    if (t0) {
        unsigned* bar = b.bar;
        __builtin_amdgcn_s_waitcnt(0);
        unsigned nloc = b.st[0], nx = b.st[1];
        if (nloc == 0u) { xcd_barrier_complete(bar, b.x, nloc, nx); b.st[0] = nloc; b.st[1] = nx; }
        const unsigned old = xb_add(&bar[XB_XSUB(b.x)], 1u);
        const unsigned gen = old / nloc;
        if (old + 1u == (gen + 1u) * nloc) {
            __builtin_amdgcn_fence(__ATOMIC_RELEASE, "agent");
            asm volatile("s_waitcnt vmcnt(0)" ::: "memory");
            const unsigned og = xb_add(&bar[XB_TOP], 1u);
            const unsigned tg = og / nx;
            if (og + 1u == (tg + 1u) * nx) xb_add(&bar[XB_TOPGEN], 1u);
            else XB_SPIN(xb_ld(&bar[XB_TOPGEN]) == tg, bar);
            __builtin_amdgcn_fence(__ATOMIC_ACQUIRE, "agent");
            xb_add(&bar[XB_XGEN(b.x)], 1u);
            asm volatile("s_waitcnt vmcnt(0)" ::: "memory");
        } else {
            XB_SPIN(xb_ld(&bar[XB_XGEN(b.x)]) == gen, bar);
            __builtin_amdgcn_fence(__ATOMIC_ACQUIRE, "agent");
            asm volatile("s_waitcnt vmcnt(0)" ::: "memory");
        }
    }
    __syncthreads();
}


#define SEL4(arr, i) ((i) == 0 ? (arr)[0] : ((i) == 1 ? (arr)[1] : ((i) == 2 ? (arr)[2] : (arr)[3])))
__global__ void __launch_bounds__(512, 2) fwd_megakernel(KArgs ka_unused) {
  extern __shared__ __attribute__((aligned(16))) char shm[];
  const int wv = __builtin_amdgcn_readfirstlane((int)(threadIdx.x >> 6));
  int ph = 0;
#define BARRIER_WS ((unsigned*)(kargs_ptr()->ws + OFF_BAR))
#if MULTI_LAUNCH
#define PHASE_BEGIN if (ph >= kargs_ptr()->phase_lo && ph < kargs_ptr()->phase_hi) { const Params p = make_params(*kargs_ptr());
#define PHASE_END } ++ph;
#else
  cg::grid_group grid = cg::this_grid();
#define PHASE_BEGIN { const Params p = make_params(*kargs_ptr());
#define PHASE_END } ++ph; { XcdBarrier xb_; xb_.bar = BARRIER_WS; xb_.x = xb_xcc_id(); xb_.st = (volatile LAS unsigned*)(shm + LDS_BYTES - 16); xcd_barrier(xb_, opaque_tid(wv) == 0); }
#endif
#define LAYER_VARS \
    const float* xin = (i == 0) ? p.x : p.out; float* rs_mix = p.rpart; float* rs_cross = p.rpart; float* rs_ffn = p.rpart; float* rs_next = p.rpart; \
    const u16* w_mix_in = p.wbase + layer_woff(i); const u16* w_mix_out = w_mix_in + mixin_elems(i); const u16* w_caq = w_mix_out + 1048576L; \
    const u16* w_cao = w_caq + 3145728L; const u16* w_gu = w_cao + 1048576L; const u16* w_down = w_gu + 5767168L; \
    const u16* mix_out_A = kind == 0 ? p.B3 : (kind == 1 ? p.B0 : p.B2); \
    (void)xin; (void)rs_mix; (void)rs_cross; (void)rs_ffn; (void)rs_next; (void)w_mix_in; (void)w_mix_out; (void)w_caq; (void)w_cao; (void)w_gu; (void)w_down; (void)mix_out_A;
#if MULTI_LAUNCH
  PHASE_BEGIN prep_phase(p, kargs_ptr(), shm, wv); PHASE_END
#else
  { const Params p = make_params(*kargs_ptr()); prep_phase(p, kargs_ptr(), shm, wv); } ++ph;
  grid.sync();
  {
    volatile LAS unsigned* xb_st = (volatile LAS unsigned*)(shm + LDS_BYTES - 16);
    if (opaque_tid(wv) == 0) { xb_st[0] = 0u; xb_st[1] = 0u; }
    __syncthreads();
    (void)xcd_barrier_post(BARRIER_WS, xb_st, opaque_tid(wv) == 0);
  }
#endif
  _Pragma("nounroll") for (int i = 0; i < 4; ++i) {
    int kind = i % 3, j = i / 3;
    if (kind == 0) {
      PHASE_BEGIN LAYER_VARS
        if (i == 0) {
          for (int t = blockIdx.x; t < 128; t += gridDim.x) {
            int l = t >> 5, tt = t & 31, tr0 = (tt & 3) * BM, fc0 = (tt >> 2) * BM;
            EpiMemKV em{p.memK + (long)l * NB * MEML * DM, p.memVT + (long)l * NB * DM * MEML};
            const u16* mA = p.memn; const u16* mB = p.wbase + layer_woff(l) + mixin_elems(l) + 2097152L;
            bool sw = em.swap(fc0);
            gemm_tile(sw ? mB : mA, sw ? mA : mB, DM, sw ? fc0 : tr0, sw ? tr0 : fc0, shm, em, tr0, fc0, sw, false, false, mA, mB, 0, 0, wv);
          }
        }
        EpiDaIn e{rs_mix, p.B0, p.B1, p.B2}; gemm_phase(p.xb, w_mix_in, T_TOK, 3 * DM, DM, shm, e, wv);
      PHASE_END
      PHASE_BEGIN diff_attn_phase(p, j, i, shm, wv); PHASE_END
    } else if (kind == 1) {
      PHASE_BEGIN LAYER_VARS EpiHgIn e{rs_mix, p.lbv, p.B0, p.B1, p.B2, p.B3}; gemm_phase(p.xb, w_mix_in, T_TOK, 4 * DM, DM, shm, e, wv); PHASE_END
      PHASE_BEGIN hg1_phase(p, shm, wv); PHASE_END
      PHASE_BEGIN hg2_phase<0>(p, shm, wv); PHASE_END
      PHASE_BEGIN hg2_phase<1>(p, shm, wv); PHASE_END
      PHASE_BEGIN hg3_phase(p, wv); PHASE_END
    } else {
      PHASE_BEGIN LAYER_VARS EpiSgIn e{rs_mix, p.B0, p.B1, p.vpart}; gemm_phase(p.xb, w_mix_in, T_TOK, 2 * DM, DM, shm, e, wv); PHASE_END
      PHASE_BEGIN sgu_phase(p, shm, wv); PHASE_END
    }
    PHASE_BEGIN LAYER_VARS EpiRes e{p.xb, rs_cross}; gemm_phase(mix_out_A, w_mix_out, T_TOK, DM, DM, shm, e, wv); PHASE_END
    PHASE_BEGIN LAYER_VARS EpiStore e{rs_cross, p.B0, DM}; gemm_phase(p.xb, w_caq, T_TOK, DM, DM, shm, e, wv); PHASE_END
    PHASE_BEGIN cross_attn_phase(p, i, shm, wv); PHASE_END
    PHASE_BEGIN LAYER_VARS EpiRes e{p.xb, rs_ffn}; gemm_phase(p.B1, w_cao, T_TOK, DM, DM, shm, e, wv); PHASE_END
    PHASE_BEGIN LAYER_VARS EpiFfn e{rs_ffn, p.B0}; gemm_phase(p.xb, w_gu, T_TOK, 2 * DFF, DM, shm, e, wv); PHASE_END
    PHASE_BEGIN LAYER_VARS EpiRes e{p.xb, rs_next}; gemm_phase(p.B0, w_down, T_TOK, DM, DFF, shm, e, wv); PHASE_END
  }
#if MULTI_LAUNCH
  PHASE_BEGIN final_phase(p, wv); PHASE_END
#else
  { const Params p = make_params(*kargs_ptr()); final_phase(p, wv); }
#endif
}

extern "C" void kernel_launch(void* const* d_in, const int* in_sizes, int n_in, void* d_out, int out_size, void* d_ws, size_t ws_size,
                              hipStream_t stream) {
  static int grid_blocks = 0;
  if (!grid_blocks) {
    int dev = 0, cus = 0, per_cu = 0;
    hipGetDevice(&dev);
    hipDeviceGetAttribute(&cus, hipDeviceAttributeMultiprocessorCount, dev);
    if (hipFuncSetAttribute((const void*)fwd_megakernel, hipFuncAttributeMaxDynamicSharedMemorySize, LDS_BYTES) != hipSuccess)
      fprintf(stderr, "hipFuncSetAttribute failed\n");
    hipOccupancyMaxActiveBlocksPerMultiprocessor(&per_cu, (const void*)fwd_megakernel, 512, LDS_BYTES);
    if (per_cu < 1) { fprintf(stderr, "occupancy query returned %d\n", per_cu); per_cu = 1; }
    grid_blocks = cus * per_cu;
    (void)hipGetLastError();
  }
  KArgs p;
  memset(&p, 0, sizeof(p));
  const float* const* in = (const float* const*)d_in;
  p.x = in[0]; p.mem = in[1]; p.rel_bias = in[2];
  const float *norm_mix = in[3], *norm_cross = in[4], *norm_ffn = in[5];
  p.norm_mem = in[6]; p.norm_final = in[7];
  const float *da_w_in = in[8], *da_w_out = in[9];
  p.da_lq1 = in[10]; p.da_lk1 = in[11]; p.da_lq2 = in[12]; p.da_lk2 = in[13]; p.da_subln = in[14];
  const float *hg_w_in = in[15], *hg_w_out = in[16];
  p.hg_lb = in[17]; p.hg_onorm = in[18];
  const float *sg_w_in = in[19], *sg_w_out = in[20];
  p.sg_vnorm = in[21]; p.sg_w_s = in[22]; p.sg_b_s = in[23];
  const float *ca_w_q = in[24], *ca_w_kv = in[25], *ca_w_o = in[26], *ffn_w_gu = in[27], *ffn_w_down = in[28];
  p.out = (float*)d_out; p.ws = (char*)d_ws;
  if (WS_END > ws_size) { fprintf(stderr, "workspace too small: need %zu have %zu\n", (size_t)WS_END, ws_size); return; }
  int nwd = 0, tiles = 0;
  u16* wcur = (u16*)((char*)d_ws + OFF_W);
  auto addw = [&](const float* src, int K, int N, const float* gain, int perm) {
    WDesc& w = p.wd[nwd++]; w.src = src; w.dst = wcur; w.gain = gain; w.K = K; w.N = N; w.perm = perm; w.tile0 = tiles;
    tiles += (K / 64) * (N / 64); wcur += (size_t)K * N;
  };
  for (int i = 0; i < 4; ++i) {
    int kind = i % 3, j = i / 3;
    if (wcur != (u16*)((char*)d_ws + OFF_W) + layer_woff(i)) fprintf(stderr, "weight layout mismatch at layer %d\n", i);
    if (kind == 0) { addw(da_w_in + (size_t)j * DM * 3 * DM, DM, 3 * DM, norm_mix + i * DM, 0); addw(da_w_out + (size_t)j * DM * DM, DM, DM, nullptr, 0); }
    else if (kind == 1) { addw(hg_w_in + (size_t)j * DM * 4 * DM, DM, 4 * DM, norm_mix + i * DM, 0); addw(hg_w_out + (size_t)j * DM * DM, DM, DM, nullptr, 0); }
    else { addw(sg_w_in + (size_t)j * DM * 2 * DM, DM, 2 * DM, norm_mix + i * DM, 0); addw(sg_w_out + (size_t)j * DM * DM, DM, DM, nullptr, 0); }
    addw(ca_w_q + (size_t)i * DM * DM, DM, DM, norm_cross + i * DM, 0);
    addw(ca_w_kv + (size_t)i * DM * 2 * DM, DM, 2 * DM, nullptr, 0);
    addw(ca_w_o + (size_t)i * DM * DM, DM, DM, nullptr, 0);
    addw(ffn_w_gu + (size_t)i * DM * 2 * DFF, DM, 2 * DFF, norm_ffn + i * DM, 1);
    addw(ffn_w_down + (size_t)i * DFF * DM, DFF, DM, nullptr, 0);
  }
  p.nwd = nwd; p.total_wtiles = tiles;
#if MULTI_LAUNCH
  _Pragma("unroll") for (int ph = 0; ph < 64; ++ph) {
    p.phase_lo = ph; p.phase_hi = ph + 1;
    hipLaunchKernelGGL(fwd_megakernel, dim3(grid_blocks), dim3(512), LDS_BYTES, stream, p);
  }
#else
  p.phase_lo = 0; p.phase_hi = 1 << 30;
  void* args[] = {&p};
  hipError_t e = hipLaunchCooperativeKernel((void*)fwd_megakernel, dim3(grid_blocks), dim3(512), args, LDS_BYTES, stream);
  if (e != hipSuccess) fprintf(stderr, "cooperative launch failed: %s (grid %d)\n", hipGetErrorString(e), grid_blocks);
#endif
}
```

```cpp
#include <hip/hip_runtime.h>
#include <hip/hip_cooperative_groups.h>
#include <cstdio>
#include <cmath>
#include <cstring>
namespace cg = cooperative_groups;

typedef unsigned short u16;
using bf16x8 = __attribute__((ext_vector_type(8))) short;
using bf16x4 = __attribute__((ext_vector_type(4))) short;
using f32x4 = __attribute__((ext_vector_type(4))) float;
using u32x4 = __attribute__((ext_vector_type(4))) unsigned;

#ifndef MULTI_LAUNCH
#define MULTI_LAUNCH 0
#endif

constexpr int T_TOK = 32768, DM = 1024, SEQ = 8192, NB = 4, DFF = 2816, MEML = 256;
constexpr float EPS = 1e-6f;
constexpr int LDS_BYTES = 147456;
constexpr float LOG2E = 1.4426950408889634f;

typedef __attribute__((ext_vector_type(2))) float f32x2;
typedef __attribute__((ext_vector_type(2))) __bf16 bf16x2_t;
__device__ __forceinline__ unsigned pk2(float a, float b) { f32x2 v = {a, b}; bf16x2_t r = __builtin_convertvector(v, bf16x2_t); return *(unsigned*)&r; }
__device__ __forceinline__ u16 f2bf(float f) { return (u16)(pk2(f, 0.f) & 0xffffu); }
__device__ __forceinline__ float bf2f(u16 h) { return __uint_as_float(((unsigned)h) << 16); }
__device__ __forceinline__ float sigmoid_f(float x) { return __builtin_amdgcn_rcpf(1.f + __builtin_amdgcn_exp2f(-x * LOG2E)); }
__device__ __forceinline__ float silu_f(float x) { return x * sigmoid_f(x); }

__device__ __forceinline__ int opaque_tid(int wv) { unsigned ones = ~0u; asm volatile("" : "+s"(ones)); int lane = __builtin_amdgcn_mbcnt_hi(ones, __builtin_amdgcn_mbcnt_lo(ones, 0u)); int t = (wv << 6) | lane; asm volatile("" : "+v"(t)); return t; }

template <int M> __device__ __forceinline__ float sx(float v, int lane) {
  if (M < 32) return __int_as_float(__builtin_amdgcn_ds_swizzle(__float_as_int(v), (M << 10) | 0x1f));
  else return __int_as_float(__builtin_amdgcn_ds_bpermute((lane ^ M) << 2, __float_as_int(v)));
}
__device__ __forceinline__ float wave_sum(float v, int lane) {
  v += sx<1>(v, lane); v += sx<2>(v, lane); v += sx<4>(v, lane); v += sx<8>(v, lane); v += sx<16>(v, lane); v += sx<32>(v, lane); return v;
}

struct WDesc { const float* src; u16* dst; const float* gain; int K; int N; int perm; int tile0; };

struct KArgs {
  const float *x, *mem, *rel_bias, *norm_mem, *norm_final;
  const float *da_lq1, *da_lk1, *da_lq2, *da_lk2, *da_subln;
  const float *hg_lb, *hg_onorm;
  const float *sg_vnorm, *sg_w_s, *sg_b_s;
  float* out; char* ws;
  WDesc wd[28];
  int nwd; int total_wtiles;
  int phase_lo, phase_hi;
};

constexpr size_t MIB = 1u << 20;
constexpr size_t OFF_XB = 0, OFF_RPART = OFF_XB + 64 * MIB, OFF_VPART = OFF_RPART + 2 * MIB, OFF_MEMN = OFF_VPART + 2 * MIB,
                 OFF_MEMK = OFF_MEMN + 2 * MIB, OFF_MEMVT = OFF_MEMK + 8 * MIB, OFF_LBV = OFF_MEMVT + 8 * MIB, OFF_BIAS = OFF_LBV + 4096,
                 OFF_B0 = OFF_BIAS + 4096, OFF_B1 = OFF_B0 + 64 * MIB, OFF_B2 = OFF_B1 + 64 * MIB, OFF_B3 = OFF_B2 + 64 * MIB,
                 OFF_B4 = OFF_B3 + 64 * MIB, OFF_DBUF = OFF_B4 + 32 * MIB, OFF_W = OFF_DBUF + 2 * MIB, OFF_BAR = OFF_W + 130 * MIB, WS_END = OFF_BAR + 16384;
__host__ __device__ __forceinline__ long layer_woff(int i) { return i == 0 ? 0L : (i == 1 ? 17039360L : (i == 2 ? 35127296L : 51118080L)); }
__host__ __device__ __forceinline__ long mixin_elems(int i) { int kind = i % 3; return kind == 0 ? 3145728L : (kind == 1 ? 4194304L : 2097152L); }

struct Params {
  const float *x, *mem, *rel_bias, *norm_mem, *norm_final;
  const float *da_lq1, *da_lk1, *da_lq2, *da_lk2, *da_subln;
  const float *hg_lb, *hg_onorm;
  const float *sg_vnorm, *sg_w_s, *sg_b_s;
  float* out;
  u16* xb; float* rpart; float* vpart; u16* memn; u16* memK; u16* memVT; float* lbv; float* biastab;
  u16 *B0, *B1, *B2, *B3, *B4; float* dbuf; u16* wbase;
};
typedef const KArgs __attribute__((address_space(4)))* KArgsP;
__device__ __forceinline__ KArgsP kargs_ptr() {
  KArgsP kp = (KArgsP)__builtin_amdgcn_kernarg_segment_ptr();
  asm volatile("" : "+s"(kp));
  return kp;
}
template <class KA>
__device__ __forceinline__ Params make_params(const KA& k) {
  Params p;
  p.x = k.x; p.mem = k.mem; p.rel_bias = k.rel_bias; p.norm_mem = k.norm_mem; p.norm_final = k.norm_final;
  p.da_lq1 = k.da_lq1; p.da_lk1 = k.da_lk1; p.da_lq2 = k.da_lq2; p.da_lk2 = k.da_lk2; p.da_subln = k.da_subln;
  p.hg_lb = k.hg_lb; p.hg_onorm = k.hg_onorm; p.sg_vnorm = k.sg_vnorm; p.sg_w_s = k.sg_w_s; p.sg_b_s = k.sg_b_s; p.out = k.out;
  char* ws = k.ws;
  p.xb = (u16*)(ws + OFF_XB); p.rpart = (float*)(ws + OFF_RPART); p.vpart = (float*)(ws + OFF_VPART); p.memn = (u16*)(ws + OFF_MEMN);
  p.memK = (u16*)(ws + OFF_MEMK); p.memVT = (u16*)(ws + OFF_MEMVT); p.lbv = (float*)(ws + OFF_LBV); p.biastab = (float*)(ws + OFF_BIAS);
  p.B0 = (u16*)(ws + OFF_B0); p.B1 = (u16*)(ws + OFF_B1); p.B2 = (u16*)(ws + OFF_B2); p.B3 = (u16*)(ws + OFF_B3); p.B4 = (u16*)(ws + OFF_B4);
  p.dbuf = (float*)(ws + OFF_DBUF); p.wbase = (u16*)(ws + OFF_W);
  return p;
}


constexpr int BM = 256, BK = 64, HALF = 128, HT = HALF * BK;

__device__ __forceinline__ int lds_byte(int r, int c) {
  int st = (r >> 4) * 2 + (c >> 5), rr = r & 15, cc = c & 31, ob = rr * 64 + cc * 2;
  return st * 1024 + (ob ^ (((ob >> 9) & 1) << 5));
}
__device__ __forceinline__ void stage_rc(int b, int& R, int& C) {
  int st = b / 1024, sb = b % 1024, swz = sb ^ (((sb >> 9) & 1) << 5);
  R = (st >> 1) * 16 + swz / 64; C = (st & 1) * 32 + (swz % 64) / 2;
}

template <class Epi>
__device__ __forceinline__ void gemm_tile(const u16* __restrict__ A, const u16* __restrict__ Bt, int K, int brow, int bcol,
                                          char* shmc, Epi& epi, int tr0, int fc0, bool sw, bool pre, bool has_next,
                                          const u16* __restrict__ nA, const u16* __restrict__ nBt, int nbrow, int nbcol, int wv) {
  u16* shm = (u16*)shmc;
  const int tx = opaque_tid(wv);
#define SA(b, h) (shm + ((b) * 2 + (h)) * HT)
#define SB(b, h) (shm + (4 + (b) * 2 + (h)) * HT)
#define STAGE(P, BASE, br, kt) do { int _so = ((br) * K + (kt) * BK) * 2; \
    __builtin_amdgcn_raw_ptr_buffer_load_lds(rs_##BASE, (__attribute__((address_space(3))) void*)((char*)(P) + tx * 16), 16, voff0, _so, 0, 0); \
    __builtin_amdgcn_raw_ptr_buffer_load_lds(rs_##BASE, (__attribute__((address_space(3))) void*)((char*)(P) + tx * 16 + 8192), 16, voff1, _so, 0, 0); } while (0)
#define LDA(dst, b, h) _Pragma("unroll") for (int m = 0; m < 4; ++m) _Pragma("unroll") for (int k = 0; k < 2; ++k) \
    dst[m][k] = *reinterpret_cast<const bf16x8*>((char*)SA(b, h) + lds_byte(wr * 64 + m * 16 + fr, k * 32 + fq * 8))
#define LDB(dst, b, h) _Pragma("unroll") for (int n = 0; n < 2; ++n) _Pragma("unroll") for (int k = 0; k < 2; ++k) \
    dst[n][k] = *reinterpret_cast<const bf16x8*>((char*)SB(b, h) + lds_byte(wc * 32 + n * 16 + fr, k * 32 + fq * 8))
#define MMA(ai, bj, At, Bt_) do { __builtin_amdgcn_s_setprio(1); \
    _Pragma("unroll") for (int m = 0; m < 4; ++m) _Pragma("unroll") for (int n = 0; n < 2; ++n) _Pragma("unroll") for (int k = 0; k < 2; ++k) \
      acc[ai][bj][m][n] = __builtin_amdgcn_mfma_f32_16x16x32_bf16(At[m][k], Bt_[n][k], acc[ai][bj][m][n], 0, 0, 0); \
    __builtin_amdgcn_s_setprio(0); } while (0)
#define WAIT_V(n) asm volatile("s_waitcnt vmcnt(" #n ")" ::: "memory")
#define WAIT_L(n) asm volatile("s_waitcnt lgkmcnt(" #n ")" ::: "memory")
#define BAR __builtin_amdgcn_s_barrier()
#define SCHED __builtin_amdgcn_sched_barrier(0)

  int wid = tx >> 6, lane = tx & 63, wr = wid >> 2, wc = wid & 3, fr = lane & 15, fq = lane >> 4;
  f32x4 acc[2][2][4][2] = {};
  bf16x8 At[4][2], B0[2][2], B1[2][2];
  int nt = K / BK;
  int voff0, voff1;
  { int _r, _c; stage_rc(tx * 16, _r, _c); voff0 = (_r * K + _c) * 2; stage_rc(tx * 16 + 8192, _r, _c); voff1 = (_r * K + _c) * 2; }
  __amdgpu_buffer_rsrc_t rs_A = __builtin_amdgcn_make_buffer_rsrc((void*)A, 0, 0x7fffffff, 0x00020000);
  __amdgpu_buffer_rsrc_t rs_Bt = __builtin_amdgcn_make_buffer_rsrc((void*)Bt, 0, 0x7fffffff, 0x00020000);
  if (!pre) {
    STAGE(SB(0, 0), Bt, bcol, 0); STAGE(SA(0, 0), A, brow, 0);
    STAGE(SB(0, 1), Bt, bcol + HALF, 0); STAGE(SA(0, 1), A, brow + HALF, 0);
  }
  if (wr == 1) BAR;
  if (pre) { WAIT_V(0); } else { WAIT_V(4); }
  BAR;
  STAGE(SB(1, 0), Bt, bcol, 1); STAGE(SA(1, 0), A, brow, 1); STAGE(SB(1, 1), Bt, bcol + HALF, 1);
  WAIT_V(6); BAR;
  for (int t = 0; t < nt - 2; t += 2) {
    LDB(B0, 0, 0); SCHED; LDA(At, 0, 0); STAGE(SA(1, 1), A, brow + HALF, t + 1);
    WAIT_L(8); BAR; WAIT_L(0); MMA(0, 0, At, B0); BAR; SCHED;
    LDB(B1, 0, 1); STAGE(SB(0, 0), Bt, bcol, t + 2);
    BAR; WAIT_L(0); MMA(0, 1, At, B1); BAR;
    LDA(At, 0, 1); STAGE(SA(0, 0), A, brow, t + 2);
    BAR; WAIT_L(0); MMA(1, 0, At, B0); BAR; SCHED;
    STAGE(SB(0, 1), Bt, bcol + HALF, t + 2);
    WAIT_V(6); BAR; MMA(1, 1, At, B1); BAR;
    LDB(B0, 1, 0); SCHED; LDA(At, 1, 0); STAGE(SA(0, 1), A, brow + HALF, t + 2);
    WAIT_L(8); BAR; WAIT_L(0); MMA(0, 0, At, B0); BAR; SCHED;
    LDB(B1, 1, 1); STAGE(SB(1, 0), Bt, bcol, t + 3);
    BAR; WAIT_L(0); MMA(0, 1, At, B1); BAR;
    LDA(At, 1, 1); STAGE(SA(1, 0), A, brow, t + 3);
    BAR; WAIT_L(0); MMA(1, 0, At, B0); BAR; SCHED;
    STAGE(SB(1, 1), Bt, bcol + HALF, t + 3);
    WAIT_V(6); BAR; MMA(1, 1, At, B1); BAR;
  }
  { LDB(B0, 0, 0); LDA(At, 0, 0); STAGE(SA(1, 1), A, brow + HALF, nt - 1);
    BAR; WAIT_L(0); MMA(0, 0, At, B0); BAR;
    LDB(B1, 0, 1); BAR; WAIT_L(0); MMA(0, 1, At, B1); BAR;
    LDA(At, 0, 1); WAIT_V(4); BAR; WAIT_L(0); MMA(1, 0, At, B0); MMA(1, 1, At, B1); BAR; }
  { LDB(B0, 1, 0); LDA(At, 1, 0); WAIT_V(2); BAR; WAIT_L(0); MMA(0, 0, At, B0); BAR;
    LDB(B1, 1, 1); WAIT_V(0); BAR; WAIT_L(0); MMA(0, 1, At, B1); BAR;
    LDA(At, 1, 1); BAR; WAIT_L(0); MMA(1, 0, At, B0); MMA(1, 1, At, B1); BAR; }
  if (wr == 0) BAR;
  if (has_next) {
    __amdgpu_buffer_rsrc_t rs_nA = __builtin_amdgcn_make_buffer_rsrc((void*)nA, 0, 0x7fffffff, 0x00020000);
    __amdgpu_buffer_rsrc_t rs_nBt = __builtin_amdgcn_make_buffer_rsrc((void*)nBt, 0, 0x7fffffff, 0x00020000);
    STAGE(SB(0, 0), nBt, nbcol, 0); STAGE(SA(0, 0), nA, nbrow, 0);
    STAGE(SB(0, 1), nBt, nbcol + HALF, 0); STAGE(SA(0, 1), nA, nbrow + HALF, 0);
  }
  {
    const int tx2 = opaque_tid(wv); const int wid2 = tx2 >> 6, lane2 = tx2 & 63;
    epi(acc, tr0, fc0, sw, wid2 >> 2, wid2 & 3, lane2 & 15, lane2 >> 4);
  }
  __syncthreads();
#undef SA
#undef SB
#undef STAGE
#undef LDA
#undef LDB
#undef MMA
}

template <class Epi>
__device__ __forceinline__ void gemm_phase(const u16* A, const u16* Bt, int M, int N, int K, char* shm, Epi& epi, int wv) {
  int nM = M / BM, nN = N / BM;
  int G = gridDim.x, bid = blockIdx.x;
  bool xmap = ((G & 7) == 0 && (nM & 63) == 0);
  int xcd = bid & 7, slot = bid >> 3, nslots = G >> 3, gpx = nM / 64;
  int first = xmap ? slot : bid, step = xmap ? nslots : G, total = xmap ? gpx * 8 * nN : nM * nN;
  auto coords = [&](int L, int& tr0, int& fc0) {
    if (xmap) { int grp = xcd * gpx + L / (8 * nN), within = L % (8 * nN); tr0 = (grp * 8 + (within & 7)) * BM; fc0 = (within >> 3) * BM; }
    else { tr0 = (L % nM) * BM; fc0 = (L / nM) * BM; }
  };
  bool pre = false;
  for (int L = first; L < total; L += step) {
    int tr0, fc0, ntr0 = 0, nfc0 = 0;
    coords(L, tr0, fc0);
    bool hn = (L + step) < total;
    if (hn) coords(L + step, ntr0, nfc0);
    bool sw = epi.swap(fc0), nsw = epi.swap(nfc0);
    gemm_tile(sw ? Bt : A, sw ? A : Bt, K, sw ? fc0 : tr0, sw ? tr0 : fc0, shm, epi, tr0, fc0, sw, pre, hn,
              nsw ? Bt : A, nsw ? A : Bt, nsw ? nfc0 : ntr0, nsw ? ntr0 : nfc0, wv);
    pre = hn;
  }
}

__device__ __forceinline__ float row_rs(const float* part, int row) {
  const float4* q = (const float4*)(part + (long)row * 16);
  float4 a = q[0], b = q[1], c = q[2], d = q[3];
  float s = ((a.x + a.y) + (a.z + a.w)) + ((b.x + b.y) + (b.z + b.w)) + ((c.x + c.y) + (c.z + c.w)) + ((d.x + d.y) + (d.z + d.w));
  return rsqrtf(s * (1.f / DM) + EPS);
}
#define EPI_ARGS f32x4 (&acc)[2][2][4][2], int tr0, int fc0, bool sw, int wr, int wc, int fr, int fq
#define S_FEAT(ai, m) (fc0 + (ai) * 128 + wr * 64 + (m) * 16 + fq * 4)
#define S_TOK(bj, n) (tr0 + (bj) * 128 + wc * 32 + (n) * 16 + fr)
#define U_TOK(ai, m) (tr0 + (ai) * 128 + wr * 64 + (m) * 16 + fq * 4)
#define U_FEAT(bj, n) (fc0 + (bj) * 128 + wc * 32 + (n) * 16 + fr)

__device__ __forceinline__ uint2 pack4(float a, float b, float c, float d) { uint2 r; r.x = pk2(a, b); r.y = pk2(c, d); return r; }

struct EpiRes {
  u16* xb; float* part;
  __device__ __forceinline__ bool swap(int) const { return true; }
  __device__ __forceinline__ void operator()(EPI_ARGS) {
    _Pragma("unroll") for (int bj = 0; bj < 2; ++bj) _Pragma("unroll") for (int n = 0; n < 2; ++n) {
      int t = S_TOK(bj, n); float ss = 0.f;
      u16* xbp = xb + (long)t * DM;
      _Pragma("unroll") for (int ai = 0; ai < 2; ++ai) _Pragma("unroll") for (int m = 0; m < 4; ++m) {
        int f = S_FEAT(ai, m); f32x4 a = acc[ai][bj][m][n];
        uint2 xv = *(const uint2*)(xbp + f);
        float v0 = __uint_as_float(xv.x << 16) + a[0], v1 = __uint_as_float(xv.x & 0xffff0000u) + a[1];
        float v2 = __uint_as_float(xv.y << 16) + a[2], v3 = __uint_as_float(xv.y & 0xffff0000u) + a[3];
        *(uint2*)(xbp + f) = pack4(v0, v1, v2, v3);
        ss += v0 * v0 + v1 * v1 + v2 * v2 + v3 * v3;
      }
      ss += sx<16>(ss, fq * 16 + fr); ss += sx<32>(ss, fq * 16 + fr);
      if (fq == 0) part[(long)t * 16 + (fc0 >> 8) * 4 + wr] = ss;
      __builtin_amdgcn_sched_barrier(0);
    }
  }
};

struct EpiDaIn {
  const float* rowss; u16 *q, *k, *vT;
  __device__ __forceinline__ bool swap(int fc0) const { return (fc0 >> 10) < 2; }
  __device__ __forceinline__ void operator()(EPI_ARGS) {
    int sect = fc0 >> 10, cb = fc0 & 1023;
    if (sw) {
      u16* dst = sect ? k : q;
      _Pragma("unroll") for (int bj = 0; bj < 2; ++bj) _Pragma("unroll") for (int n = 0; n < 2; ++n) {
        int t = S_TOK(bj, n); float rs = row_rs(rowss, t); u16* d = dst + (long)t * DM + (cb - fc0);
        _Pragma("unroll") for (int ai = 0; ai < 2; ++ai) _Pragma("unroll") for (int m = 0; m < 4; ++m) {
          f32x4 a = acc[ai][bj][m][n]; *(uint2*)(d + S_FEAT(ai, m)) = pack4(a[0] * rs, a[1] * rs, a[2] * rs, a[3] * rs);
        }
      }
    } else {
      _Pragma("unroll") for (int ai = 0; ai < 2; ++ai) _Pragma("unroll") for (int m = 0; m < 4; ++m) {
        int r0 = U_TOK(ai, m); float rs[4];
        _Pragma("unroll") for (int j = 0; j < 4; ++j) rs[j] = row_rs(rowss, r0 + j);
        int b = r0 / SEQ, s0 = r0 % SEQ;
        _Pragma("unroll") for (int bj = 0; bj < 2; ++bj) _Pragma("unroll") for (int n = 0; n < 2; ++n) {
          int c = U_FEAT(bj, n) - fc0 + cb; f32x4 a = acc[ai][bj][m][n];
          *(uint2*)&vT[((long)(b * DM + c)) * SEQ + s0] = pack4(a[0] * rs[0], a[1] * rs[1], a[2] * rs[2], a[3] * rs[3]);
        }
        __builtin_amdgcn_sched_barrier(0);
      }
    }
  }
};

struct EpiHgIn {
  const float* rowss; const float* lbv; u16 *q, *logf_, *iT, *g;
  __device__ __forceinline__ bool swap(int fc0) const { return (fc0 >> 10) != 2; }
  __device__ __forceinline__ void operator()(EPI_ARGS) {
    int sect = fc0 >> 10, cb = fc0 & 1023;
    if (sw) {
      u16* dst = q + (long)sect * (32L << 20);
      _Pragma("unroll") for (int bj = 0; bj < 2; ++bj) _Pragma("unroll") for (int n = 0; n < 2; ++n) {
        int t = S_TOK(bj, n); float rs = row_rs(rowss, t); u16* d = dst + (long)t * DM + (cb - fc0);
        _Pragma("unroll") for (int ai = 0; ai < 2; ++ai) _Pragma("unroll") for (int m = 0; m < 4; ++m) {
          int f = S_FEAT(ai, m); f32x4 a = acc[ai][bj][m][n]; float v[4];
          if (sect == 0) { _Pragma("unroll") for (int j = 0; j < 4; ++j) v[j] = silu_f(a[j] * rs); }
          else if (sect == 1) {
            float4 lb = *(const float4*)&lbv[f - fc0 + cb]; float lbs[4] = {lb.x, lb.y, lb.z, lb.w};
            _Pragma("unroll") for (int j = 0; j < 4; ++j) v[j] = __logf(lbs[j] + (1.f - lbs[j]) * sigmoid_f(a[j] * rs));
          } else { _Pragma("unroll") for (int j = 0; j < 4; ++j) v[j] = a[j] * rs; }
          *(uint2*)(d + f) = pack4(v[0], v[1], v[2], v[3]);
        }
      }
    } else {
      _Pragma("unroll") for (int ai = 0; ai < 2; ++ai) _Pragma("unroll") for (int m = 0; m < 4; ++m) {
        int r0 = U_TOK(ai, m); float rs[4];
        _Pragma("unroll") for (int j = 0; j < 4; ++j) rs[j] = row_rs(rowss, r0 + j);
        _Pragma("unroll") for (int bj = 0; bj < 2; ++bj) _Pragma("unroll") for (int n = 0; n < 2; ++n) {
          int c = U_FEAT(bj, n) - fc0 + cb; f32x4 a = acc[ai][bj][m][n];
          *(uint2*)&iT[((long)(r0 >> 6) * DM + c) * 64 + (r0 & 63)] = pack4(a[0] * rs[0], a[1] * rs[1], a[2] * rs[2], a[3] * rs[3]);
        }
        __builtin_amdgcn_sched_barrier(0);
      }
    }
  }
};

__device__ __forceinline__ float gelu_f(float x) { return 0.5f * x * (1.f + erff(x * 0.70710678118654752f)); }

struct EpiSgIn {
  const float* rowss; u16 *u, *vT; float* rowss_v;
  __device__ __forceinline__ bool swap(int fc0) const { return (fc0 >> 10) == 0; }
  __device__ __forceinline__ void operator()(EPI_ARGS) {
    int cb = fc0 & 1023;
    if (sw) {
      _Pragma("unroll") for (int bj = 0; bj < 2; ++bj) _Pragma("unroll") for (int n = 0; n < 2; ++n) {
        int t = S_TOK(bj, n); float rs = row_rs(rowss, t); u16* d = u + (long)t * DM;
        _Pragma("unroll") for (int ai = 0; ai < 2; ++ai) _Pragma("unroll") for (int m = 0; m < 4; ++m) {
          f32x4 a = acc[ai][bj][m][n];
          *(uint2*)(d + S_FEAT(ai, m)) = pack4(gelu_f(a[0] * rs), gelu_f(a[1] * rs), gelu_f(a[2] * rs), gelu_f(a[3] * rs));
        }
      }
    } else {
      _Pragma("unroll") for (int ai = 0; ai < 2; ++ai) _Pragma("unroll") for (int m = 0; m < 4; ++m) {
        int r0 = U_TOK(ai, m); float rs[4], ss[4] = {0.f, 0.f, 0.f, 0.f};
        _Pragma("unroll") for (int j = 0; j < 4; ++j) rs[j] = row_rs(rowss, r0 + j);
        _Pragma("unroll") for (int bj = 0; bj < 2; ++bj) _Pragma("unroll") for (int n = 0; n < 2; ++n) {
          int c = U_FEAT(bj, n) - fc0 + cb; f32x4 a = acc[ai][bj][m][n];
          float gv[4]; _Pragma("unroll") for (int j = 0; j < 4; ++j) gv[j] = gelu_f(a[j] * rs[j]);
          *(uint2*)&vT[((long)(r0 >> 7) * DM + c) * 128 + (r0 & 127)] = pack4(gv[0], gv[1], gv[2], gv[3]);
          _Pragma("unroll") for (int j = 0; j < 4; ++j) ss[j] += gv[j] * gv[j];
        }
        _Pragma("unroll") for (int j = 0; j < 4; ++j) {
          float s = ss[j]; s += sx<1>(s, 0); s += sx<2>(s, 0); s += sx<4>(s, 0); s += sx<8>(s, 0);
          if (fr == 0) rowss_v[(long)(r0 + j) * 16 + (cb >> 8) * 4 + wc] = s;
        }
        __builtin_amdgcn_sched_barrier(0);
      }
    }
  }
};

struct EpiStore {
  const float* rowss; u16* dst; int ld;
  __device__ __forceinline__ bool swap(int) const { return true; }
  __device__ __forceinline__ void operator()(EPI_ARGS) {
    _Pragma("unroll") for (int bj = 0; bj < 2; ++bj) _Pragma("unroll") for (int n = 0; n < 2; ++n) {
      int t = S_TOK(bj, n); float rs = rowss ? row_rs(rowss, t) : 1.f; u16* d = dst + (long)t * ld;
      _Pragma("unroll") for (int ai = 0; ai < 2; ++ai) _Pragma("unroll") for (int m = 0; m < 4; ++m) {
        f32x4 a = acc[ai][bj][m][n]; *(uint2*)(d + S_FEAT(ai, m)) = pack4(a[0] * rs, a[1] * rs, a[2] * rs, a[3] * rs);
      }
    }
  }
};

struct EpiFfn {
  const float* rowss; u16* act;
  __device__ __forceinline__ bool swap(int) const { return true; }
  __device__ __forceinline__ void operator()(EPI_ARGS) {
    int tile = fc0 >> 8;
    _Pragma("unroll") for (int bj = 0; bj < 2; ++bj) _Pragma("unroll") for (int n = 0; n < 2; ++n) {
      int t = S_TOK(bj, n); float rs = row_rs(rowss, t); u16* d = act + (long)t * DFF + tile * 128 + wr * 64 + fq * 4;
      _Pragma("unroll") for (int m = 0; m < 4; ++m) {
        f32x4 g = acc[0][bj][m][n], u = acc[1][bj][m][n]; float v[4];
        _Pragma("unroll") for (int j = 0; j < 4; ++j) v[j] = silu_f(g[j] * rs) * (u[j] * rs);
        *(uint2*)(d + m * 16) = pack4(v[0], v[1], v[2], v[3]);
      }
    }
  }
};

struct EpiMemKV {
  u16 *K, *VT;
  __device__ __forceinline__ bool swap(int fc0) const { return (fc0 >> 10) == 0; }
  __device__ __forceinline__ void operator()(EPI_ARGS) {
    int cb = fc0 & 1023;
    if (sw) {
      _Pragma("unroll") for (int bj = 0; bj < 2; ++bj) _Pragma("unroll") for (int n = 0; n < 2; ++n) {
        int t = S_TOK(bj, n); u16* d = K + (long)t * DM;
        _Pragma("unroll") for (int ai = 0; ai < 2; ++ai) _Pragma("unroll") for (int m = 0; m < 4; ++m) {
          f32x4 a = acc[ai][bj][m][n]; *(uint2*)(d + S_FEAT(ai, m)) = pack4(a[0], a[1], a[2], a[3]);
        }
      }
    } else {
      _Pragma("unroll") for (int ai = 0; ai < 2; ++ai) _Pragma("unroll") for (int m = 0; m < 4; ++m) {
        int r0 = U_TOK(ai, m);
        _Pragma("unroll") for (int bj = 0; bj < 2; ++bj) _Pragma("unroll") for (int n = 0; n < 2; ++n) {
          int c = U_FEAT(bj, n) - fc0 + cb; f32x4 a = acc[ai][bj][m][n];
          *(uint2*)&VT[((long)((r0 >> 8) * DM + c)) * MEML + (r0 & 255)] = pack4(a[0], a[1], a[2], a[3]);
        }
      }
    }
  }
};

__device__ __forceinline__ void prep_phase(const Params& p, KArgsP kap, char* shm, int wv) {
  int tid = opaque_tid(wv), bid = blockIdx.x, G = gridDim.x;
  int lane = tid & 63, wid = tid >> 6;
  for (int row = bid * 8 + wid; row < T_TOK; row += G * 8) {
    const float4* src = (const float4*)(p.x + (long)row * DM);
    float ss = 0.f;
    _Pragma("unroll") for (int i = 0; i < 4; ++i) {
      float4 v = src[i * 64 + lane];
      ss += v.x * v.x + v.y * v.y + v.z * v.z + v.w * v.w;
      *(uint2*)&p.xb[(long)row * DM + (i * 64 + lane) * 4] = pack4(v.x, v.y, v.z, v.w);
    }
    ss = wave_sum(ss, lane);
    if (lane < 16) p.rpart[(long)row * 16 + lane] = (lane == 0) ? ss : 0.f;
  }
  for (int row = bid * 8 + wid; row < NB * MEML; row += G * 8) {
    const float4* src = (const float4*)(p.mem + (long)row * DM);
    float4 v[4]; float ss = 0.f;
    _Pragma("unroll") for (int i = 0; i < 4; ++i) { v[i] = src[i * 64 + lane]; ss += v[i].x * v[i].x + v[i].y * v[i].y + v[i].z * v[i].z + v[i].w * v[i].w; }
    ss = wave_sum(ss, lane);
    float rs = rsqrtf(ss * (1.f / DM) + EPS);
    _Pragma("unroll") for (int i = 0; i < 4; ++i) {
      float4 g = ((const float4*)p.norm_mem)[i * 64 + lane];
      *(uint2*)&p.memn[(long)row * DM + (i * 64 + lane) * 4] = pack4(v[i].x * rs * g.x, v[i].y * rs * g.y, v[i].z * rs * g.z, v[i].w * rs * g.w);
    }
  }
  if (bid == 0) {
    for (int i = tid; i < 3456; i += 512) ((unsigned*)((char*)p.xb - OFF_XB + OFF_BAR))[i] = 0u;
    for (int c = tid; c < DM; c += 512) {
      float v0 = p.hg_lb[c], v1 = p.hg_lb[DM + c], v2 = p.hg_lb[2 * DM + c], v3 = p.hg_lb[3 * DM + c];
      float mx = fmaxf(fmaxf(v0, v1), fmaxf(v2, v3));
      float e0 = expf(v0 - mx), e1 = expf(v1 - mx), e2 = expf(v2 - mx), e3 = expf(v3 - mx);
      p.lbv[c] = e1 / (e0 + e1 + e2 + e3);
    }
    for (int i = tid; i < 8 * 128; i += 512) {
      int h = i >> 7, n = i & 127, bucket;
      if (n < 16) bucket = n;
      else { float nf = (float)n; int lg = 16 + (int)(logf(nf / 16.f) / 2.0794415416798357f * 16.f); bucket = lg < 31 ? lg : 31; }
      p.biastab[i] = p.rel_bias[h * 32 + bucket] * LOG2E;
    }
  }
  float* tl = (float*)shm;
  for (int t = bid; t < kap->total_wtiles; t += G) {
    int wi = 0;
    while (wi + 1 < kap->nwd && kap->wd[wi + 1].tile0 <= t) ++wi;
    const float* src = kap->wd[wi].src; u16* dst = kap->wd[wi].dst; const float* gain = kap->wd[wi].gain;
    int K = kap->wd[wi].K, N = kap->wd[wi].N, perm = kap->wd[wi].perm;
    int lt = t - kap->wd[wi].tile0, nNt = N >> 6;
    int k0 = (lt / nNt) * 64, n0 = (lt % nNt) * 64;
    {
      int kk = tid >> 3, seg = (tid & 7) * 8;
      const float4* s4 = (const float4*)(src + (long)(k0 + kk) * N + n0 + seg);
      float4 a = s4[0], b = s4[1]; float g = gain ? gain[k0 + kk] : 1.f;
      float* d = tl + kk * 65 + seg;
      d[0] = a.x * g; d[1] = a.y * g; d[2] = a.z * g; d[3] = a.w * g; d[4] = b.x * g; d[5] = b.y * g; d[6] = b.z * g; d[7] = b.w * g;
    }
    __syncthreads();
    {
      int nn = tid >> 3, seg = (tid & 7) * 8;
      int n = n0 + nn, drow = n;
      if (perm) { int part = n / DFF, idx = n % DFF; drow = (idx >> 7) * 256 + part * 128 + (idx & 127); }
      float v[8]; _Pragma("unroll") for (int i = 0; i < 8; ++i) v[i] = tl[(seg + i) * 65 + nn];
      uint4 o; uint2 lo = pack4(v[0], v[1], v[2], v[3]), hi = pack4(v[4], v[5], v[6], v[7]);
      o.x = lo.x; o.y = lo.y; o.z = hi.x; o.w = hi.y;
      *(uint4*)&dst[(long)drow * K + k0 + seg] = o;
    }
    __syncthreads();
  }
}

template <int NC, int DQK, int DV, bool CAUSAL, bool PF>
__device__ __forceinline__ void flash_item(const u16* __restrict__ Qg, int q_stride, const u16* __restrict__ Kg, int k_stride,
                                           const u16* __restrict__ VTg, int vt_stride, int nkt, int q0, float scale_log2,
                                           const float* btab, float lam, const float* subln_g, float outscale,
                                           u16* __restrict__ Og, int o_stride, char* shm, int wv) {
  constexpr int KW = NC * DQK, KLD = KW + 8, VLD = 72;
  constexpr int KBUF = 64 * KLD, VBUF = DV * VLD;
  constexpr int KCH = KW / 8, KPT = 64 * KCH / 512, VPT = DV * 8 / 512;
  constexpr int NKS = DQK / 32, NVT = DV / 16;
  u16* Ks = (u16*)shm; u16* Vs = Ks + 2 * KBUF;
  int tid = opaque_tid(wv), wid = tid >> 6, lane = tid & 63, fr = lane & 15, fq = lane >> 4;
  int qw0 = q0 + wid * 16, qpos = qw0 + fr;

  bf16x8 qf[NC][NKS];
  _Pragma("unroll") for (int c = 0; c < NC; ++c) _Pragma("unroll") for (int ks = 0; ks < NKS; ++ks)
    qf[c][ks] = *(const bf16x8*)&Qg[(long)(wid * 16 + fr) * q_stride + c * DQK + ks * 32 + fq * 8];
  f32x4 O[NC][NVT];
  _Pragma("unroll") for (int c = 0; c < NC; ++c) _Pragma("unroll") for (int v = 0; v < NVT; ++v) O[c][v] = f32x4{0.f, 0.f, 0.f, 0.f};
  float mrun[NC], lsum[NC];
  _Pragma("unroll") for (int c = 0; c < NC; ++c) { mrun[c] = -1e30f; lsum[c] = 0.f; }

  u32x4 kreg[KPT], vreg[VPT];
#define FA_PREFETCH(kt_) do { int k0_ = (kt_) * 64; \
    _Pragma("unroll") for (int i = 0; i < KPT; ++i) { int id = tid + i * 512, row = id / KCH, cc = id % KCH; kreg[i] = *(const u32x4*)&Kg[(long)(k0_ + row) * k_stride + cc * 8]; } \
    _Pragma("unroll") for (int i = 0; i < VPT; ++i) { int id = tid + i * 512, row = id >> 3, cc = id & 7; vreg[i] = *(const u32x4*)&VTg[(long)row * vt_stride + k0_ + cc * 8]; } } while (0)
  if (PF) FA_PREFETCH(0);
  for (int kt = 0; kt < nkt; ++kt) {
    if (!PF) FA_PREFETCH(kt);
    u16* Kb = Ks + (kt & 1) * KBUF; u16* Vb = Vs + (kt & 1) * VBUF;
    _Pragma("unroll") for (int i = 0; i < KPT; ++i) { int id = tid + i * 512, row = id / KCH, cc = id % KCH; *(u32x4*)&Kb[row * KLD + cc * 8] = kreg[i]; }
    _Pragma("unroll") for (int i = 0; i < VPT; ++i) {
      int id = tid + i * 512, row = id >> 3, cc = id & 7;
      int pos = 32 * (cc >> 2) + 16 * (cc & 1) + 4 * ((cc >> 1) & 1);
      uint2 lo2, hi2; lo2.x = vreg[i][0]; lo2.y = vreg[i][1]; hi2.x = vreg[i][2]; hi2.y = vreg[i][3];
      *(uint2*)&Vb[row * VLD + pos] = lo2; *(uint2*)&Vb[row * VLD + pos + 8] = hi2;
    }
    __syncthreads();
    if (PF && kt + 1 < nkt) FA_PREFETCH(kt + 1);
    int k0 = kt * 64;
    if (CAUSAL && k0 > qw0 + 15) continue;
    bf16x8 pf[NC][2];
    _Pragma("unroll") for (int c = 0; c < NC; ++c) {
      f32x4 s[4];
      _Pragma("unroll") for (int m = 0; m < 4; ++m) s[m] = f32x4{0.f, 0.f, 0.f, 0.f};
      _Pragma("unroll") for (int ks = 0; ks < NKS; ++ks) _Pragma("unroll") for (int m = 0; m < 4; ++m) {
        bf16x8 a = *(const bf16x8*)&Kb[(16 * m + fr) * KLD + c * DQK + ks * 32 + fq * 8];
        s[m] = __builtin_amdgcn_mfma_f32_16x16x32_bf16(a, qf[c][ks], s[m], 0, 0, 0);
      }
      bool general = false; float bb = 0.f;
      if (CAUSAL) { general = (qw0 - (k0 + 63)) < 113; bb = btab[127]; }
      constexpr float THR = 8.f;
      float tnew, psum = 0.f;
      if (general) {
        bool diag = (k0 + 63) > qw0; float tmax = -1e30f;
        _Pragma("unroll") for (int m = 0; m < 4; ++m) _Pragma("unroll") for (int j = 0; j < 4; ++j) {
          int dist = qpos - (k0 + 16 * m + fq * 4 + j);
          int di = dist < 0 ? 0 : (dist > 127 ? 127 : dist);
          float v = s[m][j] * scale_log2 + btab[di];
          if (diag && dist < 0) v = -1e30f;
          s[m][j] = v; tmax = fmaxf(tmax, v);
        }
        tnew = tmax;
      } else {
        float rmax = fmaxf(fmaxf(s[0][0], s[0][1]), fmaxf(s[0][2], s[0][3]));
        _Pragma("unroll") for (int m = 1; m < 4; ++m) rmax = fmaxf(rmax, fmaxf(fmaxf(s[m][0], s[m][1]), fmaxf(s[m][2], s[m][3])));
        tnew = rmax * scale_log2 + bb;
      }
      if (__builtin_amdgcn_ballot_w64(tnew - mrun[c] > THR) != 0ull) {
        tnew = fmaxf(tnew, sx<16>(tnew, lane)); tnew = fmaxf(tnew, sx<32>(tnew, lane));
        float mnew = fmaxf(mrun[c], tnew);
        float alpha = __builtin_amdgcn_exp2f(mrun[c] - mnew);
        mrun[c] = mnew; lsum[c] *= alpha;
        _Pragma("unroll") for (int v = 0; v < NVT; ++v) _Pragma("unroll") for (int j = 0; j < 4; ++j) O[c][v][j] *= alpha;
      }
      if (general) {
        float mm = mrun[c];
        _Pragma("unroll") for (int m = 0; m < 4; ++m) _Pragma("unroll") for (int j = 0; j < 4; ++j) { float pv = __builtin_amdgcn_exp2f(s[m][j] - mm); s[m][j] = pv; psum += pv; }
      } else {
        float cc = bb - mrun[c];
        _Pragma("unroll") for (int m = 0; m < 4; ++m) _Pragma("unroll") for (int j = 0; j < 4; ++j) { float pv = __builtin_amdgcn_exp2f(s[m][j] * scale_log2 + cc); s[m][j] = pv; psum += pv; }
      }
      lsum[c] += psum;
      _Pragma("unroll") for (int k2 = 0; k2 < 2; ++k2) {
        uint2 lo = pack4(s[2 * k2][0], s[2 * k2][1], s[2 * k2][2], s[2 * k2][3]);
        uint2 hi = pack4(s[2 * k2 + 1][0], s[2 * k2 + 1][1], s[2 * k2 + 1][2], s[2 * k2 + 1][3]);
        uint4 pk; pk.x = lo.x; pk.y = lo.y; pk.z = hi.x; pk.w = hi.y;
        pf[c][k2] = *(bf16x8*)&pk;
      }
    }
    _Pragma("unroll") for (int k2 = 0; k2 < 2; ++k2) _Pragma("unroll") for (int v = 0; v < NVT; ++v) {
      bf16x8 a = *(const bf16x8*)&Vb[(16 * v + fr) * VLD + 32 * k2 + fq * 8];
      _Pragma("unroll") for (int c = 0; c < NC; ++c) O[c][v] = __builtin_amdgcn_mfma_f32_16x16x32_bf16(a, pf[c][k2], O[c][v], 0, 0, 0);
      if ((v & 3) == 3) __builtin_amdgcn_sched_barrier(0);
    }
  }
  float inv[NC];
  _Pragma("unroll") for (int c = 0; c < NC; ++c) { float l = lsum[c]; l += sx<16>(l, lane); l += sx<32>(l, lane); inv[c] = 1.f / l; }
  u16* orow = Og + (long)(wid * 16 + fr) * o_stride;
  if (NC == 2) {
    float ss = 0.f;
    _Pragma("unroll") for (int v = 0; v < NVT; ++v) _Pragma("unroll") for (int j = 0; j < 4; ++j) { float o = O[0][v][j] * inv[0] - lam * O[NC - 1][v][j] * inv[NC - 1]; O[0][v][j] = o; ss += o * o; }
    ss += sx<16>(ss, lane); ss += sx<32>(ss, lane);
    float rs = rsqrtf(ss * (1.f / DV) + EPS) * outscale;
    _Pragma("unroll") for (int v = 0; v < NVT; ++v) {
      float4 g = *(const float4*)&subln_g[16 * v + fq * 4];
      *(uint2*)&orow[16 * v + fq * 4] = pack4(O[0][v][0] * rs * g.x, O[0][v][1] * rs * g.y, O[0][v][2] * rs * g.z, O[0][v][3] * rs * g.w);
    }
  } else {
    _Pragma("unroll") for (int v = 0; v < NVT; ++v)
      *(uint2*)&orow[16 * v + fq * 4] = pack4(O[0][v][0] * inv[0], O[0][v][1] * inv[0], O[0][v][2] * inv[0], O[0][v][3] * inv[0]);
  }
}

__device__ __forceinline__ void diff_attn_phase(const Params& p, int j, int layer_idx, char* shm, int wv) {
  int tid = opaque_tid(wv), lane = tid & 63;
  float* btab = (float*)(shm + LDS_BYTES - 1024);
  float sa = p.da_lq1[j * 64 + lane] * p.da_lk1[j * 64 + lane], sb = p.da_lq2[j * 64 + lane] * p.da_lk2[j * 64 + lane];
  sa = wave_sum(sa, lane); sb = wave_sum(sb, lane);
  float lam_init = 0.8f - 0.6f * expf(-0.3f * (float)layer_idx);
  float lam = expf(sa) - expf(sb) + lam_init;
  const u16 *qb = p.B0, *kb = p.B1, *vT = p.B2; u16* ao = p.B3;
  for (int i = blockIdx.x; i < 2048; i += gridDim.x) {
    int wgl = i & 255, step = i >> 8, xcd = wgl & 7, slot = wgl >> 3;
    int bh = xcd + 8 * (step >> 1), qblk = (step & 1) ? 63 - slot : slot;
    int b = bh >> 3, h = bh & 7, q0 = qblk * 128;
    __syncthreads();
    if (tid < 128) btab[tid] = p.biastab[h * 128 + tid];
    flash_item<2, 64, 128, true, true>(qb + ((long)(b * SEQ + q0)) * DM + h * 128, DM, kb + ((long)b * SEQ) * DM + h * 128, DM,
                                 vT + ((long)(b * DM + h * 128)) * SEQ, SEQ, q0 / 64 + 2, q0, 0.125f * LOG2E, btab, lam,
                                 p.da_subln + j * 128, 1.f - lam_init, ao + ((long)(b * SEQ + q0)) * DM + h * 128, DM, shm, wv);
  }
}

__device__ __forceinline__ void cross_attn_phase(const Params& p, int layer, char* shm, int wv) {
  const u16* caq = p.B0; u16* cao = p.B1;
  const u16* mK = p.memK + (long)layer * NB * MEML * DM; const u16* mVT = p.memVT + (long)layer * NB * DM * MEML;
  for (int i = blockIdx.x; i < 1024; i += gridDim.x) {
    int head = i & 3, blk = i >> 2, b = blk >> 6, qblk = blk & 63;
    __syncthreads();
    flash_item<1, 256, 256, false, true>(caq + ((long)(b * SEQ + qblk * 128)) * DM + head * 256, DM, mK + ((long)b * MEML) * DM + head * 256, DM,
                                   mVT + ((long)(b * DM + head * 256)) * MEML, MEML, 4, 0, 0.0625f * LOG2E, nullptr, 0.f, nullptr, 1.f,
                                   cao + ((long)(b * SEQ + qblk * 128)) * DM + head * 256, DM, shm, wv);
  }
}

constexpr int HLD = 132;
__device__ __forceinline__ long kdt_off(int tok0, int h, int k) {
  return ((long)(tok0 + (k >> 1)) * DM + h * 128) + (k & 1) * 64;
}

__device__ __forceinline__ void hg1_phase(const Params& p, char* shm, int wv) {
  float* L = (float*)shm; float* Gs = L + 64 * HLD; float* Qs = Gs + 64 * HLD; float* R = Qs + 64 * HLD;
  int tid = opaque_tid(wv), wid = tid >> 6, lane = tid & 63, fr = lane & 15, fq = lane >> 4;
  u16* qbuf = p.B0; u16* lfbuf = p.B1; u16* Abuf = p.B4;
  u32x4 plv[2], pqv[2];
#define HG1_PREFETCH(it_) do { int h_ = (it_) & 7, cn_ = ((it_) >> 3) & 127, b_ = (it_) >> 10, tk_ = b_ * SEQ + cn_ * 64; \
    _Pragma("unroll") for (int i = 0; i < 2; ++i) { int id = tid + i * 512, row = id >> 4, cc = id & 15; \
      plv[i] = *(const u32x4*)&lfbuf[(long)(tk_ + row) * DM + h_ * 128 + cc * 8]; pqv[i] = *(const u32x4*)&qbuf[(long)(tk_ + row) * DM + h_ * 128 + cc * 8]; } } while (0)
  if ((int)blockIdx.x < 4096) HG1_PREFETCH((int)blockIdx.x);
  for (int it = blockIdx.x; it < 4096; it += gridDim.x) {
    int h = it & 7, cn = (it >> 3) & 127, b = it >> 10, tok0 = b * SEQ + cn * 64;
    __syncthreads();
    _Pragma("unroll") for (int i = 0; i < 2; ++i) {
      int id = tid + i * 512, row = id >> 4, cc = id & 15;
      _Pragma("unroll") for (int e = 0; e < 4; ++e) {
        unsigned lw = plv[i][e], qw = pqv[i][e];
        L[row * HLD + cc * 8 + 2 * e] = __uint_as_float(lw << 16); L[row * HLD + cc * 8 + 2 * e + 1] = __uint_as_float(lw & 0xffff0000u);
        Qs[row * HLD + cc * 8 + 2 * e] = __uint_as_float(qw << 16); Qs[row * HLD + cc * 8 + 2 * e + 1] = __uint_as_float(qw & 0xffff0000u);
      }
    }
    __syncthreads();
    if (it + (int)gridDim.x < 4096) HG1_PREFETCH(it + (int)gridDim.x);
    {
      int k = tid & 127, qd = tid >> 7; float run = 0.f;
      _Pragma("unroll") for (int i = 0; i < 16; ++i) { run += L[(16 * qd + i) * HLD + k]; Gs[(16 * qd + i) * HLD + k] = run; }
      R[(qd + 1) * 128 + k] = run;
    }
    __syncthreads();
    {
      int k = tid & 127, qd = tid >> 7; float r = 0.f;
      for (int i = 0; i < qd; ++i) r += R[(i + 1) * 128 + k];
      float tot = R[(qd + 1) * 128 + k];
      __syncthreads();
      _Pragma("unroll") for (int i = 0; i < 16; ++i) Gs[(16 * qd + i) * HLD + k] += r;
      R[qd * 128 + k] = r;
      if (qd == 3) R[4 * 128 + k] = r + tot;
    }
    __syncthreads();
    _Pragma("unroll") for (int i = 0; i < 2; ++i) {
      int id = tid + i * 512, row = id >> 4, cc = id & 15; float v[8];
      _Pragma("unroll") for (int e = 0; e < 8; ++e) v[e] = Qs[row * HLD + cc * 8 + e] * __expf(Gs[row * HLD + cc * 8 + e]);
      uint2 lo = pack4(v[0], v[1], v[2], v[3]), hi = pack4(v[4], v[5], v[6], v[7]);
      uint4 o; o.x = lo.x; o.y = lo.y; o.z = hi.x; o.w = hi.y;
      *(uint4*)&qbuf[(long)(tok0 + row) * DM + h * 128 + cc * 8] = o;
    }
    _Pragma("unroll") for (int i = 0; i < 2; ++i) {
      int id = tid + i * 512, k = id & 127, sc = id >> 7; float gl = R[4 * 128 + k]; float v[8];
      _Pragma("unroll") for (int e = 0; e < 8; ++e) { int s = sc * 8 + e; v[e] = (1.f - __expf(L[s * HLD + k])) * __expf(gl - Gs[s * HLD + k]); }
      uint2 lo = pack4(v[0], v[1], v[2], v[3]), hi = pack4(v[4], v[5], v[6], v[7]);
      uint4 o; o.x = lo.x; o.y = lo.y; o.z = hi.x; o.w = hi.y;
      *(uint4*)&lfbuf[kdt_off(tok0, h, k) + sc * 8] = o;
    }
    if (tid < 128) p.dbuf[(long)it * 128 + tid] = __expf(R[4 * 128 + tid]);
    u16* Ait = Abuf + (long)it * 4096;
    for (int blk = wid; blk < 10; blk += 8) {
      int ti = blk < 1 ? 0 : (blk < 3 ? 1 : (blk < 6 ? 2 : 3));
      int sj = blk - (ti * (ti + 1)) / 2;
      f32x4 acc = {0.f, 0.f, 0.f, 0.f};
      _Pragma("unroll") for (int ks = 0; ks < 4; ++ks) {
        float av[8], bv[8];
        _Pragma("unroll") for (int e = 0; e < 8; ++e) {
          int kk = ks * 32 + fq * 8 + e; float rr = R[ti * 128 + kk];
          av[e] = Qs[(16 * ti + fr) * HLD + kk] * __expf(Gs[(16 * ti + fr) * HLD + kk] - rr);
          bv[e] = (1.f - __expf(L[(16 * sj + fr) * HLD + kk])) * __expf(fminf(rr - Gs[(16 * sj + fr) * HLD + kk], 80.f));
        }
        uint2 al = pack4(av[0], av[1], av[2], av[3]), ah = pack4(av[4], av[5], av[6], av[7]);
        uint2 bl = pack4(bv[0], bv[1], bv[2], bv[3]), bh = pack4(bv[4], bv[5], bv[6], bv[7]);
        uint4 a4, b4; a4.x = al.x; a4.y = al.y; a4.z = ah.x; a4.w = ah.y; b4.x = bl.x; b4.y = bl.y; b4.z = bh.x; b4.w = bh.y;
        acc = __builtin_amdgcn_mfma_f32_16x16x32_bf16(*(bf16x8*)&a4, *(bf16x8*)&b4, acc, 0, 0, 0);
      }
      _Pragma("unroll") for (int j = 0; j < 4; ++j) {
        int t = 16 * ti + fq * 4 + j, s = 16 * sj + fr;
        float v = (s <= t) ? acc[j] : 0.f;
        Ait[t * 64 + s] = f2bf(v);
      }
    }
    if (wid < 6) {
      int ti = wid < 3 ? 0 : (wid < 5 ? 1 : 2);
      int sj = wid < 3 ? wid + 1 : (wid < 5 ? wid - 1 : 3);
      _Pragma("unroll") for (int j = 0; j < 4; ++j) Ait[(16 * ti + fq * 4 + j) * 64 + 16 * sj + fr] = 0;
    }
  }
}

template <int MODE>
__device__ __forceinline__ void hg2_phase(const Params& p, char* shm, int wv) {
  constexpr int QLD = 136, KLD = 72;
  constexpr int QB = 64 * QLD, KB = 128 * KLD, AB = 64 * KLD, VB = 128 * KLD;
  constexpr int BUF_EL = QB + KB + AB + VB + 256;
  int tid = opaque_tid(wv), wid = tid >> 6, lane = tid & 63, fr = lane & 15, fq = lane >> 4;
  u16* qbuf = p.B0; const u16* kdbuf = p.B1; const u16* iT = p.B2; const u16* Abuf = p.B4;
  float* Send = p.out; float* Dseg = Send + 32L * 8 * 128 * 128;
  for (int it = blockIdx.x; it < 256; it += gridDim.x) {
    int bh = it >> 3, seg = it & 7, b = bh >> 3, h = bh & 7;
    if (MODE == 0 && seg == 7) continue;
    f32x4 S[8];
    _Pragma("unroll") for (int m = 0; m < 8; ++m) S[m] = f32x4{0.f, 0.f, 0.f, 0.f};
    if (MODE == 1) {
      for (int g = 0; g < seg; ++g) {
        const float* se = Send + ((long)(bh * 8 + g)) * 16384; const float* dg = Dseg + (bh * 8 + g) * 128;
        _Pragma("unroll") for (int m = 0; m < 8; ++m) {
          float4 dv = *(const float4*)&dg[16 * m + fq * 4];
          S[m][0] = S[m][0] * dv.x + se[(16 * m + fq * 4 + 0) * 128 + 16 * wid + fr];
          S[m][1] = S[m][1] * dv.y + se[(16 * m + fq * 4 + 1) * 128 + 16 * wid + fr];
          S[m][2] = S[m][2] * dv.z + se[(16 * m + fq * 4 + 2) * 128 + 16 * wid + fr];
          S[m][3] = S[m][3] * dv.w + se[(16 * m + fq * 4 + 3) * 128 + 16 * wid + fr];
        }
      }
    }
    float dacc = 1.f;
    u32x4 rq[2], rk[2], ra, rv[2]; f32x4 rd = {0.f, 0.f, 0.f, 0.f};
#define HG_PREFETCH(cn_) do { int tok0_ = b * SEQ + (cn_) * 64; long it_ = ((long)(b * 128 + (cn_))) * 8 + h; \
      if (MODE == 1) { _Pragma("unroll") for (int i = 0; i < 2; ++i) { int id = tid + i * 512, row = id >> 4, cc = id & 15; rq[i] = *(const u32x4*)&qbuf[(long)(tok0_ + row) * DM + h * 128 + cc * 8]; } } \
      _Pragma("unroll") for (int i = 0; i < 2; ++i) { int id = tid + i * 512, k = id >> 3, sc = id & 7; rk[i] = *(const u32x4*)&kdbuf[kdt_off(tok0_, h, k) + sc * 8]; } \
      if (MODE == 1) { int t = tid >> 3, sc = tid & 7; ra = *(const u32x4*)&Abuf[it_ * 4096 + t * 64 + sc * 8]; } \
      _Pragma("unroll") for (int i = 0; i < 2; ++i) { int id = tid + i * 512, v = id >> 3, sc = id & 7; rv[i] = *(const u32x4*)&iT[((long)(b * 128 + (cn_)) * DM + h * 128 + v) * 64 + sc * 8]; } \
      if (tid < 32) rd = *(const f32x4*)&p.dbuf[it_ * 128 + tid * 4]; } while (0)
#define HG_STASH(bi_) do { \
      u16* base_ = (u16*)shm + (bi_) * BUF_EL; u16* Qt_ = base_; u16* Kd_ = Qt_ + QB; u16* At_ = Kd_ + KB; u16* Vt_ = At_ + AB; float* dd_ = (float*)(Vt_ + VB); \
      if (MODE == 1) { _Pragma("unroll") for (int i = 0; i < 2; ++i) { int id = tid + i * 512, row = id >> 4, cc = id & 15; *(u32x4*)&Qt_[row * QLD + cc * 8] = rq[i]; } } \
      _Pragma("unroll") for (int i = 0; i < 2; ++i) { int id = tid + i * 512, k = id >> 3, sc = id & 7; *(u32x4*)&Kd_[k * KLD + sc * 8] = rk[i]; } \
      if (MODE == 1) { int t = tid >> 3, sc = tid & 7; *(u32x4*)&At_[t * KLD + sc * 8] = ra; } \
      _Pragma("unroll") for (int i = 0; i < 2; ++i) { int id = tid + i * 512, v = id >> 3, sc = id & 7; *(u32x4*)&Vt_[v * KLD + sc * 8] = rv[i]; } \
      if (tid < 32) *(f32x4*)&dd_[tid * 4] = rd; } while (0)
    __syncthreads();
    HG_PREFETCH(seg * 16); HG_STASH(0);
    for (int c = 0; c < 16; ++c) {
      int cn = seg * 16 + c;
      __syncthreads();
      if (c + 1 < 16) HG_PREFETCH(cn + 1);
      u16* base = (u16*)shm + (c & 1) * BUF_EL; u16* Qt = base; u16* Kd = Qt + QB; u16* At = Kd + KB; u16* Vt = At + AB; float* dd = (float*)(Vt + VB);
      bf16x8 vb[2];
      _Pragma("unroll") for (int k2 = 0; k2 < 2; ++k2) vb[k2] = *(const bf16x8*)&Vt[(16 * wid + fr) * KLD + k2 * 32 + fq * 8];
      if (MODE == 1) {
        bf16x8 Sb[4];
        _Pragma("unroll") for (int ks = 0; ks < 4; ++ks) {
          uint2 lo = pack4(S[2 * ks][0], S[2 * ks][1], S[2 * ks][2], S[2 * ks][3]);
          uint2 hi = pack4(S[2 * ks + 1][0], S[2 * ks + 1][1], S[2 * ks + 1][2], S[2 * ks + 1][3]);
          uint4 pk; pk.x = lo.x; pk.y = lo.y; pk.z = hi.x; pk.w = hi.y; Sb[ks] = *(bf16x8*)&pk;
        }
        int tok0 = b * SEQ + cn * 64;
        _Pragma("unroll") for (int rt = 0; rt < 4; ++rt) {
          f32x4 o = {0.f, 0.f, 0.f, 0.f};
          _Pragma("unroll") for (int ks = 0; ks < 4; ++ks) {
            uint2 lo = *(const uint2*)&Qt[(16 * rt + fr) * QLD + 32 * ks + fq * 4];
            uint2 hi = *(const uint2*)&Qt[(16 * rt + fr) * QLD + 32 * ks + 16 + fq * 4];
            uint4 pk; pk.x = lo.x; pk.y = lo.y; pk.z = hi.x; pk.w = hi.y;
            o = __builtin_amdgcn_mfma_f32_16x16x32_bf16(*(bf16x8*)&pk, Sb[ks], o, 0, 0, 0);
          }
          _Pragma("unroll") for (int k2 = 0; k2 < 2; ++k2) {
            bf16x8 a = *(const bf16x8*)&At[(16 * rt + fr) * KLD + k2 * 32 + fq * 8];
            o = __builtin_amdgcn_mfma_f32_16x16x32_bf16(a, vb[k2], o, 0, 0, 0);
          }
          _Pragma("unroll") for (int j = 0; j < 4; ++j) qbuf[(long)(tok0 + 16 * rt + fq * 4 + j) * DM + h * 128 + 16 * wid + fr] = f2bf(o[j]);
        }
      } else if (tid < 128) dacc *= dd[tid];
      _Pragma("unroll") for (int m = 0; m < 8; ++m) {
        float4 dv = *(const float4*)&dd[16 * m + fq * 4];
        S[m][0] *= dv.x; S[m][1] *= dv.y; S[m][2] *= dv.z; S[m][3] *= dv.w;
        _Pragma("unroll") for (int k2 = 0; k2 < 2; ++k2) {
          bf16x8 a = *(const bf16x8*)&Kd[(16 * m + fr) * KLD + k2 * 32 + fq * 8];
          S[m] = __builtin_amdgcn_mfma_f32_16x16x32_bf16(a, vb[k2], S[m], 0, 0, 0);
        }
      }
      if (c + 1 < 16) HG_STASH((c + 1) & 1);
    }
    if (MODE == 0) {
      float* se = Send + ((long)(bh * 8 + seg)) * 16384;
      _Pragma("unroll") for (int m = 0; m < 8; ++m) _Pragma("unroll") for (int j = 0; j < 4; ++j) se[(16 * m + fq * 4 + j) * 128 + 16 * wid + fr] = S[m][j];
      if (tid < 128) Dseg[(bh * 8 + seg) * 128 + tid] = dacc;
    }
  }
}

__device__ __forceinline__ void hg3_phase(const Params& p, int wv) {
  int tid = opaque_tid(wv); int wid = tid >> 6, lane = tid & 63;
  u16* ob = p.B0; const u16* gb = p.B3;
  for (int row = blockIdx.x * 8 + wid; row < T_TOK; row += gridDim.x * 8) {
    uint4 o0 = *(const uint4*)&ob[(long)row * DM + lane * 16], o1 = *(const uint4*)&ob[(long)row * DM + lane * 16 + 8];
    uint4 g0 = *(const uint4*)&gb[(long)row * DM + lane * 16], g1 = *(const uint4*)&gb[(long)row * DM + lane * 16 + 8];
    float o[16], g[16];
    const u16* po0 = (const u16*)&o0; const u16* po1 = (const u16*)&o1; const u16* pg0 = (const u16*)&g0; const u16* pg1 = (const u16*)&g1;
    _Pragma("unroll") for (int e = 0; e < 8; ++e) { o[e] = bf2f(po0[e]); o[8 + e] = bf2f(po1[e]); g[e] = bf2f(pg0[e]); g[8 + e] = bf2f(pg1[e]); }
    float ss = 0.f; _Pragma("unroll") for (int e = 0; e < 16; ++e) ss += o[e] * o[e];
    ss += sx<1>(ss, lane); ss += sx<2>(ss, lane); ss += sx<4>(ss, lane);
    float rs = rsqrtf(ss * (1.f / 128.f) + EPS);
    int c0 = (lane & 7) * 16; float r[16];
    _Pragma("unroll") for (int e = 0; e < 16; ++e) r[e] = o[e] * rs * p.hg_onorm[c0 + e] * silu_f(g[e]);
    uint2 a = pack4(r[0], r[1], r[2], r[3]), b2 = pack4(r[4], r[5], r[6], r[7]), c = pack4(r[8], r[9], r[10], r[11]), d = pack4(r[12], r[13], r[14], r[15]);
    uint4 w0, w1; w0.x = a.x; w0.y = a.y; w0.z = b2.x; w0.w = b2.y; w1.x = c.x; w1.y = c.y; w1.z = d.x; w1.w = d.y;
    *(uint4*)&ob[(long)row * DM + lane * 16] = w0; *(uint4*)&ob[(long)row * DM + lane * 16 + 8] = w1;
  }
}

__device__ __forceinline__ void sgu_phase(const Params& p, char* shm, int wv) {
  constexpr int WLD = 136;
  u16* Wp = (u16*)shm; float* rsv = (float*)(shm + 128 * WLD * 2);
  int tid = opaque_tid(wv), wid = tid >> 6, lane = tid & 63, fr = lane & 15, fq = lane >> 4;
  const u16* ub = p.B0; const u16* vT = p.B1; u16* ob = p.B2; const float* rowss_v = p.vpart;
  for (int it = blockIdx.x; it < 2048; it += gridDim.x) {
    int g = it & 7, c128 = it >> 3, tok0 = c128 * 128;
    __syncthreads();
    if (tid < 128) rsv[tid] = row_rs(rowss_v, tok0 + tid);
    __syncthreads();
    _Pragma("unroll") for (int i = 0; i < 4; ++i) {
      int id = tid + i * 512, t = id >> 4, sc = id & 15;
      const float4* w4 = (const float4*)(p.sg_w_s + ((long)(g * 128 + t)) * 128 + sc * 8);
      float4 a = w4[0], b = w4[1]; float v[8] = {a.x, a.y, a.z, a.w, b.x, b.y, b.z, b.w};
      _Pragma("unroll") for (int e = 0; e < 8; ++e) { int s = sc * 8 + e; v[e] = (s <= t) ? v[e] * rsv[s] : 0.f; }
      uint2 lo = pack4(v[0], v[1], v[2], v[3]), hi = pack4(v[4], v[5], v[6], v[7]);
      uint4 o; o.x = lo.x; o.y = lo.y; o.z = hi.x; o.w = hi.y;
      *(uint4*)&Wp[t * WLD + sc * 8] = o;
    }
    bf16x8 vb[4];
    int cc = g * 128 + 16 * wid + fr;
    _Pragma("unroll") for (int ks = 0; ks < 4; ++ks) vb[ks] = *(const bf16x8*)&vT[((long)c128 * DM + cc) * 128 + ks * 32 + fq * 8];
    float4 gvn = *(const float4*)&p.sg_vnorm[g * 128 + 16 * wid + fq * 4];
    __syncthreads();
    _Pragma("unroll") for (int mt = 0; mt < 8; ++mt) {
      f32x4 acc = {0.f, 0.f, 0.f, 0.f};
      _Pragma("unroll") for (int ks = 0; ks <= (mt >> 1); ++ks) {
        bf16x8 a = *(const bf16x8*)&Wp[(16 * mt + fr) * WLD + ks * 32 + fq * 8];
        acc = __builtin_amdgcn_mfma_f32_16x16x32_bf16(vb[ks], a, acc, 0, 0, 0);
      }
      int t = 16 * mt + fr; float bs = p.sg_b_s[g * 128 + t];
      long idx = (long)(tok0 + t) * DM + g * 128 + 16 * wid + fq * 4;
      uint2 uv = *(const uint2*)&ub[idx];
      float u0 = __uint_as_float(uv.x << 16), u1 = __uint_as_float(uv.x & 0xffff0000u), u2 = __uint_as_float(uv.y << 16), u3 = __uint_as_float(uv.y & 0xffff0000u);
      *(uint2*)&ob[idx] = pack4(u0 * (acc[0] * gvn.x + bs), u1 * (acc[1] * gvn.y + bs), u2 * (acc[2] * gvn.z + bs), u3 * (acc[3] * gvn.w + bs));
    }
  }
}

__device__ __forceinline__ void final_phase(const Params& p, int wv) {
  int tid = opaque_tid(wv); int wid = tid >> 6, lane = tid & 63;
  for (int row = blockIdx.x * 8 + wid; row < T_TOK; row += gridDim.x * 8) {
    float rs = row_rs(p.rpart, row);
    float4* o4 = (float4*)(p.out + (long)row * DM);
    const uint2* x2 = (const uint2*)(p.xb + (long)row * DM);
    _Pragma("unroll") for (int i = 0; i < 4; ++i) {
      uint2 xv = x2[i * 64 + lane]; float4 g = ((const float4*)p.norm_final)[i * 64 + lane]; float4 v;
      v.x = __uint_as_float(xv.x << 16) * rs * g.x; v.y = __uint_as_float(xv.x & 0xffff0000u) * rs * g.y;
      v.z = __uint_as_float(xv.y << 16) * rs * g.z; v.w = __uint_as_float(xv.y & 0xffff0000u) * rs * g.w;
      o4[i * 64 + lane] = v;
    }
  }
}

#define XB_TMO      128
#define XB_XCNT(j)  (256  + 64 * (j))
#define XB_XSUB(j)  (1280 + 64 * (j))
#define XB_XGEN(j)  (2304 + 64 * (j))
#define XB_TOP      3328
#define XB_TOPGEN   3392
#define XCD_BAR_WORDS 3456
#define XB_SPIN_CAP (1u << 22)
#define LAS __attribute__((address_space(3)))

__device__ __forceinline__ unsigned xb_ld(unsigned* p)              { return __hip_atomic_load(p, __ATOMIC_RELAXED, __HIP_MEMORY_SCOPE_AGENT); }
__device__ __forceinline__ unsigned xb_add(unsigned* p, unsigned v) { return __hip_atomic_fetch_add(p, v, __ATOMIC_RELAXED, __HIP_MEMORY_SCOPE_AGENT); }
__device__ __forceinline__ unsigned xb_xcc_id() { return (unsigned)__builtin_amdgcn_s_getreg((3 << 11) | 20) & 0xFu; }
#define XB_SPIN(cond, bar) do { unsigned _sp = 0; while (cond) { __builtin_amdgcn_s_sleep(1); \
    if ((++_sp & 255u) == 0u) { if (xb_ld(&(bar)[XB_TMO])) break; if (_sp > XB_SPIN_CAP) { atomicAdd(&(bar)[XB_TMO], 1u); break; } } } } while (0)

struct XcdBarrier {
    unsigned* bar; unsigned x;
    volatile LAS unsigned* st;
};

__device__ __forceinline__ XcdBarrier xcd_barrier_post(unsigned* bar, volatile LAS unsigned* st, bool t0) {
    XcdBarrier b; b.bar = bar; b.x = xb_xcc_id(); b.st = st;
    if (t0) (void)xb_add(&bar[XB_XCNT(b.x)], 1u);
    return b;
}
__device__ __forceinline__ void xcd_barrier_complete(unsigned* bar, unsigned x, unsigned& nloc, unsigned& nx) {
    const unsigned G = gridDim.x * gridDim.y * gridDim.z;
    unsigned sum, cnt, mine, sp = 0u;
    for (;;) {
        sum = 0u; cnt = 0u; mine = 0u;
#pragma unroll
        for (unsigned j = 0; j < 16; ++j) { const unsigned c = xb_ld(&bar[XB_XCNT(j)]); sum += c; cnt += (c > 0u) ? 1u : 0u; mine = (j == x) ? c : mine; }
        if (sum == G) break;
        __builtin_amdgcn_s_sleep(1);
        if ((++sp & 255u) == 0u) { if (xb_ld(&bar[XB_TMO])) break; if (sp > XB_SPIN_CAP) { atomicAdd(&bar[XB_TMO], 1u); break; } }
    }
    nloc = mine > 0u ? mine : 1u; nx = cnt > 0u ? cnt : 1u;
}

__device__ __forceinline__ void xcd_barrier(const XcdBarrier& b, bool t0) {
    asm volatile("s_waitcnt vmcnt(0)" ::: "memory");
    __syncthreads();
    if (t0) {
        unsigned* bar = b.bar;
        __builtin_amdgcn_s_waitcnt(0);
        unsigned nloc = b.st[0], nx = b.st[1];
        if (nloc == 0u) { xcd_barrier_complete(bar, b.x, nloc, nx); b.st[0] = nloc; b.st[1] = nx; }
        const unsigned old = xb_add(&bar[XB_XSUB(b.x)], 1u);
        const unsigned gen = old / nloc;
        if (old + 1u == (gen + 1u) * nloc) {
            __builtin_amdgcn_fence(__ATOMIC_RELEASE, "agent");
            asm volatile("s_waitcnt vmcnt(0)" ::: "memory");
            const unsigned og = xb_add(&bar[XB_TOP], 1u);
            const unsigned tg = og / nx;
            if (og + 1u == (tg + 1u) * nx) xb_add(&bar[XB_TOPGEN], 1u);
            else XB_SPIN(xb_ld(&bar[XB_TOPGEN]) == tg, bar);
            __builtin_amdgcn_fence(__ATOMIC_ACQUIRE, "agent");
            xb_add(&bar[XB_XGEN(b.x)], 1u);
            asm volatile("s_waitcnt vmcnt(0)" ::: "memory");
        } else {
            XB_SPIN(xb_ld(&bar[XB_XGEN(b.x)]) == gen, bar);
            __builtin_amdgcn_fence(__ATOMIC_ACQUIRE, "agent");
            asm volatile("s_waitcnt vmcnt(0)" ::: "memory");
        }
    }
    __syncthreads();
}


#define SEL4(arr, i) ((i) == 0 ? (arr)[0] : ((i) == 1 ? (arr)[1] : ((i) == 2 ? (arr)[2] : (arr)[3])))
__global__ void __launch_bounds__(512, 2) fwd_megakernel(KArgs ka_unused) {
  extern __shared__ __attribute__((aligned(16))) char shm[];
  const int wv = __builtin_amdgcn_readfirstlane((int)(threadIdx.x >> 6));
  int ph = 0;
#define BARRIER_WS ((unsigned*)(kargs_ptr()->ws + OFF_BAR))
#if MULTI_LAUNCH
#define PHASE_BEGIN if (ph >= kargs_ptr()->phase_lo && ph < kargs_ptr()->phase_hi) { const Params p = make_params(*kargs_ptr());
#define PHASE_END } ++ph;
#else
  cg::grid_group grid = cg::this_grid();
#define PHASE_BEGIN { const Params p = make_params(*kargs_ptr());
#define PHASE_END } ++ph; { XcdBarrier xb_; xb_.bar = BARRIER_WS; xb_.x = xb_xcc_id(); xb_.st = (volatile LAS unsigned*)(shm + LDS_BYTES - 16); xcd_barrier(xb_, opaque_tid(wv) == 0); }
#endif
#define LAYER_VARS \
    const float* xin = (i == 0) ? p.x : p.out; float* rs_mix = p.rpart; float* rs_cross = p.rpart; float* rs_ffn = p.rpart; float* rs_next = p.rpart; \
    const u16* w_mix_in = p.wbase + layer_woff(i); const u16* w_mix_out = w_mix_in + mixin_elems(i); const u16* w_caq = w_mix_out + 1048576L; \
    const u16* w_cao = w_caq + 3145728L; const u16* w_gu = w_cao + 1048576L; const u16* w_down = w_gu + 5767168L; \
    const u16* mix_out_A = kind == 0 ? p.B3 : (kind == 1 ? p.B0 : p.B2); \
    (void)xin; (void)rs_mix; (void)rs_cross; (void)rs_ffn; (void)rs_next; (void)w_mix_in; (void)w_mix_out; (void)w_caq; (void)w_cao; (void)w_gu; (void)w_down; (void)mix_out_A;
#if MULTI_LAUNCH
  PHASE_BEGIN prep_phase(p, kargs_ptr(), shm, wv); PHASE_END
#else
  { const Params p = make_params(*kargs_ptr()); prep_phase(p, kargs_ptr(), shm, wv); } ++ph;
  grid.sync();
  {
    volatile LAS unsigned* xb_st = (volatile LAS unsigned*)(shm + LDS_BYTES - 16);
    if (opaque_tid(wv) == 0) { xb_st[0] = 0u; xb_st[1] = 0u; }
    __syncthreads();
    (void)xcd_barrier_post(BARRIER_WS, xb_st, opaque_tid(wv) == 0);
  }
#endif
  _Pragma("nounroll") for (int i = 0; i < 4; ++i) {
    int kind = i % 3, j = i / 3;
    if (kind == 0) {
      PHASE_BEGIN LAYER_VARS
        if (i == 0) {
          for (int t = blockIdx.x; t < 128; t += gridDim.x) {
            int l = t >> 5, tt = t & 31, tr0 = (tt & 3) * BM, fc0 = (tt >> 2) * BM;
            EpiMemKV em{p.memK + (long)l * NB * MEML * DM, p.memVT + (long)l * NB * DM * MEML};
            const u16* mA = p.memn; const u16* mB = p.wbase + layer_woff(l) + mixin_elems(l) + 2097152L;
            bool sw = em.swap(fc0);
            gemm_tile(sw ? mB : mA, sw ? mA : mB, DM, sw ? fc0 : tr0, sw ? tr0 : fc0, shm, em, tr0, fc0, sw, false, false, mA, mB, 0, 0, wv);
          }
        }
        EpiDaIn e{rs_mix, p.B0, p.B1, p.B2}; gemm_phase(p.xb, w_mix_in, T_TOK, 3 * DM, DM, shm, e, wv);
      PHASE_END
      PHASE_BEGIN diff_attn_phase(p, j, i, shm, wv); PHASE_END
    } else if (kind == 1) {
      PHASE_BEGIN LAYER_VARS EpiHgIn e{rs_mix, p.lbv, p.B0, p.B1, p.B2, p.B3}; gemm_phase(p.xb, w_mix_in, T_TOK, 4 * DM, DM, shm, e, wv); PHASE_END
      PHASE_BEGIN hg1_phase(p, shm, wv); PHASE_END
      PHASE_BEGIN hg2_phase<0>(p, shm, wv); PHASE_END
      PHASE_BEGIN hg2_phase<1>(p, shm, wv); PHASE_END
      PHASE_BEGIN hg3_phase(p, wv); PHASE_END
    } else {
      PHASE_BEGIN LAYER_VARS EpiSgIn e{rs_mix, p.B0, p.B1, p.vpart}; gemm_phase(p.xb, w_mix_in, T_TOK, 2 * DM, DM, shm, e, wv); PHASE_END
      PHASE_BEGIN sgu_phase(p, shm, wv); PHASE_END
    }
    PHASE_BEGIN LAYER_VARS EpiRes e{p.xb, rs_cross}; gemm_phase(mix_out_A, w_mix_out, T_TOK, DM, DM, shm, e, wv); PHASE_END
    PHASE_BEGIN LAYER_VARS EpiStore e{rs_cross, p.B0, DM}; gemm_phase(p.xb, w_caq, T_TOK, DM, DM, shm, e, wv); PHASE_END
    PHASE_BEGIN cross_attn_phase(p, i, shm, wv); PHASE_END
    PHASE_BEGIN LAYER_VARS EpiRes e{p.xb, rs_ffn}; gemm_phase(p.B1, w_cao, T_TOK, DM, DM, shm, e, wv); PHASE_END
    PHASE_BEGIN LAYER_VARS EpiFfn e{rs_ffn, p.B0}; gemm_phase(p.xb, w_gu, T_TOK, 2 * DFF, DM, shm, e, wv); PHASE_END
    PHASE_BEGIN LAYER_VARS EpiRes e{p.xb, rs_next}; gemm_phase(p.B0, w_down, T_TOK, DM, DFF, shm, e, wv); PHASE_END
  }
#if MULTI_LAUNCH
  PHASE_BEGIN final_phase(p, wv); PHASE_END
#else
  { const Params p = make_params(*kargs_ptr()); final_phase(p, wv); }
#endif
}

extern "C" void kernel_launch(void* const* d_in, const int* in_sizes, int n_in, void* d_out, int out_size, void* d_ws, size_t ws_size,
                              hipStream_t stream) {
  static int grid_blocks = 0;
  if (!grid_blocks) {
    int dev = 0, cus = 0, per_cu = 0;
    hipGetDevice(&dev);
    hipDeviceGetAttribute(&cus, hipDeviceAttributeMultiprocessorCount, dev);
    if (hipFuncSetAttribute((const void*)fwd_megakernel, hipFuncAttributeMaxDynamicSharedMemorySize, LDS_BYTES) != hipSuccess)
      fprintf(stderr, "hipFuncSetAttribute failed\n");
    hipOccupancyMaxActiveBlocksPerMultiprocessor(&per_cu, (const void*)fwd_megakernel, 512, LDS_BYTES);
    if (per_cu < 1) { fprintf(stderr, "occupancy query returned %d\n", per_cu); per_cu = 1; }
    grid_blocks = cus * per_cu;
    (void)hipGetLastError();
  }
  KArgs p;
  memset(&p, 0, sizeof(p));
  const float* const* in = (const float* const*)d_in;
  p.x = in[0]; p.mem = in[1]; p.rel_bias = in[2];
  const float *norm_mix = in[3], *norm_cross = in[4], *norm_ffn = in[5];
  p.norm_mem = in[6]; p.norm_final = in[7];
  const float *da_w_in = in[8], *da_w_out = in[9];
  p.da_lq1 = in[10]; p.da_lk1 = in[11]; p.da_lq2 = in[12]; p.da_lk2 = in[13]; p.da_subln = in[14];
  const float *hg_w_in = in[15], *hg_w_out = in[16];
  p.hg_lb = in[17]; p.hg_onorm = in[18];
  const float *sg_w_in = in[19], *sg_w_out = in[20];
  p.sg_vnorm = in[21]; p.sg_w_s = in[22]; p.sg_b_s = in[23];
  const float *ca_w_q = in[24], *ca_w_kv = in[25], *ca_w_o = in[26], *ffn_w_gu = in[27], *ffn_w_down = in[28];
  p.out = (float*)d_out; p.ws = (char*)d_ws;
  if (WS_END > ws_size) { fprintf(stderr, "workspace too small: need %zu have %zu\n", (size_t)WS_END, ws_size); return; }
  int nwd = 0, tiles = 0;
  u16* wcur = (u16*)((char*)d_ws + OFF_W);
  auto addw = [&](const float* src, int K, int N, const float* gain, int perm) {
    WDesc& w = p.wd[nwd++]; w.src = src; w.dst = wcur; w.gain = gain; w.K = K; w.N = N; w.perm = perm; w.tile0 = tiles;
    tiles += (K / 64) * (N / 64); wcur += (size_t)K * N;
  };
  for (int i = 0; i < 4; ++i) {
    int kind = i % 3, j = i / 3;
    if (wcur != (u16*)((char*)d_ws + OFF_W) + layer_woff(i)) fprintf(stderr, "weight layout mismatch at layer %d\n", i);
    if (kind == 0) { addw(da_w_in + (size_t)j * DM * 3 * DM, DM, 3 * DM, norm_mix + i * DM, 0); addw(da_w_out + (size_t)j * DM * DM, DM, DM, nullptr, 0); }
    else if (kind == 1) { addw(hg_w_in + (size_t)j * DM * 4 * DM, DM, 4 * DM, norm_mix + i * DM, 0); addw(hg_w_out + (size_t)j * DM * DM, DM, DM, nullptr, 0); }
    else { addw(sg_w_in + (size_t)j * DM * 2 * DM, DM, 2 * DM, norm_mix + i * DM, 0); addw(sg_w_out + (size_t)j * DM * DM, DM, DM, nullptr, 0); }
    addw(ca_w_q + (size_t)i * DM * DM, DM, DM, norm_cross + i * DM, 0);
    addw(ca_w_kv + (size_t)i * DM * 2 * DM, DM, 2 * DM, nullptr, 0);
    addw(ca_w_o + (size_t)i * DM * DM, DM, DM, nullptr, 0);
    addw(ffn_w_gu + (size_t)i * DM * 2 * DFF, DM, 2 * DFF, norm_ffn + i * DM, 1);
    addw(ffn_w_down + (size_t)i * DFF * DM, DFF, DM, nullptr, 0);
  }
  p.nwd = nwd; p.total_wtiles = tiles;
#if MULTI_LAUNCH
  _Pragma("unroll") for (int ph = 0; ph < 64; ++ph) {
    p.phase_lo = ph; p.phase_hi = ph + 1;
    hipLaunchKernelGGL(fwd_megakernel, dim3(grid_blocks), dim3(512), LDS_BYTES, stream, p);
  }
#else
  p.phase_lo = 0; p.phase_hi = 1 << 30;
  void* args[] = {&p};
  hipError_t e = hipLaunchCooperativeKernel((void*)fwd_megakernel, dim3(grid_blocks), dim3(512), args, LDS_BYTES, stream);
  if (e != hipSuccess) fprintf(stderr, "cooperative launch failed: %s (grid %d)\n", hipGetErrorString(e), grid_blocks);
#endif
}
```

```cpp
#include <hip/hip_runtime.h>
#include <hip/hip_cooperative_groups.h>
#include <cstdio>
#include <cmath>
#include <cstring>
namespace cg = cooperative_groups;

typedef unsigned short u16;
using bf16x8 = __attribute__((ext_vector_type(8))) short;
using bf16x4 = __attribute__((ext_vector_type(4))) short;
using f32x4 = __attribute__((ext_vector_type(4))) float;
using u32x4 = __attribute__((ext_vector_type(4))) unsigned;

#ifndef MULTI_LAUNCH
#define MULTI_LAUNCH 0
#endif

constexpr int T_TOK = 32768, DM = 1024, SEQ = 8192, NB = 4, DFF = 2816, MEML = 256;
constexpr float EPS = 1e-6f;
constexpr int LDS_BYTES = 147456;
constexpr float LOG2E = 1.4426950408889634f;

typedef __attribute__((ext_vector_type(2))) float f32x2;
typedef __attribute__((ext_vector_type(2))) __bf16 bf16x2_t;
__device__ __forceinline__ unsigned pk2(float a, float b) { f32x2 v = {a, b}; bf16x2_t r = __builtin_convertvector(v, bf16x2_t); return *(unsigned*)&r; }
__device__ __forceinline__ u16 f2bf(float f) { return (u16)(pk2(f, 0.f) & 0xffffu); }
__device__ __forceinline__ float bf2f(u16 h) { return __uint_as_float(((unsigned)h) << 16); }
__device__ __forceinline__ float sigmoid_f(float x) { return __builtin_amdgcn_rcpf(1.f + __builtin_amdgcn_exp2f(-x * LOG2E)); }
__device__ __forceinline__ float silu_f(float x) { return x * sigmoid_f(x); }

__device__ __forceinline__ int opaque_tid(int wv) { unsigned ones = ~0u; asm volatile("" : "+s"(ones)); int lane = __builtin_amdgcn_mbcnt_hi(ones, __builtin_amdgcn_mbcnt_lo(ones, 0u)); int t = (wv << 6) | lane; asm volatile("" : "+v"(t)); return t; }

template <int M> __device__ __forceinline__ float sx(float v, int lane) {
  if (M < 32) return __int_as_float(__builtin_amdgcn_ds_swizzle(__float_as_int(v), (M << 10) | 0x1f));
  else return __int_as_float(__builtin_amdgcn_ds_bpermute((lane ^ M) << 2, __float_as_int(v)));
}
__device__ __forceinline__ float wave_sum(float v, int lane) {
  v += sx<1>(v, lane); v += sx<2>(v, lane); v += sx<4>(v, lane); v += sx<8>(v, lane); v += sx<16>(v, lane); v += sx<32>(v, lane); return v;
}

struct WDesc { const float* src; u16* dst; const float* gain; int K; int N; int perm; int tile0; };

struct KArgs {
  const float *x, *mem, *rel_bias, *norm_mem, *norm_final;
  const float *da_lq1, *da_lk1, *da_lq2, *da_lk2, *da_subln;
  const float *hg_lb, *hg_onorm;
  const float *sg_vnorm, *sg_w_s, *sg_b_s;
  float* out; char* ws;
  WDesc wd[28];
  int nwd; int total_wtiles;
  int phase_lo, phase_hi;
};

constexpr size_t MIB = 1u << 20;
constexpr size_t OFF_XB = 0, OFF_RPART = OFF_XB + 64 * MIB, OFF_VPART = OFF_RPART + 2 * MIB, OFF_MEMN = OFF_VPART + 2 * MIB,
                 OFF_MEMK = OFF_MEMN + 2 * MIB, OFF_MEMVT = OFF_MEMK + 8 * MIB, OFF_LBV = OFF_MEMVT + 8 * MIB, OFF_BIAS = OFF_LBV + 4096,
                 OFF_B0 = OFF_BIAS + 4096, OFF_B1 = OFF_B0 + 64 * MIB, OFF_B2 = OFF_B1 + 64 * MIB, OFF_B3 = OFF_B2 + 64 * MIB,
                 OFF_B4 = OFF_B3 + 64 * MIB, OFF_DBUF = OFF_B4 + 32 * MIB, OFF_W = OFF_DBUF + 2 * MIB, OFF_BAR = OFF_W + 130 * MIB, WS_END = OFF_BAR + 16384;
__host__ __device__ __forceinline__ long layer_woff(int i) { return i == 0 ? 0L : (i == 1 ? 17039360L : (i == 2 ? 35127296L : 51118080L)); }
__host__ __device__ __forceinline__ long mixin_elems(int i) { int kind = i % 3; return kind == 0 ? 3145728L : (kind == 1 ? 4194304L : 2097152L); }

struct Params {
  const float *x, *mem, *rel_bias, *norm_mem, *norm_final;
  const float *da_lq1, *da_lk1, *da_lq2, *da_lk2, *da_subln;
  const float *hg_lb, *hg_onorm;
  const float *sg_vnorm, *sg_w_s, *sg_b_s;
  float* out;
  u16* xb; float* rpart; float* vpart; u16* memn; u16* memK; u16* memVT; float* lbv; float* biastab;
  u16 *B0, *B1, *B2, *B3, *B4; float* dbuf; u16* wbase;
};
typedef const KArgs __attribute__((address_space(4)))* KArgsP;
__device__ __forceinline__ KArgsP kargs_ptr() {
  KArgsP kp = (KArgsP)__builtin_amdgcn_kernarg_segment_ptr();
  asm volatile("" : "+s"(kp));
  return kp;
}
template <class KA>
__device__ __forceinline__ Params make_params(const KA& k) {
  Params p;
  p.x = k.x; p.mem = k.mem; p.rel_bias = k.rel_bias; p.norm_mem = k.norm_mem; p.norm_final = k.norm_final;
  p.da_lq1 = k.da_lq1; p.da_lk1 = k.da_lk1; p.da_lq2 = k.da_lq2; p.da_lk2 = k.da_lk2; p.da_subln = k.da_subln;
  p.hg_lb = k.hg_lb; p.hg_onorm = k.hg_onorm; p.sg_vnorm = k.sg_vnorm; p.sg_w_s = k.sg_w_s; p.sg_b_s = k.sg_b_s; p.out = k.out;
  char* ws = k.ws;
  p.xb = (u16*)(ws + OFF_XB); p.rpart = (float*)(ws + OFF_RPART); p.vpart = (float*)(ws + OFF_VPART); p.memn = (u16*)(ws + OFF_MEMN);
  p.memK = (u16*)(ws + OFF_MEMK); p.memVT = (u16*)(ws + OFF_MEMVT); p.lbv = (float*)(ws + OFF_LBV); p.biastab = (float*)(ws + OFF_BIAS);
  p.B0 = (u16*)(ws + OFF_B0); p.B1 = (u16*)(ws + OFF_B1); p.B2 = (u16*)(ws + OFF_B2); p.B3 = (u16*)(ws + OFF_B3); p.B4 = (u16*)(ws + OFF_B4);
  p.dbuf = (float*)(ws + OFF_DBUF); p.wbase = (u16*)(ws + OFF_W);
  return p;
}


constexpr int BM = 256, BK = 64, HALF = 128, HT = HALF * BK;

__device__ __forceinline__ int lds_byte(int r, int c) {
  int st = (r >> 4) * 2 + (c >> 5), rr = r & 15, cc = c & 31, ob = rr * 64 + cc * 2;
  return st * 1024 + (ob ^ (((ob >> 9) & 1) << 5));
}
__device__ __forceinline__ void stage_rc(int b, int& R, int& C) {
  int st = b / 1024, sb = b % 1024, swz = sb ^ (((sb >> 9) & 1) << 5);
  R = (st >> 1) * 16 + swz / 64; C = (st & 1) * 32 + (swz % 64) / 2;
}

template <class Epi>
__device__ __forceinline__ void gemm_tile(const u16* __restrict__ A, const u16* __restrict__ Bt, int K, int brow, int bcol,
                                          char* shmc, Epi& epi, int tr0, int fc0, bool sw, bool pre, bool has_next,
                                          const u16* __restrict__ nA, const u16* __restrict__ nBt, int nbrow, int nbcol, int wv) {
  u16* shm = (u16*)shmc;
  const int tx = opaque_tid(wv);
#define SA(b, h) (shm + ((b) * 2 + (h)) * HT)
#define SB(b, h) (shm + (4 + (b) * 2 + (h)) * HT)
#define STAGE(P, BASE, br, kt) do { int _so = ((br) * K + (kt) * BK) * 2; \
    __builtin_amdgcn_raw_ptr_buffer_load_lds(rs_##BASE, (__attribute__((address_space(3))) void*)((char*)(P) + tx * 16), 16, voff0, _so, 0, 0); \
    __builtin_amdgcn_raw_ptr_buffer_load_lds(rs_##BASE, (__attribute__((address_space(3))) void*)((char*)(P) + tx * 16 + 8192), 16, voff1, _so, 0, 0); } while (0)
#define LDA(dst, b, h) _Pragma("unroll") for (int m = 0; m < 4; ++m) _Pragma("unroll") for (int k = 0; k < 2; ++k) \
    dst[m][k] = *reinterpret_cast<const bf16x8*>((char*)SA(b, h) + lds_byte(wr * 64 + m * 16 + fr, k * 32 + fq * 8))
#define LDB(dst, b, h) _Pragma("unroll") for (int n = 0; n < 2; ++n) _Pragma("unroll") for (int k = 0; k < 2; ++k) \
    dst[n][k] = *reinterpret_cast<const bf16x8*>((char*)SB(b, h) + lds_byte(wc * 32 + n * 16 + fr, k * 32 + fq * 8))
#define MMA(ai, bj, At, Bt_) do { __builtin_amdgcn_s_setprio(1); \
    _Pragma("unroll") for (int m = 0; m < 4; ++m) _Pragma("unroll") for (int n = 0; n < 2; ++n) _Pragma("unroll") for (int k = 0; k < 2; ++k) \
      acc[ai][bj][m][n] = __builtin_amdgcn_mfma_f32_16x16x32_bf16(At[m][k], Bt_[n][k], acc[ai][bj][m][n], 0, 0, 0); \
    __builtin_amdgcn_s_setprio(0); } while (0)
#define WAIT_V(n) asm volatile("s_waitcnt vmcnt(" #n ")" ::: "memory")
#define WAIT_L(n) asm volatile("s_waitcnt lgkmcnt(" #n ")" ::: "memory")
#define BAR __builtin_amdgcn_s_barrier()
#define SCHED __builtin_amdgcn_sched_barrier(0)

  int wid = tx >> 6, lane = tx & 63, wr = wid >> 2, wc = wid & 3, fr = lane & 15, fq = lane >> 4;
  f32x4 acc[2][2][4][2] = {};
  bf16x8 At[4][2], B0[2][2], B1[2][2];
  int nt = K / BK;
  int voff0, voff1;
  { int _r, _c; stage_rc(tx * 16, _r, _c); voff0 = (_r * K + _c) * 2; stage_rc(tx * 16 + 8192, _r, _c); voff1 = (_r * K + _c) * 2; }
  __amdgpu_buffer_rsrc_t rs_A = __builtin_amdgcn_make_buffer_rsrc((void*)A, 0, 0x7fffffff, 0x00020000);
  __amdgpu_buffer_rsrc_t rs_Bt = __builtin_amdgcn_make_buffer_rsrc((void*)Bt, 0, 0x7fffffff, 0x00020000);
  if (!pre) {
    STAGE(SB(0, 0), Bt, bcol, 0); STAGE(SA(0, 0), A, brow, 0);
    STAGE(SB(0, 1), Bt, bcol + HALF, 0); STAGE(SA(0, 1), A, brow + HALF, 0);
  }
  if (wr == 1) BAR;
  if (pre) { WAIT_V(0); } else { WAIT_V(4); }
  BAR;
  STAGE(SB(1, 0), Bt, bcol, 1); STAGE(SA(1, 0), A, brow, 1); STAGE(SB(1, 1), Bt, bcol + HALF, 1);
  WAIT_V(6); BAR;
  for (int t = 0; t < nt - 2; t += 2) {
    LDB(B0, 0, 0); SCHED; LDA(At, 0, 0); STAGE(SA(1, 1), A, brow + HALF, t + 1);
    WAIT_L(8); BAR; WAIT_L(0); MMA(0, 0, At, B0); BAR; SCHED;
    LDB(B1, 0, 1); STAGE(SB(0, 0), Bt, bcol, t + 2);
    BAR; WAIT_L(0); MMA(0, 1, At, B1); BAR;
    LDA(At, 0, 1); STAGE(SA(0, 0), A, brow, t + 2);
    BAR; WAIT_L(0); MMA(1, 0, At, B0); BAR; SCHED;
    STAGE(SB(0, 1), Bt, bcol + HALF, t + 2);
    WAIT_V(6); BAR; MMA(1, 1, At, B1); BAR;
    LDB(B0, 1, 0); SCHED; LDA(At, 1, 0); STAGE(SA(0, 1), A, brow + HALF, t + 2);
    WAIT_L(8); BAR; WAIT_L(0); MMA(0, 0, At, B0); BAR; SCHED;
    LDB(B1, 1, 1); STAGE(SB(1, 0), Bt, bcol, t + 3);
    BAR; WAIT_L(0); MMA(0, 1, At, B1); BAR;
    LDA(At, 1, 1); STAGE(SA(1, 0), A, brow, t + 3);
    BAR; WAIT_L(0); MMA(1, 0, At, B0); BAR; SCHED;
    STAGE(SB(1, 1), Bt, bcol + HALF, t + 3);
    WAIT_V(6); BAR; MMA(1, 1, At, B1); BAR;
  }
  { LDB(B0, 0, 0); LDA(At, 0, 0); STAGE(SA(1, 1), A, brow + HALF, nt - 1);
    BAR; WAIT_L(0); MMA(0, 0, At, B0); BAR;
    LDB(B1, 0, 1); BAR; WAIT_L(0); MMA(0, 1, At, B1); BAR;
    LDA(At, 0, 1); WAIT_V(4); BAR; WAIT_L(0); MMA(1, 0, At, B0); MMA(1, 1, At, B1); BAR; }
  { LDB(B0, 1, 0); LDA(At, 1, 0); WAIT_V(2); BAR; WAIT_L(0); MMA(0, 0, At, B0); BAR;
    LDB(B1, 1, 1); WAIT_V(0); BAR; WAIT_L(0); MMA(0, 1, At, B1); BAR;
    LDA(At, 1, 1); BAR; WAIT_L(0); MMA(1, 0, At, B0); MMA(1, 1, At, B1); BAR; }
  if (wr == 0) BAR;
  if (has_next) {
    __amdgpu_buffer_rsrc_t rs_nA = __builtin_amdgcn_make_buffer_rsrc((void*)nA, 0, 0x7fffffff, 0x00020000);
    __amdgpu_buffer_rsrc_t rs_nBt = __builtin_amdgcn_make_buffer_rsrc((void*)nBt, 0, 0x7fffffff, 0x00020000);
    STAGE(SB(0, 0), nBt, nbcol, 0); STAGE(SA(0, 0), nA, nbrow, 0);
    STAGE(SB(0, 1), nBt, nbcol + HALF, 0); STAGE(SA(0, 1), nA, nbrow + HALF, 0);
  }
  {
    const int tx2 = opaque_tid(wv); const int wid2 = tx2 >> 6, lane2 = tx2 & 63;
    epi(acc, tr0, fc0, sw, wid2 >> 2, wid2 & 3, lane2 & 15, lane2 >> 4);
  }
  __syncthreads();
#undef SA
#undef SB
#undef STAGE
#undef LDA
#undef LDB
#undef MMA
}

template <class Epi>
__device__ __forceinline__ void gemm_phase(const u16* A, const u16* Bt, int M, int N, int K, char* shm, Epi& epi, int wv) {
  int nM = M / BM, nN = N / BM;
  int G = gridDim.x, bid = blockIdx.x;
  bool xmap = ((G & 7) == 0 && (nM & 63) == 0);
  int xcd = bid & 7, slot = bid >> 3, nslots = G >> 3, gpx = nM / 64;
  int first = xmap ? slot : bid, step = xmap ? nslots : G, total = xmap ? gpx * 8 * nN : nM * nN;
  auto coords = [&](int L, int& tr0, int& fc0) {
    if (xmap) { int grp = xcd * gpx + L / (8 * nN), within = L % (8 * nN); tr0 = (grp * 8 + (within & 7)) * BM; fc0 = (within >> 3) * BM; }
    else { tr0 = (L % nM) * BM; fc0 = (L / nM) * BM; }
  };
  bool pre = false;
  for (int L = first; L < total; L += step) {
    int tr0, fc0, ntr0 = 0, nfc0 = 0;
    coords(L, tr0, fc0);
    bool hn = (L + step) < total;
    if (hn) coords(L + step, ntr0, nfc0);
    bool sw = epi.swap(fc0), nsw = epi.swap(nfc0);
    gemm_tile(sw ? Bt : A, sw ? A : Bt, K, sw ? fc0 : tr0, sw ? tr0 : fc0, shm, epi, tr0, fc0, sw, pre, hn,
              nsw ? Bt : A, nsw ? A : Bt, nsw ? nfc0 : ntr0, nsw ? ntr0 : nfc0, wv);
    pre = hn;
  }
}

__device__ __forceinline__ float row_rs(const float* part, int row) {
  const float4* q = (const float4*)(part + (long)row * 16);
  float4 a = q[0], b = q[1], c = q[2], d = q[3];
  float s = ((a.x + a.y) + (a.z + a.w)) + ((b.x + b.y) + (b.z + b.w)) + ((c.x + c.y) + (c.z + c.w)) + ((d.x + d.y) + (d.z + d.w));
  return rsqrtf(s * (1.f / DM) + EPS);
}
#define EPI_ARGS f32x4 (&acc)[2][2][4][2], int tr0, int fc0, bool sw, int wr, int wc, int fr, int fq
#define S_FEAT(ai, m) (fc0 + (ai) * 128 + wr * 64 + (m) * 16 + fq * 4)
#define S_TOK(bj, n) (tr0 + (bj) * 128 + wc * 32 + (n) * 16 + fr)
#define U_TOK(ai, m) (tr0 + (ai) * 128 + wr * 64 + (m) * 16 + fq * 4)
#define U_FEAT(bj, n) (fc0 + (bj) * 128 + wc * 32 + (n) * 16 + fr)

__device__ __forceinline__ uint2 pack4(float a, float b, float c, float d) { uint2 r; r.x = pk2(a, b); r.y = pk2(c, d); return r; }

struct EpiRes {
  u16* xb; float* part;
  __device__ __forceinline__ bool swap(int) const { return true; }
  __device__ __forceinline__ void operator()(EPI_ARGS) {
    _Pragma("unroll") for (int bj = 0; bj < 2; ++bj) _Pragma("unroll") for (int n = 0; n < 2; ++n) {
      int t = S_TOK(bj, n); float ss = 0.f;
      u16* xbp = xb + (long)t * DM;
      _Pragma("unroll") for (int ai = 0; ai < 2; ++ai) _Pragma("unroll") for (int m = 0; m < 4; ++m) {
        int f = S_FEAT(ai, m); f32x4 a = acc[ai][bj][m][n];
        uint2 xv = *(const uint2*)(xbp + f);
        float v0 = __uint_as_float(xv.x << 16) + a[0], v1 = __uint_as_float(xv.x & 0xffff0000u) + a[1];
        float v2 = __uint_as_float(xv.y << 16) + a[2], v3 = __uint_as_float(xv.y & 0xffff0000u) + a[3];
        *(uint2*)(xbp + f) = pack4(v0, v1, v2, v3);
        ss += v0 * v0 + v1 * v1 + v2 * v2 + v3 * v3;
      }
      ss += sx<16>(ss, fq * 16 + fr); ss += sx<32>(ss, fq * 16 + fr);
      if (fq == 0) part[(long)t * 16 + (fc0 >> 8) * 4 + wr] = ss;
      __builtin_amdgcn_sched_barrier(0);
    }
  }
};

struct EpiDaIn {
  const float* rowss; u16 *q, *k, *vT;
  __device__ __forceinline__ bool swap(int fc0) const { return (fc0 >> 10) < 2; }
  __device__ __forceinline__ void operator()(EPI_ARGS) {
    int sect = fc0 >> 10, cb = fc0 & 1023;
    if (sw) {
      u16* dst = sect ? k : q;
      _Pragma("unroll") for (int bj = 0; bj < 2; ++bj) _Pragma("unroll") for (int n = 0; n < 2; ++n) {
        int t = S_TOK(bj, n); float rs = row_rs(rowss, t); u16* d = dst + (long)t * DM + (cb - fc0);
        _Pragma("unroll") for (int ai = 0; ai < 2; ++ai) _Pragma("unroll") for (int m = 0; m < 4; ++m) {
          f32x4 a = acc[ai][bj][m][n]; *(uint2*)(d + S_FEAT(ai, m)) = pack4(a[0] * rs, a[1] * rs, a[2] * rs, a[3] * rs);
        }
      }
    } else {
      _Pragma("unroll") for (int ai = 0; ai < 2; ++ai) _Pragma("unroll") for (int m = 0; m < 4; ++m) {
        int r0 = U_TOK(ai, m); float rs[4];
        _Pragma("unroll") for (int j = 0; j < 4; ++j) rs[j] = row_rs(rowss, r0 + j);
        int b = r0 / SEQ, s0 = r0 % SEQ;
        _Pragma("unroll") for (int bj = 0; bj < 2; ++bj) _Pragma("unroll") for (int n = 0; n < 2; ++n) {
          int c = U_FEAT(bj, n) - fc0 + cb; f32x4 a = acc[ai][bj][m][n];
          *(uint2*)&vT[((long)(b * DM + c)) * SEQ + s0] = pack4(a[0] * rs[0], a[1] * rs[1], a[2] * rs[2], a[3] * rs[3]);
        }
        __builtin_amdgcn_sched_barrier(0);
      }
    }
  }
};

struct EpiHgIn {
  const float* rowss; const float* lbv; u16 *q, *logf_, *iT, *g;
  __device__ __forceinline__ bool swap(int fc0) const { return (fc0 >> 10) != 2; }
  __device__ __forceinline__ void operator()(EPI_ARGS) {
    int sect = fc0 >> 10, cb = fc0 & 1023;
    if (sw) {
      u16* dst = q + (long)sect * (32L << 20);
      _Pragma("unroll") for (int bj = 0; bj < 2; ++bj) _Pragma("unroll") for (int n = 0; n < 2; ++n) {
        int t = S_TOK(bj, n); float rs = row_rs(rowss, t); u16* d = dst + (long)t * DM + (cb - fc0);
        _Pragma("unroll") for (int ai = 0; ai < 2; ++ai) _Pragma("unroll") for (int m = 0; m < 4; ++m) {
          int f = S_FEAT(ai, m); f32x4 a = acc[ai][bj][m][n]; float v[4];
          if (sect == 0) { _Pragma("unroll") for (int j = 0; j < 4; ++j) v[j] = silu_f(a[j] * rs); }
          else if (sect == 1) {
            float4 lb = *(const float4*)&lbv[f - fc0 + cb]; float lbs[4] = {lb.x, lb.y, lb.z, lb.w};
            _Pragma("unroll") for (int j = 0; j < 4; ++j) v[j] = __logf(lbs[j] + (1.f - lbs[j]) * sigmoid_f(a[j] * rs));
          } else { _Pragma("unroll") for (int j = 0; j < 4; ++j) v[j] = a[j] * rs; }
          *(uint2*)(d + f) = pack4(v[0], v[1], v[2], v[3]);
        }
      }
    } else {
      _Pragma("unroll") for (int ai = 0; ai < 2; ++ai) _Pragma("unroll") for (int m = 0; m < 4; ++m) {
        int r0 = U_TOK(ai, m); float rs[4];
        _Pragma("unroll") for (int j = 0; j < 4; ++j) rs[j] = row_rs(rowss, r0 + j);
        _Pragma("unroll") for (int bj = 0; bj < 2; ++bj) _Pragma("unroll") for (int n = 0; n < 2; ++n) {
          int c = U_FEAT(bj, n) - fc0 + cb; f32x4 a = acc[ai][bj][m][n];
          *(uint2*)&iT[((long)(r0 >> 6) * DM + c) * 64 + (r0 & 63)] = pack4(a[0] * rs[0], a[1] * rs[1], a[2] * rs[2], a[3] * rs[3]);
        }
        __builtin_amdgcn_sched_barrier(0);
      }
    }
  }
};

__device__ __forceinline__ float gelu_f(float x) { return 0.5f * x * (1.f + erff(x * 0.70710678118654752f)); }

struct EpiSgIn {
  const float* rowss; u16 *u, *vT; float* rowss_v;
  __device__ __forceinline__ bool swap(int fc0) const { return (fc0 >> 10) == 0; }
  __device__ __forceinline__ void operator()(EPI_ARGS) {
    int cb = fc0 & 1023;
    if (sw) {
      _Pragma("unroll") for (int bj = 0; bj < 2; ++bj) _Pragma("unroll") for (int n = 0; n < 2; ++n) {
        int t = S_TOK(bj, n); float rs = row_rs(rowss, t); u16* d = u + (long)t * DM;
        _Pragma("unroll") for (int ai = 0; ai < 2; ++ai) _Pragma("unroll") for (int m = 0; m < 4; ++m) {
          f32x4 a = acc[ai][bj][m][n];
          *(uint2*)(d + S_FEAT(ai, m)) = pack4(gelu_f(a[0] * rs), gelu_f(a[1] * rs), gelu_f(a[2] * rs), gelu_f(a[3] * rs));
        }
      }
    } else {
      _Pragma("unroll") for (int ai = 0; ai < 2; ++ai) _Pragma("unroll") for (int m = 0; m < 4; ++m) {
        int r0 = U_TOK(ai, m); float rs[4], ss[4] = {0.f, 0.f, 0.f, 0.f};
        _Pragma("unroll") for (int j = 0; j < 4; ++j) rs[j] = row_rs(rowss, r0 + j);
        _Pragma("unroll") for (int bj = 0; bj < 2; ++bj) _Pragma("unroll") for (int n = 0; n < 2; ++n) {
          int c = U_FEAT(bj, n) - fc0 + cb; f32x4 a = acc[ai][bj][m][n];
          float gv[4]; _Pragma("unroll") for (int j = 0; j < 4; ++j) gv[j] = gelu_f(a[j] * rs[j]);
          *(uint2*)&vT[((long)(r0 >> 7) * DM + c) * 128 + (r0 & 127)] = pack4(gv[0], gv[1], gv[2], gv[3]);
          _Pragma("unroll") for (int j = 0; j < 4; ++j) ss[j] += gv[j] * gv[j];
        }
        _Pragma("unroll") for (int j = 0; j < 4; ++j) {
          float s = ss[j]; s += sx<1>(s, 0); s += sx<2>(s, 0); s += sx<4>(s, 0); s += sx<8>(s, 0);
          if (fr == 0) rowss_v[(long)(r0 + j) * 16 + (cb >> 8) * 4 + wc] = s;
        }
        __builtin_amdgcn_sched_barrier(0);
      }
    }
  }
};

struct EpiStore {
  const float* rowss; u16* dst; int ld;
  __device__ __forceinline__ bool swap(int) const { return true; }
  __device__ __forceinline__ void operator()(EPI_ARGS) {
    _Pragma("unroll") for (int bj = 0; bj < 2; ++bj) _Pragma("unroll") for (int n = 0; n < 2; ++n) {
      int t = S_TOK(bj, n); float rs = rowss ? row_rs(rowss, t) : 1.f; u16* d = dst + (long)t * ld;
      _Pragma("unroll") for (int ai = 0; ai < 2; ++ai) _Pragma("unroll") for (int m = 0; m < 4; ++m) {
        f32x4 a = acc[ai][bj][m][n]; *(uint2*)(d + S_FEAT(ai, m)) = pack4(a[0] * rs, a[1] * rs, a[2] * rs, a[3] * rs);
      }
    }
  }
};

struct EpiFfn {
  const float* rowss; u16* act;
  __device__ __forceinline__ bool swap(int) const { return true; }
  __device__ __forceinline__ void operator()(EPI_ARGS) {
    int tile = fc0 >> 8;
    _Pragma("unroll") for (int bj = 0; bj < 2; ++bj) _Pragma("unroll") for (int n = 0; n < 2; ++n) {
      int t = S_TOK(bj, n); float rs = row_rs(rowss, t); u16* d = act + (long)t * DFF + tile * 128 + wr * 64 + fq * 4;
      _Pragma("unroll") for (int m = 0; m < 4; ++m) {
        f32x4 g = acc[0][bj][m][n], u = acc[1][bj][m][n]; float v[4];
        _Pragma("unroll") for (int j = 0; j < 4; ++j) v[j] = silu_f(g[j] * rs) * (u[j] * rs);
        *(uint2*)(d + m * 16) = pack4(v[0], v[1], v[2], v[3]);
      }
    }
  }
};

struct EpiMemKV {
  u16 *K, *VT;
  __device__ __forceinline__ bool swap(int fc0) const { return (fc0 >> 10) == 0; }
  __device__ __forceinline__ void operator()(EPI_ARGS) {
    int cb = fc0 & 1023;
    if (sw) {
      _Pragma("unroll") for (int bj = 0; bj < 2; ++bj) _Pragma("unroll") for (int n = 0; n < 2; ++n) {
        int t = S_TOK(bj, n); u16* d = K + (long)t * DM;
        _Pragma("unroll") for (int ai = 0; ai < 2; ++ai) _Pragma("unroll") for (int m = 0; m < 4; ++m) {
          f32x4 a = acc[ai][bj][m][n]; *(uint2*)(d + S_FEAT(ai, m)) = pack4(a[0], a[1], a[2], a[3]);
        }
      }
    } else {
      _Pragma("unroll") for (int ai = 0; ai < 2; ++ai) _Pragma("unroll") for (int m = 0; m < 4; ++m) {
        int r0 = U_TOK(ai, m);
        _Pragma("unroll") for (int bj = 0; bj < 2; ++bj) _Pragma("unroll") for (int n = 0; n < 2; ++n) {
          int c = U_FEAT(bj, n) - fc0 + cb; f32x4 a = acc[ai][bj][m][n];
          *(uint2*)&VT[((long)((r0 >> 8) * DM + c)) * MEML + (r0 & 255)] = pack4(a[0], a[1], a[2], a[3]);
        }
      }
    }
  }
};

__device__ __forceinline__ void prep_phase(const Params& p, KArgsP kap, char* shm, int wv) {
  int tid = opaque_tid(wv), bid = blockIdx.x, G = gridDim.x;
  int lane = tid & 63, wid = tid >> 6;
  for (int row = bid * 8 + wid; row < T_TOK; row += G * 8) {
    const float4* src = (const float4*)(p.x + (long)row * DM);
    float ss = 0.f;
    _Pragma("unroll") for (int i = 0; i < 4; ++i) {
      float4 v = src[i * 64 + lane];
      ss += v.x * v.x + v.y * v.y + v.z * v.z + v.w * v.w;
      *(uint2*)&p.xb[(long)row * DM + (i * 64 + lane) * 4] = pack4(v.x, v.y, v.z, v.w);
    }
    ss = wave_sum(ss, lane);
    if (lane < 16) p.rpart[(long)row * 16 + lane] = (lane == 0) ? ss : 0.f;
  }
  for (int row = bid * 8 + wid; row < NB * MEML; row += G * 8) {
    const float4* src = (const float4*)(p.mem + (long)row * DM);
    float4 v[4]; float ss = 0.f;
    _Pragma("unroll") for (int i = 0; i < 4; ++i) { v[i] = src[i * 64 + lane]; ss += v[i].x * v[i].x + v[i].y * v[i].y + v[i].z * v[i].z + v[i].w * v[i].w; }
    ss = wave_sum(ss, lane);
    float rs = rsqrtf(ss * (1.f / DM) + EPS);
    _Pragma("unroll") for (int i = 0; i < 4; ++i) {
      float4 g = ((const float4*)p.norm_mem)[i * 64 + lane];
      *(uint2*)&p.memn[(long)row * DM + (i * 64 + lane) * 4] = pack4(v[i].x * rs * g.x, v[i].y * rs * g.y, v[i].z * rs * g.z, v[i].w * rs * g.w);
    }
  }
  if (bid == 0) {
    for (int i = tid; i < 3456; i += 512) ((unsigned*)((char*)p.xb - OFF_XB + OFF_BAR))[i] = 0u;
    for (int c = tid; c < DM; c += 512) {
      float v0 = p.hg_lb[c], v1 = p.hg_lb[DM + c], v2 = p.hg_lb[2 * DM + c], v3 = p.hg_lb[3 * DM + c];
      float mx = fmaxf(fmaxf(v0, v1), fmaxf(v2, v3));
      float e0 = expf(v0 - mx), e1 = expf(v1 - mx), e2 = expf(v2 - mx), e3 = expf(v3 - mx);
      p.lbv[c] = e1 / (e0 + e1 + e2 + e3);
    }
    for (int i = tid; i < 8 * 128; i += 512) {
      int h = i >> 7, n = i & 127, bucket;
      if (n < 16) bucket = n;
      else { float nf = (float)n; int lg = 16 + (int)(logf(nf / 16.f) / 2.0794415416798357f * 16.f); bucket = lg < 31 ? lg : 31; }
      p.biastab[i] = p.rel_bias[h * 32 + bucket] * LOG2E;
    }
  }
  float* tl = (float*)shm;
  for (int t = bid; t < kap->total_wtiles; t += G) {
    int wi = 0;
    while (wi + 1 < kap->nwd && kap->wd[wi + 1].tile0 <= t) ++wi;
    const float* src = kap->wd[wi].src; u16* dst = kap->wd[wi].dst; const float* gain = kap->wd[wi].gain;
    int K = kap->wd[wi].K, N = kap->wd[wi].N, perm = kap->wd[wi].perm;
    int lt = t - kap->wd[wi].tile0, nNt = N >> 6;
    int k0 = (lt / nNt) * 64, n0 = (lt % nNt) * 64;
    {
      int kk = tid >> 3, seg = (tid & 7) * 8;
      const float4* s4 = (const float4*)(src + (long)(k0 + kk) * N + n0 + seg);
      float4 a = s4[0], b = s4[1]; float g = gain ? gain[k0 + kk] : 1.f;
      float* d = tl + kk * 65 + seg;
      d[0] = a.x * g; d[1] = a.y * g; d[2] = a.z * g; d[3] = a.w * g; d[4] = b.x * g; d[5] = b.y * g; d[6] = b.z * g; d[7] = b.w * g;
    }
    __syncthreads();
    {
      int nn = tid >> 3, seg = (tid & 7) * 8;
      int n = n0 + nn, drow = n;
      if (perm) { int part = n / DFF, idx = n % DFF; drow = (idx >> 7) * 256 + part * 128 + (idx & 127); }
      float v[8]; _Pragma("unroll") for (int i = 0; i < 8; ++i) v[i] = tl[(seg + i) * 65 + nn];
      uint4 o; uint2 lo = pack4(v[0], v[1], v[2], v[3]), hi = pack4(v[4], v[5], v[6], v[7]);
      o.x = lo.x; o.y = lo.y; o.z = hi.x; o.w = hi.y;
      *(uint4*)&dst[(long)drow * K + k0 + seg] = o;
    }
    __syncthreads();
  }
}

template <int NC, int DQK, int DV, bool CAUSAL, bool PF>
__device__ __forceinline__ void flash_item(const u16* __restrict__ Qg, int q_stride, const u16* __restrict__ Kg, int k_stride,
                                           const u16* __restrict__ VTg, int vt_stride, int nkt, int q0, float scale_log2,
                                           const float* btab, float lam, const float* subln_g, float outscale,
                                           u16* __restrict__ Og, int o_stride, char* shm, int wv) {
  constexpr int KW = NC * DQK, KLD = KW + 8, VLD = 72;
  constexpr int KBUF = 64 * KLD, VBUF = DV * VLD;
  constexpr int KCH = KW / 8, KPT = 64 * KCH / 512, VPT = DV * 8 / 512;
  constexpr int NKS = DQK / 32, NVT = DV / 16;
  u16* Ks = (u16*)shm; u16* Vs = Ks + 2 * KBUF;
  int tid = opaque_tid(wv), wid = tid >> 6, lane = tid & 63, fr = lane & 15, fq = lane >> 4;
  int qw0 = q0 + wid * 16, qpos = qw0 + fr;

  bf16x8 qf[NC][NKS];
  _Pragma("unroll") for (int c = 0; c < NC; ++c) _Pragma("unroll") for (int ks = 0; ks < NKS; ++ks)
    qf[c][ks] = *(const bf16x8*)&Qg[(long)(wid * 16 + fr) * q_stride + c * DQK + ks * 32 + fq * 8];
  f32x4 O[NC][NVT];
  _Pragma("unroll") for (int c = 0; c < NC; ++c) _Pragma("unroll") for (int v = 0; v < NVT; ++v) O[c][v] = f32x4{0.f, 0.f, 0.f, 0.f};
  float mrun[NC], lsum[NC];
  _Pragma("unroll") for (int c = 0; c < NC; ++c) { mrun[c] = -1e30f; lsum[c] = 0.f; }

  u32x4 kreg[KPT], vreg[VPT];
#define FA_PREFETCH(kt_) do { int k0_ = (kt_) * 64; \
    _Pragma("unroll") for (int i = 0; i < KPT; ++i) { int id = tid + i * 512, row = id / KCH, cc = id % KCH; kreg[i] = *(const u32x4*)&Kg[(long)(k0_ + row) * k_stride + cc * 8]; } \
    _Pragma("unroll") for (int i = 0; i < VPT; ++i) { int id = tid + i * 512, row = id >> 3, cc = id & 7; vreg[i] = *(const u32x4*)&VTg[(long)row * vt_stride + k0_ + cc * 8]; } } while (0)
  if (PF) FA_PREFETCH(0);
  for (int kt = 0; kt < nkt; ++kt) {
    if (!PF) FA_PREFETCH(kt);
    u16* Kb = Ks + (kt & 1) * KBUF; u16* Vb = Vs + (kt & 1) * VBUF;
    _Pragma("unroll") for (int i = 0; i < KPT; ++i) { int id = tid + i * 512, row = id / KCH, cc = id % KCH; *(u32x4*)&Kb[row * KLD + cc * 8] = kreg[i]; }
    _Pragma("unroll") for (int i = 0; i < VPT; ++i) {
      int id = tid + i * 512, row = id >> 3, cc = id & 7;
      int pos = 32 * (cc >> 2) + 16 * (cc & 1) + 4 * ((cc >> 1) & 1);
      uint2 lo2, hi2; lo2.x = vreg[i][0]; lo2.y = vreg[i][1]; hi2.x = vreg[i][2]; hi2.y = vreg[i][3];
      *(uint2*)&Vb[row * VLD + pos] = lo2; *(uint2*)&Vb[row * VLD + pos + 8] = hi2;
    }
    __syncthreads();
    if (PF && kt + 1 < nkt) FA_PREFETCH(kt + 1);
    int k0 = kt * 64;
    if (CAUSAL && k0 > qw0 + 15) continue;
    bf16x8 pf[NC][2];
    bool general = false; float bb = 0.f;
    if (CAUSAL) { general = (qw0 - (k0 + 63)) < 113; bb = btab[127]; }
    f32x4 bv[4];
    if (general) {
      bool diag = (k0 + 63) > qw0;
      _Pragma("unroll") for (int m = 0; m < 4; ++m) _Pragma("unroll") for (int j = 0; j < 4; ++j) {
        int dist = qpos - (k0 + 16 * m + fq * 4 + j);
        int di = dist < 0 ? 0 : (dist > 127 ? 127 : dist);
        float b = btab[di];
        bv[m][j] = (diag && dist < 0) ? -1e30f : b;
      }
    }
    _Pragma("unroll") for (int c = 0; c < NC; ++c) {
      f32x4 s[4];
      _Pragma("unroll") for (int m = 0; m < 4; ++m) s[m] = f32x4{0.f, 0.f, 0.f, 0.f};
      _Pragma("unroll") for (int ks = 0; ks < NKS; ++ks) _Pragma("unroll") for (int m = 0; m < 4; ++m) {
        bf16x8 a = *(const bf16x8*)&Kb[(16 * m + fr) * KLD + c * DQK + ks * 32 + fq * 8];
        s[m] = __builtin_amdgcn_mfma_f32_16x16x32_bf16(a, qf[c][ks], s[m], 0, 0, 0);
      }
      constexpr float THR = 8.f;
      float tnew, psum = 0.f;
      if (general) {
        float tmax = -1e30f;
        _Pragma("unroll") for (int m = 0; m < 4; ++m) _Pragma("unroll") for (int j = 0; j < 4; ++j) {
          float v = s[m][j] * scale_log2 + bv[m][j];
          s[m][j] = v; tmax = fmaxf(tmax, v);
        }
        tnew = tmax;
      } else {
        float rmax = fmaxf(fmaxf(s[0][0], s[0][1]), fmaxf(s[0][2], s[0][3]));
        _Pragma("unroll") for (int m = 1; m < 4; ++m) rmax = fmaxf(rmax, fmaxf(fmaxf(s[m][0], s[m][1]), fmaxf(s[m][2], s[m][3])));
        tnew = rmax * scale_log2 + bb;
      }
      if (__builtin_amdgcn_ballot_w64(tnew - mrun[c] > THR) != 0ull) {
        tnew = fmaxf(tnew, sx<16>(tnew, lane)); tnew = fmaxf(tnew, sx<32>(tnew, lane));
        float mnew = fmaxf(mrun[c], tnew);
        float alpha = __builtin_amdgcn_exp2f(mrun[c] - mnew);
        mrun[c] = mnew; lsum[c] *= alpha;
        _Pragma("unroll") for (int v = 0; v < NVT; ++v) _Pragma("unroll") for (int j = 0; j < 4; ++j) O[c][v][j] *= alpha;
      }
      if (general) {
        float mm = mrun[c];
        _Pragma("unroll") for (int m = 0; m < 4; ++m) _Pragma("unroll") for (int j = 0; j < 4; ++j) { float pv = __builtin_amdgcn_exp2f(s[m][j] - mm); s[m][j] = pv; psum += pv; }
      } else {
        float cc = bb - mrun[c];
        _Pragma("unroll") for (int m = 0; m < 4; ++m) _Pragma("unroll") for (int j = 0; j < 4; ++j) { float pv = __builtin_amdgcn_exp2f(s[m][j] * scale_log2 + cc); s[m][j] = pv; psum += pv; }
      }
      lsum[c] += psum;
      _Pragma("unroll") for (int k2 = 0; k2 < 2; ++k2) {
        uint2 lo = pack4(s[2 * k2][0], s[2 * k2][1], s[2 * k2][2], s[2 * k2][3]);
        uint2 hi = pack4(s[2 * k2 + 1][0], s[2 * k2 + 1][1], s[2 * k2 + 1][2], s[2 * k2 + 1][3]);
        uint4 pk; pk.x = lo.x; pk.y = lo.y; pk.z = hi.x; pk.w = hi.y;
        pf[c][k2] = *(bf16x8*)&pk;
      }
    }
    _Pragma("unroll") for (int k2 = 0; k2 < 2; ++k2) _Pragma("unroll") for (int v = 0; v < NVT; ++v) {
      bf16x8 a = *(const bf16x8*)&Vb[(16 * v + fr) * VLD + 32 * k2 + fq * 8];
      _Pragma("unroll") for (int c = 0; c < NC; ++c) O[c][v] = __builtin_amdgcn_mfma_f32_16x16x32_bf16(a, pf[c][k2], O[c][v], 0, 0, 0);
      if ((v & 3) == 3) __builtin_amdgcn_sched_barrier(0);
    }
  }
  float inv[NC];
  _Pragma("unroll") for (int c = 0; c < NC; ++c) { float l = lsum[c]; l += sx<16>(l, lane); l += sx<32>(l, lane); inv[c] = 1.f / l; }
  u16* orow = Og + (long)(wid * 16 + fr) * o_stride;
  if (NC == 2) {
    float ss = 0.f;
    _Pragma("unroll") for (int v = 0; v < NVT; ++v) _Pragma("unroll") for (int j = 0; j < 4; ++j) { float o = O[0][v][j] * inv[0] - lam * O[NC - 1][v][j] * inv[NC - 1]; O[0][v][j] = o; ss += o * o; }
    ss += sx<16>(ss, lane); ss += sx<32>(ss, lane);
    float rs = rsqrtf(ss * (1.f / DV) + EPS) * outscale;
    _Pragma("unroll") for (int v = 0; v < NVT; ++v) {
      float4 g = *(const float4*)&subln_g[16 * v + fq * 4];
      *(uint2*)&orow[16 * v + fq * 4] = pack4(O[0][v][0] * rs * g.x, O[0][v][1] * rs * g.y, O[0][v][2] * rs * g.z, O[0][v][3] * rs * g.w);
    }
  } else {
    _Pragma("unroll") for (int v = 0; v < NVT; ++v)
      *(uint2*)&orow[16 * v + fq * 4] = pack4(O[0][v][0] * inv[0], O[0][v][1] * inv[0], O[0][v][2] * inv[0], O[0][v][3] * inv[0]);
  }
}

__device__ __forceinline__ void diff_attn_phase(const Params& p, int j, int layer_idx, char* shm, int wv) {
  int tid = opaque_tid(wv), lane = tid & 63;
  float* btab = (float*)(shm + LDS_BYTES - 1024);
  float sa = p.da_lq1[j * 64 + lane] * p.da_lk1[j * 64 + lane], sb = p.da_lq2[j * 64 + lane] * p.da_lk2[j * 64 + lane];
  sa = wave_sum(sa, lane); sb = wave_sum(sb, lane);
  float lam_init = 0.8f - 0.6f * expf(-0.3f * (float)layer_idx);
  float lam = expf(sa) - expf(sb) + lam_init;
  const u16 *qb = p.B0, *kb = p.B1, *vT = p.B2; u16* ao = p.B3;
  for (int i = blockIdx.x; i < 2048; i += gridDim.x) {
    int wgl = i & 255, step = i >> 8, xcd = wgl & 7, slot = wgl >> 3;
    int bh = xcd + 8 * (step >> 1), qblk = (step & 1) ? 63 - slot : slot;
    int b = bh >> 3, h = bh & 7, q0 = qblk * 128;
    __syncthreads();
    if (tid < 128) btab[tid] = p.biastab[h * 128 + tid];
    flash_item<2, 64, 128, true, true>(qb + ((long)(b * SEQ + q0)) * DM + h * 128, DM, kb + ((long)b * SEQ) * DM + h * 128, DM,
                                 vT + ((long)(b * DM + h * 128)) * SEQ, SEQ, q0 / 64 + 2, q0, 0.125f * LOG2E, btab, lam,
                                 p.da_subln + j * 128, 1.f - lam_init, ao + ((long)(b * SEQ + q0)) * DM + h * 128, DM, shm, wv);
  }
}

__device__ __forceinline__ void cross_attn_phase(const Params& p, int layer, char* shm, int wv) {
  const u16* caq = p.B0; u16* cao = p.B1;
  const u16* mK = p.memK + (long)layer * NB * MEML * DM; const u16* mVT = p.memVT + (long)layer * NB * DM * MEML;
  for (int i = blockIdx.x; i < 1024; i += gridDim.x) {
    int head = i & 3, blk = i >> 2, b = blk >> 6, qblk = blk & 63;
    __syncthreads();
    flash_item<1, 256, 256, false, true>(caq + ((long)(b * SEQ + qblk * 128)) * DM + head * 256, DM, mK + ((long)b * MEML) * DM + head * 256, DM,
                                   mVT + ((long)(b * DM + head * 256)) * MEML, MEML, 4, 0, 0.0625f * LOG2E, nullptr, 0.f, nullptr, 1.f,
                                   cao + ((long)(b * SEQ + qblk * 128)) * DM + head * 256, DM, shm, wv);
  }
}

constexpr int HLD = 132;
__device__ __forceinline__ long kdt_off(int tok0, int h, int k) {
  return ((long)(tok0 + (k >> 1)) * DM + h * 128) + (k & 1) * 64;
}

__device__ __forceinline__ void hg1_phase(const Params& p, char* shm, int wv) {
  float* L = (float*)shm; float* Gs = L + 64 * HLD; float* Qs = Gs + 64 * HLD; float* R = Qs + 64 * HLD;
  int tid = opaque_tid(wv), wid = tid >> 6, lane = tid & 63, fr = lane & 15, fq = lane >> 4;
  u16* qbuf = p.B0; u16* lfbuf = p.B1; u16* Abuf = p.B4;
  u32x4 plv[2], pqv[2];
#define HG1_PREFETCH(it_) do { int h_ = (it_) & 7, cn_ = ((it_) >> 3) & 127, b_ = (it_) >> 10, tk_ = b_ * SEQ + cn_ * 64; \
    _Pragma("unroll") for (int i = 0; i < 2; ++i) { int id = tid + i * 512, row = id >> 4, cc = id & 15; \
      plv[i] = *(const u32x4*)&lfbuf[(long)(tk_ + row) * DM + h_ * 128 + cc * 8]; pqv[i] = *(const u32x4*)&qbuf[(long)(tk_ + row) * DM + h_ * 128 + cc * 8]; } } while (0)
  if ((int)blockIdx.x < 4096) HG1_PREFETCH((int)blockIdx.x);
  for (int it = blockIdx.x; it < 4096; it += gridDim.x) {
    int h = it & 7, cn = (it >> 3) & 127, b = it >> 10, tok0 = b * SEQ + cn * 64;
    __syncthreads();
    _Pragma("unroll") for (int i = 0; i < 2; ++i) {
      int id = tid + i * 512, row = id >> 4, cc = id & 15;
      _Pragma("unroll") for (int e = 0; e < 4; ++e) {
        unsigned lw = plv[i][e], qw = pqv[i][e];
        L[row * HLD + cc * 8 + 2 * e] = __uint_as_float(lw << 16); L[row * HLD + cc * 8 + 2 * e + 1] = __uint_as_float(lw & 0xffff0000u);
        Qs[row * HLD + cc * 8 + 2 * e] = __uint_as_float(qw << 16); Qs[row * HLD + cc * 8 + 2 * e + 1] = __uint_as_float(qw & 0xffff0000u);
      }
    }
    __syncthreads();
    if (it + (int)gridDim.x < 4096) HG1_PREFETCH(it + (int)gridDim.x);
    {
      int k = tid & 127, qd = tid >> 7; float run = 0.f;
      _Pragma("unroll") for (int i = 0; i < 16; ++i) { run += L[(16 * qd + i) * HLD + k]; Gs[(16 * qd + i) * HLD + k] = run; }
      R[(qd + 1) * 128 + k] = run;
    }
    __syncthreads();
    {
      int k = tid & 127, qd = tid >> 7; float r = 0.f;
      for (int i = 0; i < qd; ++i) r += R[(i + 1) * 128 + k];
      float tot = R[(qd + 1) * 128 + k];
      __syncthreads();
      _Pragma("unroll") for (int i = 0; i < 16; ++i) Gs[(16 * qd + i) * HLD + k] += r;
      R[qd * 128 + k] = r;
      if (qd == 3) R[4 * 128 + k] = r + tot;
    }
    __syncthreads();
    _Pragma("unroll") for (int i = 0; i < 2; ++i) {
      int id = tid + i * 512, row = id >> 4, cc = id & 15; float v[8];
      _Pragma("unroll") for (int e = 0; e < 8; ++e) v[e] = Qs[row * HLD + cc * 8 + e] * __expf(Gs[row * HLD + cc * 8 + e]);
      uint2 lo = pack4(v[0], v[1], v[2], v[3]), hi = pack4(v[4], v[5], v[6], v[7]);
      uint4 o; o.x = lo.x; o.y = lo.y; o.z = hi.x; o.w = hi.y;
      *(uint4*)&qbuf[(long)(tok0 + row) * DM + h * 128 + cc * 8] = o;
    }
    _Pragma("unroll") for (int i = 0; i < 2; ++i) {
      int id = tid + i * 512, k = id & 127, sc = id >> 7; float gl = R[4 * 128 + k]; float v[8];
      _Pragma("unroll") for (int e = 0; e < 8; ++e) { int s = sc * 8 + e; v[e] = (1.f - __expf(L[s * HLD + k])) * __expf(gl - Gs[s * HLD + k]); }
      uint2 lo = pack4(v[0], v[1], v[2], v[3]), hi = pack4(v[4], v[5], v[6], v[7]);
      uint4 o; o.x = lo.x; o.y = lo.y; o.z = hi.x; o.w = hi.y;
      *(uint4*)&lfbuf[kdt_off(tok0, h, k) + sc * 8] = o;
    }
    if (tid < 128) p.dbuf[(long)it * 128 + tid] = __expf(R[4 * 128 + tid]);
    u16* Ait = Abuf + (long)it * 4096;
    for (int blk = wid; blk < 10; blk += 8) {
      int ti = blk < 1 ? 0 : (blk < 3 ? 1 : (blk < 6 ? 2 : 3));
      int sj = blk - (ti * (ti + 1)) / 2;
      f32x4 acc = {0.f, 0.f, 0.f, 0.f};
      _Pragma("unroll") for (int ks = 0; ks < 4; ++ks) {
        float av[8], bv[8];
        _Pragma("unroll") for (int e = 0; e < 8; ++e) {
          int kk = ks * 32 + fq * 8 + e; float rr = R[ti * 128 + kk];
          av[e] = Qs[(16 * ti + fr) * HLD + kk] * __expf(Gs[(16 * ti + fr) * HLD + kk] - rr);
          bv[e] = (1.f - __expf(L[(16 * sj + fr) * HLD + kk])) * __expf(fminf(rr - Gs[(16 * sj + fr) * HLD + kk], 80.f));
        }
        uint2 al = pack4(av[0], av[1], av[2], av[3]), ah = pack4(av[4], av[5], av[6], av[7]);
        uint2 bl = pack4(bv[0], bv[1], bv[2], bv[3]), bh = pack4(bv[4], bv[5], bv[6], bv[7]);
        uint4 a4, b4; a4.x = al.x; a4.y = al.y; a4.z = ah.x; a4.w = ah.y; b4.x = bl.x; b4.y = bl.y; b4.z = bh.x; b4.w = bh.y;
        acc = __builtin_amdgcn_mfma_f32_16x16x32_bf16(*(bf16x8*)&a4, *(bf16x8*)&b4, acc, 0, 0, 0);
      }
      _Pragma("unroll") for (int j = 0; j < 4; ++j) {
        int t = 16 * ti + fq * 4 + j, s = 16 * sj + fr;
        float v = (s <= t) ? acc[j] : 0.f;
        Ait[t * 64 + s] = f2bf(v);
      }
    }
    if (wid < 6) {
      int ti = wid < 3 ? 0 : (wid < 5 ? 1 : 2);
      int sj = wid < 3 ? wid + 1 : (wid < 5 ? wid - 1 : 3);
      _Pragma("unroll") for (int j = 0; j < 4; ++j) Ait[(16 * ti + fq * 4 + j) * 64 + 16 * sj + fr] = 0;
    }
  }
}

template <int MODE>
__device__ __forceinline__ void hg2_phase(const Params& p, char* shm, int wv) {
  constexpr int QLD = 136, KLD = 72;
  constexpr int QB = 64 * QLD, KB = 128 * KLD, AB = 64 * KLD, VB = 128 * KLD;
  constexpr int BUF_EL = QB + KB + AB + VB + 256;
  int tid = opaque_tid(wv), wid = tid >> 6, lane = tid & 63, fr = lane & 15, fq = lane >> 4;
  u16* qbuf = p.B0; const u16* kdbuf = p.B1; const u16* iT = p.B2; const u16* Abuf = p.B4;
  float* Send = p.out; float* Dseg = Send + 32L * 8 * 128 * 128;
  for (int it = blockIdx.x; it < 256; it += gridDim.x) {
    int bh = it >> 3, seg = it & 7, b = bh >> 3, h = bh & 7;
    if (MODE == 0 && seg == 7) continue;
    f32x4 S[8];
    _Pragma("unroll") for (int m = 0; m < 8; ++m) S[m] = f32x4{0.f, 0.f, 0.f, 0.f};
    if (MODE == 1) {
      for (int g = 0; g < seg; ++g) {
        const float* se = Send + ((long)(bh * 8 + g)) * 16384; const float* dg = Dseg + (bh * 8 + g) * 128;
        _Pragma("unroll") for (int m = 0; m < 8; ++m) {
          float4 dv = *(const float4*)&dg[16 * m + fq * 4];
          S[m][0] = S[m][0] * dv.x + se[(16 * m + fq * 4 + 0) * 128 + 16 * wid + fr];
          S[m][1] = S[m][1] * dv.y + se[(16 * m + fq * 4 + 1) * 128 + 16 * wid + fr];
          S[m][2] = S[m][2] * dv.z + se[(16 * m + fq * 4 + 2) * 128 + 16 * wid + fr];
          S[m][3] = S[m][3] * dv.w + se[(16 * m + fq * 4 + 3) * 128 + 16 * wid + fr];
        }
      }
    }
    float dacc = 1.f;
    u32x4 rq[2], rk[2], ra, rv[2]; f32x4 rd = {0.f, 0.f, 0.f, 0.f};
#define HG_PREFETCH(cn_) do { int tok0_ = b * SEQ + (cn_) * 64; long it_ = ((long)(b * 128 + (cn_))) * 8 + h; \
      if (MODE == 1) { _Pragma("unroll") for (int i = 0; i < 2; ++i) { int id = tid + i * 512, row = id >> 4, cc = id & 15; rq[i] = *(const u32x4*)&qbuf[(long)(tok0_ + row) * DM + h * 128 + cc * 8]; } } \
      _Pragma("unroll") for (int i = 0; i < 2; ++i) { int id = tid + i * 512, k = id >> 3, sc = id & 7; rk[i] = *(const u32x4*)&kdbuf[kdt_off(tok0_, h, k) + sc * 8]; } \
      if (MODE == 1) { int t = tid >> 3, sc = tid & 7; ra = *(const u32x4*)&Abuf[it_ * 4096 + t * 64 + sc * 8]; } \
      _Pragma("unroll") for (int i = 0; i < 2; ++i) { int id = tid + i * 512, v = id >> 3, sc = id & 7; rv[i] = *(const u32x4*)&iT[((long)(b * 128 + (cn_)) * DM + h * 128 + v) * 64 + sc * 8]; } \
      if (tid < 32) rd = *(const f32x4*)&p.dbuf[it_ * 128 + tid * 4]; } while (0)
#define HG_STASH(bi_) do { \
      u16* base_ = (u16*)shm + (bi_) * BUF_EL; u16* Qt_ = base_; u16* Kd_ = Qt_ + QB; u16* At_ = Kd_ + KB; u16* Vt_ = At_ + AB; float* dd_ = (float*)(Vt_ + VB); \
      if (MODE == 1) { _Pragma("unroll") for (int i = 0; i < 2; ++i) { int id = tid + i * 512, row = id >> 4, cc = id & 15; *(u32x4*)&Qt_[row * QLD + cc * 8] = rq[i]; } } \
      _Pragma("unroll") for (int i = 0; i < 2; ++i) { int id = tid + i * 512, k = id >> 3, sc = id & 7; *(u32x4*)&Kd_[k * KLD + sc * 8] = rk[i]; } \
      if (MODE == 1) { int t = tid >> 3, sc = tid & 7; *(u32x4*)&At_[t * KLD + sc * 8] = ra; } \
      _Pragma("unroll") for (int i = 0; i < 2; ++i) { int id = tid + i * 512, v = id >> 3, sc = id & 7; *(u32x4*)&Vt_[v * KLD + sc * 8] = rv[i]; } \
      if (tid < 32) *(f32x4*)&dd_[tid * 4] = rd; } while (0)
    __syncthreads();
    HG_PREFETCH(seg * 16); HG_STASH(0);
    for (int c = 0; c < 16; ++c) {
      int cn = seg * 16 + c;
      __syncthreads();
      if (c + 1 < 16) HG_PREFETCH(cn + 1);
      u16* base = (u16*)shm + (c & 1) * BUF_EL; u16* Qt = base; u16* Kd = Qt + QB; u16* At = Kd + KB; u16* Vt = At + AB; float* dd = (float*)(Vt + VB);
      bf16x8 vb[2];
      _Pragma("unroll") for (int k2 = 0; k2 < 2; ++k2) vb[k2] = *(const bf16x8*)&Vt[(16 * wid + fr) * KLD + k2 * 32 + fq * 8];
      if (MODE == 1) {
        bf16x8 Sb[4];
        _Pragma("unroll") for (int ks = 0; ks < 4; ++ks) {
          uint2 lo = pack4(S[2 * ks][0], S[2 * ks][1], S[2 * ks][2], S[2 * ks][3]);
          uint2 hi = pack4(S[2 * ks + 1][0], S[2 * ks + 1][1], S[2 * ks + 1][2], S[2 * ks + 1][3]);
          uint4 pk; pk.x = lo.x; pk.y = lo.y; pk.z = hi.x; pk.w = hi.y; Sb[ks] = *(bf16x8*)&pk;
        }
        int tok0 = b * SEQ + cn * 64;
        _Pragma("unroll") for (int rt = 0; rt < 4; ++rt) {
          f32x4 o = {0.f, 0.f, 0.f, 0.f};
          _Pragma("unroll") for (int ks = 0; ks < 4; ++ks) {
            uint2 lo = *(const uint2*)&Qt[(16 * rt + fr) * QLD + 32 * ks + fq * 4];
            uint2 hi = *(const uint2*)&Qt[(16 * rt + fr) * QLD + 32 * ks + 16 + fq * 4];
            uint4 pk; pk.x = lo.x; pk.y = lo.y; pk.z = hi.x; pk.w = hi.y;
            o = __builtin_amdgcn_mfma_f32_16x16x32_bf16(*(bf16x8*)&pk, Sb[ks], o, 0, 0, 0);
          }
          _Pragma("unroll") for (int k2 = 0; k2 < 2; ++k2) {
            bf16x8 a = *(const bf16x8*)&At[(16 * rt + fr) * KLD + k2 * 32 + fq * 8];
            o = __builtin_amdgcn_mfma_f32_16x16x32_bf16(a, vb[k2], o, 0, 0, 0);
          }
          _Pragma("unroll") for (int j = 0; j < 4; ++j) qbuf[(long)(tok0 + 16 * rt + fq * 4 + j) * DM + h * 128 + 16 * wid + fr] = f2bf(o[j]);
        }
      } else if (tid < 128) dacc *= dd[tid];
      _Pragma("unroll") for (int m = 0; m < 8; ++m) {
        float4 dv = *(const float4*)&dd[16 * m + fq * 4];
        S[m][0] *= dv.x; S[m][1] *= dv.y; S[m][2] *= dv.z; S[m][3] *= dv.w;
        _Pragma("unroll") for (int k2 = 0; k2 < 2; ++k2) {
          bf16x8 a = *(const bf16x8*)&Kd[(16 * m + fr) * KLD + k2 * 32 + fq * 8];
          S[m] = __builtin_amdgcn_mfma_f32_16x16x32_bf16(a, vb[k2], S[m], 0, 0, 0);
        }
      }
      if (c + 1 < 16) HG_STASH((c + 1) & 1);
    }
    if (MODE == 0) {
      float* se = Send + ((long)(bh * 8 + seg)) * 16384;
      _Pragma("unroll") for (int m = 0; m < 8; ++m) _Pragma("unroll") for (int j = 0; j < 4; ++j) se[(16 * m + fq * 4 + j) * 128 + 16 * wid + fr] = S[m][j];
      if (tid < 128) Dseg[(bh * 8 + seg) * 128 + tid] = dacc;
    }
  }
}

__device__ __forceinline__ void hg3_phase(const Params& p, int wv) {
  int tid = opaque_tid(wv); int wid = tid >> 6, lane = tid & 63;
  u16* ob = p.B0; const u16* gb = p.B3;
  for (int row = blockIdx.x * 8 + wid; row < T_TOK; row += gridDim.x * 8) {
    uint4 o0 = *(const uint4*)&ob[(long)row * DM + lane * 16], o1 = *(const uint4*)&ob[(long)row * DM + lane * 16 + 8];
    uint4 g0 = *(const uint4*)&gb[(long)row * DM + lane * 16], g1 = *(const uint4*)&gb[(long)row * DM + lane * 16 + 8];
    float o[16], g[16];
    const u16* po0 = (const u16*)&o0; const u16* po1 = (const u16*)&o1; const u16* pg0 = (const u16*)&g0; const u16* pg1 = (const u16*)&g1;
    _Pragma("unroll") for (int e = 0; e < 8; ++e) { o[e] = bf2f(po0[e]); o[8 + e] = bf2f(po1[e]); g[e] = bf2f(pg0[e]); g[8 + e] = bf2f(pg1[e]); }
    float ss = 0.f; _Pragma("unroll") for (int e = 0; e < 16; ++e) ss += o[e] * o[e];
    ss += sx<1>(ss, lane); ss += sx<2>(ss, lane); ss += sx<4>(ss, lane);
    float rs = rsqrtf(ss * (1.f / 128.f) + EPS);
    int c0 = (lane & 7) * 16; float r[16];
    _Pragma("unroll") for (int e = 0; e < 16; ++e) r[e] = o[e] * rs * p.hg_onorm[c0 + e] * silu_f(g[e]);
    uint2 a = pack4(r[0], r[1], r[2], r[3]), b2 = pack4(r[4], r[5], r[6], r[7]), c = pack4(r[8], r[9], r[10], r[11]), d = pack4(r[12], r[13], r[14], r[15]);
    uint4 w0, w1; w0.x = a.x; w0.y = a.y; w0.z = b2.x; w0.w = b2.y; w1.x = c.x; w1.y = c.y; w1.z = d.x; w1.w = d.y;
    *(uint4*)&ob[(long)row * DM + lane * 16] = w0; *(uint4*)&ob[(long)row * DM + lane * 16 + 8] = w1;
  }
}

__device__ __forceinline__ void sgu_phase(const Params& p, char* shm, int wv) {
  constexpr int WLD = 136;
  u16* Wp = (u16*)shm; float* rsv = (float*)(shm + 128 * WLD * 2);
  int tid = opaque_tid(wv), wid = tid >> 6, lane = tid & 63, fr = lane & 15, fq = lane >> 4;
  const u16* ub = p.B0; const u16* vT = p.B1; u16* ob = p.B2; const float* rowss_v = p.vpart;
  for (int it = blockIdx.x; it < 2048; it += gridDim.x) {
    int g = it & 7, c128 = it >> 3, tok0 = c128 * 128;
    __syncthreads();
    if (tid < 128) rsv[tid] = row_rs(rowss_v, tok0 + tid);
    __syncthreads();
    _Pragma("unroll") for (int i = 0; i < 4; ++i) {
      int id = tid + i * 512, t = id >> 4, sc = id & 15;
      const float4* w4 = (const float4*)(p.sg_w_s + ((long)(g * 128 + t)) * 128 + sc * 8);
      float4 a = w4[0], b = w4[1]; float v[8] = {a.x, a.y, a.z, a.w, b.x, b.y, b.z, b.w};
      _Pragma("unroll") for (int e = 0; e < 8; ++e) { int s = sc * 8 + e; v[e] = (s <= t) ? v[e] * rsv[s] : 0.f; }
      uint2 lo = pack4(v[0], v[1], v[2], v[3]), hi = pack4(v[4], v[5], v[6], v[7]);
      uint4 o; o.x = lo.x; o.y = lo.y; o.z = hi.x; o.w = hi.y;
      *(uint4*)&Wp[t * WLD + sc * 8] = o;
    }
    bf16x8 vb[4];
    int cc = g * 128 + 16 * wid + fr;
    _Pragma("unroll") for (int ks = 0; ks < 4; ++ks) vb[ks] = *(const bf16x8*)&vT[((long)c128 * DM + cc) * 128 + ks * 32 + fq * 8];
    float4 gvn = *(const float4*)&p.sg_vnorm[g * 128 + 16 * wid + fq * 4];
    __syncthreads();
    _Pragma("unroll") for (int mt = 0; mt < 8; ++mt) {
      f32x4 acc = {0.f, 0.f, 0.f, 0.f};
      _Pragma("unroll") for (int ks = 0; ks <= (mt >> 1); ++ks) {
        bf16x8 a = *(const bf16x8*)&Wp[(16 * mt + fr) * WLD + ks * 32 + fq * 8];
        acc = __builtin_amdgcn_mfma_f32_16x16x32_bf16(vb[ks], a, acc, 0, 0, 0);
      }
      int t = 16 * mt + fr; float bs = p.sg_b_s[g * 128 + t];
      long idx = (long)(tok0 + t) * DM + g * 128 + 16 * wid + fq * 4;
      uint2 uv = *(const uint2*)&ub[idx];
      float u0 = __uint_as_float(uv.x << 16), u1 = __uint_as_float(uv.x & 0xffff0000u), u2 = __uint_as_float(uv.y << 16), u3 = __uint_as_float(uv.y & 0xffff0000u);
      *(uint2*)&ob[idx] = pack4(u0 * (acc[0] * gvn.x + bs), u1 * (acc[1] * gvn.y + bs), u2 * (acc[2] * gvn.z + bs), u3 * (acc[3] * gvn.w + bs));
    }
  }
}

__device__ __forceinline__ void final_phase(const Params& p, int wv) {
  int tid = opaque_tid(wv); int wid = tid >> 6, lane = tid & 63;
  for (int row = blockIdx.x * 8 + wid; row < T_TOK; row += gridDim.x * 8) {
    float rs = row_rs(p.rpart, row);
    float4* o4 = (float4*)(p.out + (long)row * DM);
    const uint2* x2 = (const uint2*)(p.xb + (long)row * DM);
    _Pragma("unroll") for (int i = 0; i < 4; ++i) {
      uint2 xv = x2[i * 64 + lane]; float4 g = ((const float4*)p.norm_final)[i * 64 + lane]; float4 v;
      v.x = __uint_as_float(xv.x << 16) * rs * g.x; v.y = __uint_as_float(xv.x & 0xffff0000u) * rs * g.y;
      v.z = __uint_as_float(xv.y << 16) * rs * g.z; v.w = __uint_as_float(xv.y & 0xffff0000u) * rs * g.w;
      o4[i * 64 + lane] = v;
    }
  }
}

#define XB_TMO      128
#define XB_XCNT(j)  (256  + 64 * (j))
#define XB_XSUB(j)  (1280 + 64 * (j))
#define XB_XGEN(j)  (2304 + 64 * (j))
#define XB_TOP      3328
#define XB_TOPGEN   3392
#define XCD_BAR_WORDS 3456
#define XB_SPIN_CAP (1u << 22)
#define LAS __attribute__((address_space(3)))

__device__ __forceinline__ unsigned xb_ld(unsigned* p)              { return __hip_atomic_load(p, __ATOMIC_RELAXED, __HIP_MEMORY_SCOPE_AGENT); }
__device__ __forceinline__ unsigned xb_add(unsigned* p, unsigned v) { return __hip_atomic_fetch_add(p, v, __ATOMIC_RELAXED, __HIP_MEMORY_SCOPE_AGENT); }
__device__ __forceinline__ unsigned xb_xcc_id() { return (unsigned)__builtin_amdgcn_s_getreg((3 << 11) | 20) & 0xFu; }
#define XB_SPIN(cond, bar) do { unsigned _sp = 0; while (cond) { __builtin_amdgcn_s_sleep(1); \
    if ((++_sp & 255u) == 0u) { if (xb_ld(&(bar)[XB_TMO])) break; if (_sp > XB_SPIN_CAP) { atomicAdd(&(bar)[XB_TMO], 1u); break; } } } } while (0)

struct XcdBarrier {
    unsigned* bar; unsigned x;
    volatile LAS unsigned* st;
};

__device__ __forceinline__ XcdBarrier xcd_barrier_post(unsigned* bar, volatile LAS unsigned* st, bool t0) {
    XcdBarrier b; b.bar = bar; b.x = xb_xcc_id(); b.st = st;
    if (t0) (void)xb_add(&bar[XB_XCNT(b.x)], 1u);
    return b;
}
__device__ __forceinline__ void xcd_barrier_complete(unsigned* bar, unsigned x, unsigned& nloc, unsigned& nx) {
    const unsigned G = gridDim.x * gridDim.y * gridDim.z;
    unsigned sum, cnt, mine, sp = 0u;
    for (;;) {
        sum = 0u; cnt = 0u; mine = 0u;
#pragma unroll
        for (unsigned j = 0; j < 16; ++j) { const unsigned c = xb_ld(&bar[XB_XCNT(j)]); sum += c; cnt += (c > 0u) ? 1u : 0u; mine = (j == x) ? c : mine; }
        if (sum == G) break;
        __builtin_amdgcn_s_sleep(1);
        if ((++sp & 255u) == 0u) { if (xb_ld(&bar[XB_TMO])) break; if (sp > XB_SPIN_CAP) { atomicAdd(&bar[XB_TMO], 1u); break; } }
    }
    nloc = mine > 0u ? mine : 1u; nx = cnt > 0u ? cnt : 1u;
}

__device__ __forceinline__ void xcd_barrier(const XcdBarrier& b, bool t0) {
    asm volatile("s_waitcnt vmcnt(0)" ::: "memory");
    __syncthreads();
    if (t0) {
        unsigned* bar = b.bar;
        __builtin_amdgcn_s_waitcnt(0);
        unsigned nloc = b.st[0], nx = b.st[1];
        if (nloc == 0u) { xcd_barrier_complete(bar, b.x, nloc, nx); b.st[0] = nloc; b.st[1] = nx; }
        const unsigned old = xb_add(&bar[XB_XSUB(b.x)], 1u);
        const unsigned gen = old / nloc;
        if (old + 1u == (gen + 1u) * nloc) {
            __builtin_amdgcn_fence(__ATOMIC_RELEASE, "agent");
            asm volatile("s_waitcnt vmcnt(0)" ::: "memory");
            const unsigned og = xb_add(&bar[XB_TOP], 1u);
            const unsigned tg = og / nx;
            if (og + 1u == (tg + 1u) * nx) xb_add(&bar[XB_TOPGEN], 1u);
            else XB_SPIN(xb_ld(&bar[XB_TOPGEN]) == tg, bar);
            __builtin_amdgcn_fence(__ATOMIC_ACQUIRE, "agent");
            xb_add(&bar[XB_XGEN(b.x)], 1u);
            asm volatile("s_waitcnt vmcnt(0)" ::: "memory");
        } else {
            XB_SPIN(xb_ld(&bar[XB_XGEN(b.x)]) == gen, bar);
            __builtin_amdgcn_fence(__ATOMIC_ACQUIRE, "agent");
            asm volatile("s_waitcnt vmcnt(0)" ::: "memory");
        }
    }
    __syncthreads();
}


#define SEL4(arr, i) ((i) == 0 ? (arr)[0] : ((i) == 1 ? (arr)[1] : ((i) == 2 ? (arr)[2] : (arr)[3])))
__global__ void __launch_bounds__(512, 2) fwd_megakernel(KArgs ka_unused) {
  extern __shared__ __attribute__((aligned(16))) char shm[];
  const int wv = __builtin_amdgcn_readfirstlane((int)(threadIdx.x >> 6));
  int ph = 0;
#define BARRIER_WS ((unsigned*)(kargs_ptr()->ws + OFF_BAR))
#if MULTI_LAUNCH
#define PHASE_BEGIN if (ph >= kargs_ptr()->phase_lo && ph < kargs_ptr()->phase_hi) { const Params p = make_params(*kargs_ptr());
#define PHASE_END } ++ph;
#else
  cg::grid_group grid = cg::this_grid();
#define PHASE_BEGIN { const Params p = make_params(*kargs_ptr());
#define PHASE_END } ++ph; { XcdBarrier xb_; xb_.bar = BARRIER_WS; xb_.x = xb_xcc_id(); xb_.st = (volatile LAS unsigned*)(shm + LDS_BYTES - 16); xcd_barrier(xb_, opaque_tid(wv) == 0); }
#endif
#define LAYER_VARS \
    const float* xin = (i == 0) ? p.x : p.out; float* rs_mix = p.rpart; float* rs_cross = p.rpart; float* rs_ffn = p.rpart; float* rs_next = p.rpart; \
    const u16* w_mix_in = p.wbase + layer_woff(i); const u16* w_mix_out = w_mix_in + mixin_elems(i); const u16* w_caq = w_mix_out + 1048576L; \
    const u16* w_cao = w_caq + 3145728L; const u16* w_gu = w_cao + 1048576L; const u16* w_down = w_gu + 5767168L; \
    const u16* mix_out_A = kind == 0 ? p.B3 : (kind == 1 ? p.B0 : p.B2); \
    (void)xin; (void)rs_mix; (void)rs_cross; (void)rs_ffn; (void)rs_next; (void)w_mix_in; (void)w_mix_out; (void)w_caq; (void)w_cao; (void)w_gu; (void)w_down; (void)mix_out_A;
#if MULTI_LAUNCH
  PHASE_BEGIN prep_phase(p, kargs_ptr(), shm, wv); PHASE_END
#else
  { const Params p = make_params(*kargs_ptr()); prep_phase(p, kargs_ptr(), shm, wv); } ++ph;
  grid.sync();
  {
    volatile LAS unsigned* xb_st = (volatile LAS unsigned*)(shm + LDS_BYTES - 16);
    if (opaque_tid(wv) == 0) { xb_st[0] = 0u; xb_st[1] = 0u; }
    __syncthreads();
    (void)xcd_barrier_post(BARRIER_WS, xb_st, opaque_tid(wv) == 0);
  }
#endif
  _Pragma("nounroll") for (int i = 0; i < 4; ++i) {
    int kind = i % 3, j = i / 3;
    if (kind == 0) {
      PHASE_BEGIN LAYER_VARS
        if (i == 0) {
          for (int t = blockIdx.x; t < 128; t += gridDim.x) {
            int l = t >> 5, tt = t & 31, tr0 = (tt & 3) * BM, fc0 = (tt >> 2) * BM;
            EpiMemKV em{p.memK + (long)l * NB * MEML * DM, p.memVT + (long)l * NB * DM * MEML};
            const u16* mA = p.memn; const u16* mB = p.wbase + layer_woff(l) + mixin_elems(l) + 2097152L;
            bool sw = em.swap(fc0);
            gemm_tile(sw ? mB : mA, sw ? mA : mB, DM, sw ? fc0 : tr0, sw ? tr0 : fc0, shm, em, tr0, fc0, sw, false, false, mA, mB, 0, 0, wv);
          }
        }
        EpiDaIn e{rs_mix, p.B0, p.B1, p.B2}; gemm_phase(p.xb, w_mix_in, T_TOK, 3 * DM, DM, shm, e, wv);
      PHASE_END
      PHASE_BEGIN diff_attn_phase(p, j, i, shm, wv); PHASE_END
    } else if (kind == 1) {
      PHASE_BEGIN LAYER_VARS EpiHgIn e{rs_mix, p.lbv, p.B0, p.B1, p.B2, p.B3}; gemm_phase(p.xb, w_mix_in, T_TOK, 4 * DM, DM, shm, e, wv); PHASE_END
      PHASE_BEGIN hg1_phase(p, shm, wv); PHASE_END
      PHASE_BEGIN hg2_phase<0>(p, shm, wv); PHASE_END
      PHASE_BEGIN hg2_phase<1>(p, shm, wv); PHASE_END
      PHASE_BEGIN hg3_phase(p, wv); PHASE_END
    } else {
      PHASE_BEGIN LAYER_VARS EpiSgIn e{rs_mix, p.B0, p.B1, p.vpart}; gemm_phase(p.xb, w_mix_in, T_TOK, 2 * DM, DM, shm, e, wv); PHASE_END
      PHASE_BEGIN sgu_phase(p, shm, wv); PHASE_END
    }
    PHASE_BEGIN LAYER_VARS EpiRes e{p.xb, rs_cross}; gemm_phase(mix_out_A, w_mix_out, T_TOK, DM, DM, shm, e, wv); PHASE_END
    PHASE_BEGIN LAYER_VARS EpiStore e{rs_cross, p.B0, DM}; gemm_phase(p.xb, w_caq, T_TOK, DM, DM, shm, e, wv); PHASE_END
    PHASE_BEGIN cross_attn_phase(p, i, shm, wv); PHASE_END
    PHASE_BEGIN LAYER_VARS EpiRes e{p.xb, rs_ffn}; gemm_phase(p.B1, w_cao, T_TOK, DM, DM, shm, e, wv); PHASE_END
    PHASE_BEGIN LAYER_VARS EpiFfn e{rs_ffn, p.B0}; gemm_phase(p.xb, w_gu, T_TOK, 2 * DFF, DM, shm, e, wv); PHASE_END
    PHASE_BEGIN LAYER_VARS EpiRes e{p.xb, rs_next}; gemm_phase(p.B0, w_down, T_TOK, DM, DFF, shm, e, wv); PHASE_END
  }
#if MULTI_LAUNCH
  PHASE_BEGIN final_phase(p, wv); PHASE_END
#else
  { const Params p = make_params(*kargs_ptr()); final_phase(p, wv); }
#endif
}

extern "C" void kernel_launch(void* const* d_in, const int* in_sizes, int n_in, void* d_out, int out_size, void* d_ws, size_t ws_size,
                              hipStream_t stream) {
  static int grid_blocks = 0;
  if (!grid_blocks) {
    int dev = 0, cus = 0, per_cu = 0;
    hipGetDevice(&dev);
    hipDeviceGetAttribute(&cus, hipDeviceAttributeMultiprocessorCount, dev);
    if (hipFuncSetAttribute((const void*)fwd_megakernel, hipFuncAttributeMaxDynamicSharedMemorySize, LDS_BYTES) != hipSuccess)
      fprintf(stderr, "hipFuncSetAttribute failed\n");
    hipOccupancyMaxActiveBlocksPerMultiprocessor(&per_cu, (const void*)fwd_megakernel, 512, LDS_BYTES);
    if (per_cu < 1) { fprintf(stderr, "occupancy query returned %d\n", per_cu); per_cu = 1; }
    grid_blocks = cus * per_cu;
    (void)hipGetLastError();
  }
  KArgs p;
  memset(&p, 0, sizeof(p));
  const float* const* in = (const float* const*)d_in;
  p.x = in[0]; p.mem = in[1]; p.rel_bias = in[2];
  const float *norm_mix = in[3], *norm_cross = in[4], *norm_ffn = in[5];
  p.norm_mem = in[6]; p.norm_final = in[7];
  const float *da_w_in = in[8], *da_w_out = in[9];
  p.da_lq1 = in[10]; p.da_lk1 = in[11]; p.da_lq2 = in[12]; p.da_lk2 = in[13]; p.da_subln = in[14];
  const float *hg_w_in = in[15], *hg_w_out = in[16];
  p.hg_lb = in[17]; p.hg_onorm = in[18];
  const float *sg_w_in = in[19], *sg_w_out = in[20];
  p.sg_vnorm = in[21]; p.sg_w_s = in[22]; p.sg_b_s = in[23];
  const float *ca_w_q = in[24], *ca_w_kv = in[25], *ca_w_o = in[26], *ffn_w_gu = in[27], *ffn_w_down = in[28];
  p.out = (float*)d_out; p.ws = (char*)d_ws;
  if (WS_END > ws_size) { fprintf(stderr, "workspace too small: need %zu have %zu\n", (size_t)WS_END, ws_size); return; }
  int nwd = 0, tiles = 0;
  u16* wcur = (u16*)((char*)d_ws + OFF_W);
  auto addw = [&](const float* src, int K, int N, const float* gain, int perm) {
    WDesc& w = p.wd[nwd++]; w.src = src; w.dst = wcur; w.gain = gain; w.K = K; w.N = N; w.perm = perm; w.tile0 = tiles;
    tiles += (K / 64) * (N / 64); wcur += (size_t)K * N;
  };
  for (int i = 0; i < 4; ++i) {
    int kind = i % 3, j = i / 3;
    if (wcur != (u16*)((char*)d_ws + OFF_W) + layer_woff(i)) fprintf(stderr, "weight layout mismatch at layer %d\n", i);
    if (kind == 0) { addw(da_w_in + (size_t)j * DM * 3 * DM, DM, 3 * DM, norm_mix + i * DM, 0); addw(da_w_out + (size_t)j * DM * DM, DM, DM, nullptr, 0); }
    else if (kind == 1) { addw(hg_w_in + (size_t)j * DM * 4 * DM, DM, 4 * DM, norm_mix + i * DM, 0); addw(hg_w_out + (size_t)j * DM * DM, DM, DM, nullptr, 0); }
    else { addw(sg_w_in + (size_t)j * DM * 2 * DM, DM, 2 * DM, norm_mix + i * DM, 0); addw(sg_w_out + (size_t)j * DM * DM, DM, DM, nullptr, 0); }
    addw(ca_w_q + (size_t)i * DM * DM, DM, DM, norm_cross + i * DM, 0);
    addw(ca_w_kv + (size_t)i * DM * 2 * DM, DM, 2 * DM, nullptr, 0);
    addw(ca_w_o + (size_t)i * DM * DM, DM, DM, nullptr, 0);
    addw(ffn_w_gu + (size_t)i * DM * 2 * DFF, DM, 2 * DFF, norm_ffn + i * DM, 1);
    addw(ffn_w_down + (size_t)i * DFF * DM, DFF, DM, nullptr, 0);
  }
  p.nwd = nwd; p.total_wtiles = tiles;
#if MULTI_LAUNCH
  _Pragma("unroll") for (int ph = 0; ph < 64; ++ph) {
    p.phase_lo = ph; p.phase_hi = ph + 1;
    hipLaunchKernelGGL(fwd_megakernel, dim3(grid_blocks), dim3(512), LDS_BYTES, stream, p);
  }
#else
  p.phase_lo = 0; p.phase_hi = 1 << 30;
  void* args[] = {&p};
  hipError_t e = hipLaunchCooperativeKernel((void*)fwd_megakernel, dim3(grid_blocks), dim3(512), args, LDS_BYTES, stream);
  if (e != hipSuccess) fprintf(stderr, "cooperative launch failed: %s (grid %d)\n", hipGetErrorString(e), grid_blocks);
#endif
}
```

```cpp
#include <hip/hip_runtime.h>
#include <hip/hip_cooperative_groups.h>
#include <cstdio>
#include <cmath>
#include <cstring>
namespace cg = cooperative_groups;

typedef unsigned short u16;
using bf16x8 = __attribute__((ext_vector_type(8))) short;
using bf16x4 = __attribute__((ext_vector_type(4))) short;
using f32x4 = __attribute__((ext_vector_type(4))) float;
using u32x4 = __attribute__((ext_vector_type(4))) unsigned;

#ifndef MULTI_LAUNCH
#define MULTI_LAUNCH 0
#endif

constexpr int T_TOK = 32768, DM = 1024, SEQ = 8192, NB = 4, DFF = 2816, MEML = 256;
constexpr float EPS = 1e-6f;
constexpr int LDS_BYTES = 147456;
constexpr float LOG2E = 1.4426950408889634f;

typedef __attribute__((ext_vector_type(2))) float f32x2;
typedef __attribute__((ext_vector_type(2))) __bf16 bf16x2_t;
__device__ __forceinline__ unsigned pk2(float a, float b) { f32x2 v = {a, b}; bf16x2_t r = __builtin_convertvector(v, bf16x2_t); return *(unsigned*)&r; }
__device__ __forceinline__ u16 f2bf(float f) { return (u16)(pk2(f, 0.f) & 0xffffu); }
__device__ __forceinline__ float bf2f(u16 h) { return __uint_as_float(((unsigned)h) << 16); }
__device__ __forceinline__ float sigmoid_f(float x) { return __builtin_amdgcn_rcpf(1.f + __builtin_amdgcn_exp2f(-x * LOG2E)); }
__device__ __forceinline__ float silu_f(float x) { return x * sigmoid_f(x); }

__device__ __forceinline__ int opaque_tid(int wv) { unsigned ones = ~0u; asm volatile("" : "+s"(ones)); int lane = __builtin_amdgcn_mbcnt_hi(ones, __builtin_amdgcn_mbcnt_lo(ones, 0u)); int t = (wv << 6) | lane; asm volatile("" : "+v"(t)); return t; }

template <int M> __device__ __forceinline__ float sx(float v, int lane) {
  if (M < 32) return __int_as_float(__builtin_amdgcn_ds_swizzle(__float_as_int(v), (M << 10) | 0x1f));
  else return __int_as_float(__builtin_amdgcn_ds_bpermute((lane ^ M) << 2, __float_as_int(v)));
}
__device__ __forceinline__ float wave_sum(float v, int lane) {
  v += sx<1>(v, lane); v += sx<2>(v, lane); v += sx<4>(v, lane); v += sx<8>(v, lane); v += sx<16>(v, lane); v += sx<32>(v, lane); return v;
}

struct WDesc { const float* src; u16* dst; const float* gain; int K; int N; int perm; int tile0; };

struct KArgs {
  const float *x, *mem, *rel_bias, *norm_mem, *norm_final;
  const float *da_lq1, *da_lk1, *da_lq2, *da_lk2, *da_subln;
  const float *hg_lb, *hg_onorm;
  const float *sg_vnorm, *sg_w_s, *sg_b_s;
  float* out; char* ws;
  WDesc wd[28];
  int nwd; int total_wtiles;
  int phase_lo, phase_hi;
};

constexpr size_t MIB = 1u << 20;
constexpr size_t OFF_XB = 0, OFF_RPART = OFF_XB + 64 * MIB, OFF_VPART = OFF_RPART + 2 * MIB, OFF_MEMN = OFF_VPART + 2 * MIB,
                 OFF_MEMK = OFF_MEMN + 2 * MIB, OFF_MEMVT = OFF_MEMK + 8 * MIB, OFF_LBV = OFF_MEMVT + 8 * MIB, OFF_BIAS = OFF_LBV + 4096,
                 OFF_B0 = OFF_BIAS + 4096, OFF_B1 = OFF_B0 + 64 * MIB, OFF_B2 = OFF_B1 + 64 * MIB, OFF_B3 = OFF_B2 + 64 * MIB,
                 OFF_B4 = OFF_B3 + 64 * MIB, OFF_DBUF = OFF_B4 + 32 * MIB, OFF_W = OFF_DBUF + 2 * MIB, OFF_BAR = OFF_W + 130 * MIB, WS_END = OFF_BAR + 16384;
__host__ __device__ __forceinline__ long layer_woff(int i) { return i == 0 ? 0L : (i == 1 ? 17039360L : (i == 2 ? 35127296L : 51118080L)); }
__host__ __device__ __forceinline__ long mixin_elems(int i) { int kind = i % 3; return kind == 0 ? 3145728L : (kind == 1 ? 4194304L : 2097152L); }

struct Params {
  const float *x, *mem, *rel_bias, *norm_mem, *norm_final;
  const float *da_lq1, *da_lk1, *da_lq2, *da_lk2, *da_subln;
  const float *hg_lb, *hg_onorm;
  const float *sg_vnorm, *sg_w_s, *sg_b_s;
  float* out;
  u16* xb; float* rpart; float* vpart; u16* memn; u16* memK; u16* memVT; float* lbv; float* biastab;
  u16 *B0, *B1, *B2, *B3, *B4; float* dbuf; u16* wbase;
};
typedef const KArgs __attribute__((address_space(4)))* KArgsP;
__device__ __forceinline__ KArgsP kargs_ptr() {
  KArgsP kp = (KArgsP)__builtin_amdgcn_kernarg_segment_ptr();
  asm volatile("" : "+s"(kp));
  return kp;
}
template <class KA>
__device__ __forceinline__ Params make_params(const KA& k) {
  Params p;
  p.x = k.x; p.mem = k.mem; p.rel_bias = k.rel_bias; p.norm_mem = k.norm_mem; p.norm_final = k.norm_final;
  p.da_lq1 = k.da_lq1; p.da_lk1 = k.da_lk1; p.da_lq2 = k.da_lq2; p.da_lk2 = k.da_lk2; p.da_subln = k.da_subln;
  p.hg_lb = k.hg_lb; p.hg_onorm = k.hg_onorm; p.sg_vnorm = k.sg_vnorm; p.sg_w_s = k.sg_w_s; p.sg_b_s = k.sg_b_s; p.out = k.out;
  char* ws = k.ws;
  p.xb = (u16*)(ws + OFF_XB); p.rpart = (float*)(ws + OFF_RPART); p.vpart = (float*)(ws + OFF_VPART); p.memn = (u16*)(ws + OFF_MEMN);
  p.memK = (u16*)(ws + OFF_MEMK); p.memVT = (u16*)(ws + OFF_MEMVT); p.lbv = (float*)(ws + OFF_LBV); p.biastab = (float*)(ws + OFF_BIAS);
  p.B0 = (u16*)(ws + OFF_B0); p.B1 = (u16*)(ws + OFF_B1); p.B2 = (u16*)(ws + OFF_B2); p.B3 = (u16*)(ws + OFF_B3); p.B4 = (u16*)(ws + OFF_B4);
  p.dbuf = (float*)(ws + OFF_DBUF); p.wbase = (u16*)(ws + OFF_W);
  return p;
}


constexpr int BM = 256, BK = 64, HALF = 128, HT = HALF * BK;

__device__ __forceinline__ int lds_byte(int r, int c) {
  int st = (r >> 4) * 2 + (c >> 5), rr = r & 15, cc = c & 31, ob = rr * 64 + cc * 2;
  return st * 1024 + (ob ^ (((ob >> 9) & 1) << 5));
}
__device__ __forceinline__ void stage_rc(int b, int& R, int& C) {
  int st = b / 1024, sb = b % 1024, swz = sb ^ (((sb >> 9) & 1) << 5);
  R = (st >> 1) * 16 + swz / 64; C = (st & 1) * 32 + (swz % 64) / 2;
}

template <class Epi>
__device__ __forceinline__ void gemm_tile(const u16* __restrict__ A, const u16* __restrict__ Bt, int K, int brow, int bcol,
                                          char* shmc, Epi& epi, int tr0, int fc0, bool sw, bool pre, bool has_next,
                                          const u16* __restrict__ nA, const u16* __restrict__ nBt, int nbrow, int nbcol, int wv) {
  u16* shm = (u16*)shmc;
  const int tx = opaque_tid(wv);
#define SA(b, h) (shm + ((b) * 2 + (h)) * HT)
#define SB(b, h) (shm + (4 + (b) * 2 + (h)) * HT)
#define STAGE(P, BASE, br, kt) do { int _so = ((br) * K + (kt) * BK) * 2; \
    __builtin_amdgcn_raw_ptr_buffer_load_lds(rs_##BASE, (__attribute__((address_space(3))) void*)((char*)(P) + tx * 16), 16, voff0, _so, 0, 0); \
    __builtin_amdgcn_raw_ptr_buffer_load_lds(rs_##BASE, (__attribute__((address_space(3))) void*)((char*)(P) + tx * 16 + 8192), 16, voff1, _so, 0, 0); } while (0)
#define LDA(dst, b, h) _Pragma("unroll") for (int m = 0; m < 4; ++m) _Pragma("unroll") for (int k = 0; k < 2; ++k) \
    dst[m][k] = *reinterpret_cast<const bf16x8*>((char*)SA(b, h) + lds_byte(wr * 64 + m * 16 + fr, k * 32 + fq * 8))
#define LDB(dst, b, h) _Pragma("unroll") for (int n = 0; n < 2; ++n) _Pragma("unroll") for (int k = 0; k < 2; ++k) \
    dst[n][k] = *reinterpret_cast<const bf16x8*>((char*)SB(b, h) + lds_byte(wc * 32 + n * 16 + fr, k * 32 + fq * 8))
#define MMA(ai, bj, At, Bt_) do { __builtin_amdgcn_s_setprio(1); \
    _Pragma("unroll") for (int m = 0; m < 4; ++m) _Pragma("unroll") for (int n = 0; n < 2; ++n) _Pragma("unroll") for (int k = 0; k < 2; ++k) \
      acc[ai][bj][m][n] = __builtin_amdgcn_mfma_f32_16x16x32_bf16(At[m][k], Bt_[n][k], acc[ai][bj][m][n], 0, 0, 0); \
    __builtin_amdgcn_s_setprio(0); } while (0)
#define WAIT_V(n) asm volatile("s_waitcnt vmcnt(" #n ")" ::: "memory")
#define WAIT_L(n) asm volatile("s_waitcnt lgkmcnt(" #n ")" ::: "memory")
#define BAR __builtin_amdgcn_s_barrier()
#define SCHED __builtin_amdgcn_sched_barrier(0)

  int wid = tx >> 6, lane = tx & 63, wr = wid >> 2, wc = wid & 3, fr = lane & 15, fq = lane >> 4;
  f32x4 acc[2][2][4][2] = {};
  bf16x8 At[4][2], B0[2][2], B1[2][2];
  int nt = K / BK;
  int voff0, voff1;
  { int _r, _c; stage_rc(tx * 16, _r, _c); voff0 = (_r * K + _c) * 2; stage_rc(tx * 16 + 8192, _r, _c); voff1 = (_r * K + _c) * 2; }
  __amdgpu_buffer_rsrc_t rs_A = __builtin_amdgcn_make_buffer_rsrc((void*)A, 0, 0x7fffffff, 0x00020000);
  __amdgpu_buffer_rsrc_t rs_Bt = __builtin_amdgcn_make_buffer_rsrc((void*)Bt, 0, 0x7fffffff, 0x00020000);
  if (!pre) {
    STAGE(SB(0, 0), Bt, bcol, 0); STAGE(SA(0, 0), A, brow, 0);
    STAGE(SB(0, 1), Bt, bcol + HALF, 0); STAGE(SA(0, 1), A, brow + HALF, 0);
  }
  if (wr == 1) BAR;
  if (pre) { WAIT_V(0); } else { WAIT_V(4); }
  BAR;
  STAGE(SB(1, 0), Bt, bcol, 1); STAGE(SA(1, 0), A, brow, 1); STAGE(SB(1, 1), Bt, bcol + HALF, 1);
  WAIT_V(6); BAR;
  for (int t = 0; t < nt - 2; t += 2) {
    LDB(B0, 0, 0); SCHED; LDA(At, 0, 0); STAGE(SA(1, 1), A, brow + HALF, t + 1);
    WAIT_L(8); BAR; WAIT_L(0); MMA(0, 0, At, B0); BAR; SCHED;
    LDB(B1, 0, 1); STAGE(SB(0, 0), Bt, bcol, t + 2);
    BAR; WAIT_L(0); MMA(0, 1, At, B1); BAR;
    LDA(At, 0, 1); STAGE(SA(0, 0), A, brow, t + 2);
    BAR; WAIT_L(0); MMA(1, 0, At, B0); BAR; SCHED;
    STAGE(SB(0, 1), Bt, bcol + HALF, t + 2);
    WAIT_V(6); BAR; MMA(1, 1, At, B1); BAR;
    LDB(B0, 1, 0); SCHED; LDA(At, 1, 0); STAGE(SA(0, 1), A, brow + HALF, t + 2);
    WAIT_L(8); BAR; WAIT_L(0); MMA(0, 0, At, B0); BAR; SCHED;
    LDB(B1, 1, 1); STAGE(SB(1, 0), Bt, bcol, t + 3);
    BAR; WAIT_L(0); MMA(0, 1, At, B1); BAR;
    LDA(At, 1, 1); STAGE(SA(1, 0), A, brow, t + 3);
    BAR; WAIT_L(0); MMA(1, 0, At, B0); BAR; SCHED;
    STAGE(SB(1, 1), Bt, bcol + HALF, t + 3);
    WAIT_V(6); BAR; MMA(1, 1, At, B1); BAR;
  }
  { LDB(B0, 0, 0); LDA(At, 0, 0); STAGE(SA(1, 1), A, brow + HALF, nt - 1);
    BAR; WAIT_L(0); MMA(0, 0, At, B0); BAR;
    LDB(B1, 0, 1); BAR; WAIT_L(0); MMA(0, 1, At, B1); BAR;
    LDA(At, 0, 1); WAIT_V(4); BAR; WAIT_L(0); MMA(1, 0, At, B0); MMA(1, 1, At, B1); BAR; }
  { LDB(B0, 1, 0); LDA(At, 1, 0); WAIT_V(2); BAR; WAIT_L(0); MMA(0, 0, At, B0); BAR;
    LDB(B1, 1, 1); WAIT_V(0); BAR; WAIT_L(0); MMA(0, 1, At, B1); BAR;
    LDA(At, 1, 1); BAR; WAIT_L(0); MMA(1, 0, At, B0); MMA(1, 1, At, B1); BAR; }
  if (wr == 0) BAR;
  if (has_next) {
    __amdgpu_buffer_rsrc_t rs_nA = __builtin_amdgcn_make_buffer_rsrc((void*)nA, 0, 0x7fffffff, 0x00020000);
    __amdgpu_buffer_rsrc_t rs_nBt = __builtin_amdgcn_make_buffer_rsrc((void*)nBt, 0, 0x7fffffff, 0x00020000);
    STAGE(SB(0, 0), nBt, nbcol, 0); STAGE(SA(0, 0), nA, nbrow, 0);
    STAGE(SB(0, 1), nBt, nbcol + HALF, 0); STAGE(SA(0, 1), nA, nbrow + HALF, 0);
  }
  {
    const int tx2 = opaque_tid(wv); const int wid2 = tx2 >> 6, lane2 = tx2 & 63;
    epi(acc, tr0, fc0, sw, wid2 >> 2, wid2 & 3, lane2 & 15, lane2 >> 4);
  }
  __syncthreads();
#undef SA
#undef SB
#undef STAGE
#undef LDA
#undef LDB
#undef MMA
}

template <class Epi>
__device__ __forceinline__ void gemm_phase(const u16* A, const u16* Bt, int M, int N, int K, char* shm, Epi& epi, int wv) {
  int nM = M / BM, nN = N / BM;
  int G = gridDim.x, bid = blockIdx.x;
  bool xmap = ((G & 7) == 0 && (nM & 63) == 0);
  int xcd = bid & 7, slot = bid >> 3, nslots = G >> 3, gpx = nM / 64;
  int first = xmap ? slot : bid, step = xmap ? nslots : G, total = xmap ? gpx * 8 * nN : nM * nN;
  auto coords = [&](int L, int& tr0, int& fc0) {
    if (xmap) { int grp = xcd * gpx + L / (8 * nN), within = L % (8 * nN); tr0 = (grp * 8 + (within & 7)) * BM; fc0 = (within >> 3) * BM; }
    else { tr0 = (L % nM) * BM; fc0 = (L / nM) * BM; }
  };
  bool pre = false;
  for (int L = first; L < total; L += step) {
    int tr0, fc0, ntr0 = 0, nfc0 = 0;
    coords(L, tr0, fc0);
    bool hn = (L + step) < total;
    if (hn) coords(L + step, ntr0, nfc0);
    bool sw = epi.swap(fc0), nsw = epi.swap(nfc0);
    gemm_tile(sw ? Bt : A, sw ? A : Bt, K, sw ? fc0 : tr0, sw ? tr0 : fc0, shm, epi, tr0, fc0, sw, pre, hn,
              nsw ? Bt : A, nsw ? A : Bt, nsw ? nfc0 : ntr0, nsw ? ntr0 : nfc0, wv);
    pre = hn;
  }
}

__device__ __forceinline__ float row_rs(const float* part, int row) {
  const float4* q = (const float4*)(part + (long)row * 8);
  float4 a = q[0], b = q[1];
  float s = ((a.x + a.y) + (a.z + a.w)) + ((b.x + b.y) + (b.z + b.w));
  return rsqrtf(s * (1.f / DM) + EPS);
}
__device__ __forceinline__ float row_rs16(const float* part, int row) {
  const float4* q = (const float4*)(part + (long)row * 16);
  float4 a = q[0], b = q[1], c = q[2], d = q[3];
  float s = ((a.x + a.y) + (a.z + a.w)) + ((b.x + b.y) + (b.z + b.w)) + ((c.x + c.y) + (c.z + c.w)) + ((d.x + d.y) + (d.z + d.w));
  return rsqrtf(s * (1.f / DM) + EPS);
}
#define EPI_ARGS f32x4 (&acc)[2][2][4][2], int tr0, int fc0, bool sw, int wr, int wc, int fr, int fq
#define S_FEAT(ai, m) (fc0 + (ai) * 128 + wr * 64 + (m) * 16 + fq * 4)
#define S_TOK(bj, n) (tr0 + (bj) * 128 + wc * 32 + (n) * 16 + fr)
#define U_TOK(ai, m) (tr0 + (ai) * 128 + wr * 64 + (m) * 16 + fq * 4)
#define U_FEAT(bj, n) (fc0 + (bj) * 128 + wc * 32 + (n) * 16 + fr)

__device__ __forceinline__ uint2 pack4(float a, float b, float c, float d) { uint2 r; r.x = pk2(a, b); r.y = pk2(c, d); return r; }

struct EpiRes {
  u16* xb; float* part;
  __device__ __forceinline__ bool swap(int) const { return true; }
  __device__ __forceinline__ void operator()(EPI_ARGS) {
    _Pragma("unroll") for (int bj = 0; bj < 2; ++bj) _Pragma("unroll") for (int n = 0; n < 2; ++n) {
      int t = S_TOK(bj, n); float ss = 0.f;
      u16* xbp = xb + (long)t * DM;
      _Pragma("unroll") for (int ai = 0; ai < 2; ++ai) _Pragma("unroll") for (int m = 0; m < 4; ++m) {
        int f = S_FEAT(ai, m); f32x4 a = acc[ai][bj][m][n];
        uint2 xv = *(const uint2*)(xbp + f);
        float v0 = __uint_as_float(xv.x << 16) + a[0], v1 = __uint_as_float(xv.x & 0xffff0000u) + a[1];
        float v2 = __uint_as_float(xv.y << 16) + a[2], v3 = __uint_as_float(xv.y & 0xffff0000u) + a[3];
        *(uint2*)(xbp + f) = pack4(v0, v1, v2, v3);
        ss += v0 * v0 + v1 * v1 + v2 * v2 + v3 * v3;
      }
      ss += sx<16>(ss, fq * 16 + fr); ss += sx<32>(ss, fq * 16 + fr);
      if (fq == 0) part[(long)t * 8 + (fc0 >> 8) * 2 + wr] = ss;
    }
  }
};

struct EpiDaIn {
  const float* rowss; u16 *q, *k, *vT;
  __device__ __forceinline__ bool swap(int fc0) const { return (fc0 >> 10) < 2; }
  __device__ __forceinline__ void operator()(EPI_ARGS) {
    int sect = fc0 >> 10, cb = fc0 & 1023;
    if (sw) {
      u16* dst = sect ? k : q;
      _Pragma("unroll") for (int bj = 0; bj < 2; ++bj) _Pragma("unroll") for (int n = 0; n < 2; ++n) {
        int t = S_TOK(bj, n); float rs = row_rs(rowss, t); u16* d = dst + (long)t * DM + (cb - fc0);
        _Pragma("unroll") for (int ai = 0; ai < 2; ++ai) _Pragma("unroll") for (int m = 0; m < 4; ++m) {
          f32x4 a = acc[ai][bj][m][n]; *(uint2*)(d + S_FEAT(ai, m)) = pack4(a[0] * rs, a[1] * rs, a[2] * rs, a[3] * rs);
        }
      }
    } else {
      _Pragma("unroll") for (int ai = 0; ai < 2; ++ai) _Pragma("unroll") for (int m = 0; m < 4; ++m) {
        int r0 = U_TOK(ai, m); float rs[4];
        _Pragma("unroll") for (int j = 0; j < 4; ++j) rs[j] = row_rs(rowss, r0 + j);
        int b = r0 / SEQ, s0 = r0 % SEQ;
        _Pragma("unroll") for (int bj = 0; bj < 2; ++bj) _Pragma("unroll") for (int n = 0; n < 2; ++n) {
          int c = U_FEAT(bj, n) - fc0 + cb; f32x4 a = acc[ai][bj][m][n];
          *(uint2*)&vT[((long)(b * DM + c)) * SEQ + s0] = pack4(a[0] * rs[0], a[1] * rs[1], a[2] * rs[2], a[3] * rs[3]);
        }
        __builtin_amdgcn_sched_barrier(0);
      }
    }
  }
};

struct EpiHgIn {
  const float* rowss; const float* lbv; u16 *q, *logf_, *iT, *g;
  __device__ __forceinline__ bool swap(int fc0) const { return (fc0 >> 10) != 2; }
  __device__ __forceinline__ void operator()(EPI_ARGS) {
    int sect = fc0 >> 10, cb = fc0 & 1023;
    if (sw) {
      u16* dst = q + (long)sect * (32L << 20);
      _Pragma("unroll") for (int bj = 0; bj < 2; ++bj) _Pragma("unroll") for (int n = 0; n < 2; ++n) {
        int t = S_TOK(bj, n); float rs = row_rs(rowss, t); u16* d = dst + (long)t * DM + (cb - fc0);
        _Pragma("unroll") for (int ai = 0; ai < 2; ++ai) _Pragma("unroll") for (int m = 0; m < 4; ++m) {
          int f = S_FEAT(ai, m); f32x4 a = acc[ai][bj][m][n]; float v[4];
          if (sect == 0) { _Pragma("unroll") for (int j = 0; j < 4; ++j) v[j] = silu_f(a[j] * rs); }
          else if (sect == 1) {
            float4 lb = *(const float4*)&lbv[f - fc0 + cb]; float lbs[4] = {lb.x, lb.y, lb.z, lb.w};
            _Pragma("unroll") for (int j = 0; j < 4; ++j) v[j] = __logf(lbs[j] + (1.f - lbs[j]) * sigmoid_f(a[j] * rs));
          } else { _Pragma("unroll") for (int j = 0; j < 4; ++j) v[j] = a[j] * rs; }
          *(uint2*)(d + f) = pack4(v[0], v[1], v[2], v[3]);
        }
      }
    } else {
      _Pragma("unroll") for (int ai = 0; ai < 2; ++ai) _Pragma("unroll") for (int m = 0; m < 4; ++m) {
        int r0 = U_TOK(ai, m); float rs[4];
        _Pragma("unroll") for (int j = 0; j < 4; ++j) rs[j] = row_rs(rowss, r0 + j);
        _Pragma("unroll") for (int bj = 0; bj < 2; ++bj) _Pragma("unroll") for (int n = 0; n < 2; ++n) {
          int c = U_FEAT(bj, n) - fc0 + cb; f32x4 a = acc[ai][bj][m][n];
          *(uint2*)&iT[((long)(r0 >> 6) * DM + c) * 64 + (r0 & 63)] = pack4(a[0] * rs[0], a[1] * rs[1], a[2] * rs[2], a[3] * rs[3]);
        }
        __builtin_amdgcn_sched_barrier(0);
      }
    }
  }
};

__device__ __forceinline__ float gelu_f(float x) { return 0.5f * x * (1.f + erff(x * 0.70710678118654752f)); }

struct EpiSgIn {
  const float* rowss; u16 *u, *vT; float* rowss_v;
  __device__ __forceinline__ bool swap(int fc0) const { return (fc0 >> 10) == 0; }
  __device__ __forceinline__ void operator()(EPI_ARGS) {
    int cb = fc0 & 1023;
    if (sw) {
      _Pragma("unroll") for (int bj = 0; bj < 2; ++bj) _Pragma("unroll") for (int n = 0; n < 2; ++n) {
        int t = S_TOK(bj, n); float rs = row_rs(rowss, t); u16* d = u + (long)t * DM;
        _Pragma("unroll") for (int ai = 0; ai < 2; ++ai) _Pragma("unroll") for (int m = 0; m < 4; ++m) {
          f32x4 a = acc[ai][bj][m][n];
          *(uint2*)(d + S_FEAT(ai, m)) = pack4(gelu_f(a[0] * rs), gelu_f(a[1] * rs), gelu_f(a[2] * rs), gelu_f(a[3] * rs));
        }
      }
    } else {
      _Pragma("unroll") for (int ai = 0; ai < 2; ++ai) _Pragma("unroll") for (int m = 0; m < 4; ++m) {
        int r0 = U_TOK(ai, m); float rs[4], ss[4] = {0.f, 0.f, 0.f, 0.f};
        _Pragma("unroll") for (int j = 0; j < 4; ++j) rs[j] = row_rs(rowss, r0 + j);
        _Pragma("unroll") for (int bj = 0; bj < 2; ++bj) _Pragma("unroll") for (int n = 0; n < 2; ++n) {
          int c = U_FEAT(bj, n) - fc0 + cb; f32x4 a = acc[ai][bj][m][n];
          float gv[4]; _Pragma("unroll") for (int j = 0; j < 4; ++j) gv[j] = gelu_f(a[j] * rs[j]);
          *(uint2*)&vT[((long)(r0 >> 7) * DM + c) * 128 + (r0 & 127)] = pack4(gv[0], gv[1], gv[2], gv[3]);
          _Pragma("unroll") for (int j = 0; j < 4; ++j) ss[j] += gv[j] * gv[j];
        }
        _Pragma("unroll") for (int j = 0; j < 4; ++j) {
          float s = ss[j]; s += sx<1>(s, 0); s += sx<2>(s, 0); s += sx<4>(s, 0); s += sx<8>(s, 0);
          if (fr == 0) rowss_v[(long)(r0 + j) * 16 + (cb >> 8) * 4 + wc] = s;
        }
        __builtin_amdgcn_sched_barrier(0);
      }
    }
  }
};

struct EpiStore {
  const float* rowss; u16* dst; int ld;
  __device__ __forceinline__ bool swap(int) const { return true; }
  __device__ __forceinline__ void operator()(EPI_ARGS) {
    _Pragma("unroll") for (int bj = 0; bj < 2; ++bj) _Pragma("unroll") for (int n = 0; n < 2; ++n) {
      int t = S_TOK(bj, n); float rs = rowss ? row_rs(rowss, t) : 1.f; u16* d = dst + (long)t * ld;
      _Pragma("unroll") for (int ai = 0; ai < 2; ++ai) _Pragma("unroll") for (int m = 0; m < 4; ++m) {
        f32x4 a = acc[ai][bj][m][n]; *(uint2*)(d + S_FEAT(ai, m)) = pack4(a[0] * rs, a[1] * rs, a[2] * rs, a[3] * rs);
      }
    }
  }
};

struct EpiFfn {
  const float* rowss; u16* act;
  __device__ __forceinline__ bool swap(int) const { return true; }
  __device__ __forceinline__ void operator()(EPI_ARGS) {
    int tile = fc0 >> 8;
    _Pragma("unroll") for (int bj = 0; bj < 2; ++bj) _Pragma("unroll") for (int n = 0; n < 2; ++n) {
      int t = S_TOK(bj, n); float rs = row_rs(rowss, t); u16* d = act + (long)t * DFF + tile * 128 + wr * 64 + fq * 4;
      _Pragma("unroll") for (int m = 0; m < 4; ++m) {
        f32x4 g = acc[0][bj][m][n], u = acc[1][bj][m][n]; float v[4];
        _Pragma("unroll") for (int j = 0; j < 4; ++j) v[j] = silu_f(g[j] * rs) * (u[j] * rs);
        *(uint2*)(d + m * 16) = pack4(v[0], v[1], v[2], v[3]);
      }
    }
  }
};

struct EpiMemKV {
  u16 *K, *VT;
  __device__ __forceinline__ bool swap(int fc0) const { return (fc0 >> 10) == 0; }
  __device__ __forceinline__ void operator()(EPI_ARGS) {
    int cb = fc0 & 1023;
    if (sw) {
      _Pragma("unroll") for (int bj = 0; bj < 2; ++bj) _Pragma("unroll") for (int n = 0; n < 2; ++n) {
        int t = S_TOK(bj, n); u16* d = K + (long)t * DM;
        _Pragma("unroll") for (int ai = 0; ai < 2; ++ai) _Pragma("unroll") for (int m = 0; m < 4; ++m) {
          f32x4 a = acc[ai][bj][m][n]; *(uint2*)(d + S_FEAT(ai, m)) = pack4(a[0], a[1], a[2], a[3]);
        }
      }
    } else {
      _Pragma("unroll") for (int ai = 0; ai < 2; ++ai) _Pragma("unroll") for (int m = 0; m < 4; ++m) {
        int r0 = U_TOK(ai, m);
        _Pragma("unroll") for (int bj = 0; bj < 2; ++bj) _Pragma("unroll") for (int n = 0; n < 2; ++n) {
          int c = U_FEAT(bj, n) - fc0 + cb; f32x4 a = acc[ai][bj][m][n];
          *(uint2*)&VT[((long)((r0 >> 8) * DM + c)) * MEML + (r0 & 255)] = pack4(a[0], a[1], a[2], a[3]);
        }
      }
    }
  }
};

__device__ __forceinline__ void prep_phase(const Params& p, KArgsP kap, char* shm, int wv) {
  int tid = opaque_tid(wv), bid = blockIdx.x, G = gridDim.x;
  int lane = tid & 63, wid = tid >> 6;
  for (int row = bid * 8 + wid; row < T_TOK; row += G * 8) {
    const float4* src = (const float4*)(p.x + (long)row * DM);
    float ss = 0.f;
    _Pragma("unroll") for (int i = 0; i < 4; ++i) {
      float4 v = src[i * 64 + lane];
      ss += v.x * v.x + v.y * v.y + v.z * v.z + v.w * v.w;
      *(uint2*)&p.xb[(long)row * DM + (i * 64 + lane) * 4] = pack4(v.x, v.y, v.z, v.w);
    }
    ss = wave_sum(ss, lane);
    if (lane < 8) p.rpart[(long)row * 8 + lane] = (lane == 0) ? ss : 0.f;
  }
  for (int row = bid * 8 + wid; row < NB * MEML; row += G * 8) {
    const float4* src = (const float4*)(p.mem + (long)row * DM);
    float4 v[4]; float ss = 0.f;
    _Pragma("unroll") for (int i = 0; i < 4; ++i) { v[i] = src[i * 64 + lane]; ss += v[i].x * v[i].x + v[i].y * v[i].y + v[i].z * v[i].z + v[i].w * v[i].w; }
    ss = wave_sum(ss, lane);
    float rs = rsqrtf(ss * (1.f / DM) + EPS);
    _Pragma("unroll") for (int i = 0; i < 4; ++i) {
      float4 g = ((const float4*)p.norm_mem)[i * 64 + lane];
      *(uint2*)&p.memn[(long)row * DM + (i * 64 + lane) * 4] = pack4(v[i].x * rs * g.x, v[i].y * rs * g.y, v[i].z * rs * g.z, v[i].w * rs * g.w);
    }
  }
  if (bid == 0) {
    for (int i = tid; i < 3456; i += 512) ((unsigned*)((char*)p.xb - OFF_XB + OFF_BAR))[i] = 0u;
    for (int c = tid; c < DM; c += 512) {
      float v0 = p.hg_lb[c], v1 = p.hg_lb[DM + c], v2 = p.hg_lb[2 * DM + c], v3 = p.hg_lb[3 * DM + c];
      float mx = fmaxf(fmaxf(v0, v1), fmaxf(v2, v3));
      float e0 = expf(v0 - mx), e1 = expf(v1 - mx), e2 = expf(v2 - mx), e3 = expf(v3 - mx);
      p.lbv[c] = e1 / (e0 + e1 + e2 + e3);
    }
    for (int i = tid; i < 8 * 128; i += 512) {
      int h = i >> 7, n = i & 127, bucket;
      if (n < 16) bucket = n;
      else { float nf = (float)n; int lg = 16 + (int)(logf(nf / 16.f) / 2.0794415416798357f * 16.f); bucket = lg < 31 ? lg : 31; }
      p.biastab[i] = p.rel_bias[h * 32 + bucket] * LOG2E;
    }
  }
  float* tl = (float*)shm;
  for (int t = bid; t < kap->total_wtiles; t += G) {
    int wi = 0;
    while (wi + 1 < kap->nwd && kap->wd[wi + 1].tile0 <= t) ++wi;
    const float* src = kap->wd[wi].src; u16* dst = kap->wd[wi].dst; const float* gain = kap->wd[wi].gain;
    int K = kap->wd[wi].K, N = kap->wd[wi].N, perm = kap->wd[wi].perm;
    int lt = t - kap->wd[wi].tile0, nNt = N >> 6;
    int k0 = (lt / nNt) * 64, n0 = (lt % nNt) * 64;
    {
      int kk = tid >> 3, seg = (tid & 7) * 8;
      const float4* s4 = (const float4*)(src + (long)(k0 + kk) * N + n0 + seg);
      float4 a = s4[0], b = s4[1]; float g = gain ? gain[k0 + kk] : 1.f;
      float* d = tl + kk * 65 + seg;
      d[0] = a.x * g; d[1] = a.y * g; d[2] = a.z * g; d[3] = a.w * g; d[4] = b.x * g; d[5] = b.y * g; d[6] = b.z * g; d[7] = b.w * g;
    }
    __syncthreads();
    {
      int nn = tid >> 3, seg = (tid & 7) * 8;
      int n = n0 + nn, drow = n;
      if (perm) { int part = n / DFF, idx = n % DFF; drow = (idx >> 7) * 256 + part * 128 + (idx & 127); }
      float v[8]; _Pragma("unroll") for (int i = 0; i < 8; ++i) v[i] = tl[(seg + i) * 65 + nn];
      uint4 o; uint2 lo = pack4(v[0], v[1], v[2], v[3]), hi = pack4(v[4], v[5], v[6], v[7]);
      o.x = lo.x; o.y = lo.y; o.z = hi.x; o.w = hi.y;
      *(uint4*)&dst[(long)drow * K + k0 + seg] = o;
    }
    __syncthreads();
  }
}

template <int NC, int DQK, int DV, bool CAUSAL, bool PF>
__device__ __forceinline__ void flash_item(const u16* __restrict__ Qg, int q_stride, const u16* __restrict__ Kg, int k_stride,
                                           const u16* __restrict__ VTg, int vt_stride, int nkt, int q0, float scale_log2,
                                           const float* btab, float lam, const float* subln_g, float outscale,
                                           u16* __restrict__ Og, int o_stride, char* shm, int wv) {
  constexpr int KW = NC * DQK, KLD = KW + 8, VLD = 72;
  constexpr int KBUF = 64 * KLD, VBUF = DV * VLD;
  constexpr int KCH = KW / 8, KPT = 64 * KCH / 512, VPT = DV * 8 / 512;
  constexpr int NKS = DQK / 32, NVT = DV / 16;
  u16* Ks = (u16*)shm; u16* Vs = Ks + 2 * KBUF;
  int tid = opaque_tid(wv), wid = tid >> 6, lane = tid & 63, fr = lane & 15, fq = lane >> 4;
  int qw0 = q0 + wid * 16, qpos = qw0 + fr;

  bf16x8 qf[NC][NKS];
  _Pragma("unroll") for (int c = 0; c < NC; ++c) _Pragma("unroll") for (int ks = 0; ks < NKS; ++ks)
    qf[c][ks] = *(const bf16x8*)&Qg[(long)(wid * 16 + fr) * q_stride + c * DQK + ks * 32 + fq * 8];
  f32x4 O[NC][NVT];
  _Pragma("unroll") for (int c = 0; c < NC; ++c) _Pragma("unroll") for (int v = 0; v < NVT; ++v) O[c][v] = f32x4{0.f, 0.f, 0.f, 0.f};
  float mrun[NC], lsum[NC];
  _Pragma("unroll") for (int c = 0; c < NC; ++c) { mrun[c] = -1e30f; lsum[c] = 0.f; }

  u32x4 kreg[KPT], vreg[VPT];
#define FA_PREFETCH(kt_) do { int k0_ = (kt_) * 64; \
    _Pragma("unroll") for (int i = 0; i < KPT; ++i) { int id = tid + i * 512, row = id / KCH, cc = id % KCH; kreg[i] = *(const u32x4*)&Kg[(long)(k0_ + row) * k_stride + cc * 8]; } \
    _Pragma("unroll") for (int i = 0; i < VPT; ++i) { int id = tid + i * 512, row = id >> 3, cc = id & 7; vreg[i] = *(const u32x4*)&VTg[(long)row * vt_stride + k0_ + cc * 8]; } } while (0)
  if (PF) FA_PREFETCH(0);
  for (int kt = 0; kt < nkt; ++kt) {
    if (!PF) FA_PREFETCH(kt);
    u16* Kb = Ks + (kt & 1) * KBUF; u16* Vb = Vs + (kt & 1) * VBUF;
    _Pragma("unroll") for (int i = 0; i < KPT; ++i) { int id = tid + i * 512, row = id / KCH, cc = id % KCH; *(u32x4*)&Kb[row * KLD + cc * 8] = kreg[i]; }
    _Pragma("unroll") for (int i = 0; i < VPT; ++i) {
      int id = tid + i * 512, row = id >> 3, cc = id & 7;
      int pos = 32 * (cc >> 2) + 16 * (cc & 1) + 4 * ((cc >> 1) & 1);
      uint2 lo2, hi2; lo2.x = vreg[i][0]; lo2.y = vreg[i][1]; hi2.x = vreg[i][2]; hi2.y = vreg[i][3];
      *(uint2*)&Vb[row * VLD + pos] = lo2; *(uint2*)&Vb[row * VLD + pos + 8] = hi2;
    }
    __syncthreads();
    if (PF && kt + 1 < nkt) FA_PREFETCH(kt + 1);
    int k0 = kt * 64;
    if (CAUSAL && k0 > qw0 + 15) continue;
    bf16x8 pf[NC][2];
    bool general = false; float bb = 0.f;
    if (CAUSAL) { general = (qw0 - (k0 + 63)) < 113; bb = btab[127]; }
    f32x4 bv[4];
    if (general) {
      bool diag = (k0 + 63) > qw0;
      _Pragma("unroll") for (int m = 0; m < 4; ++m) _Pragma("unroll") for (int j = 0; j < 4; ++j) {
        int dist = qpos - (k0 + 16 * m + fq * 4 + j);
        int di = dist < 0 ? 0 : (dist > 127 ? 127 : dist);
        float b = btab[di];
        bv[m][j] = (diag && dist < 0) ? -1e30f : b;
      }
    }
    _Pragma("unroll") for (int c = 0; c < NC; ++c) {
      f32x4 s[4];
      _Pragma("unroll") for (int m = 0; m < 4; ++m) s[m] = f32x4{0.f, 0.f, 0.f, 0.f};
      _Pragma("unroll") for (int ks = 0; ks < NKS; ++ks) _Pragma("unroll") for (int m = 0; m < 4; ++m) {
        bf16x8 a = *(const bf16x8*)&Kb[(16 * m + fr) * KLD + c * DQK + ks * 32 + fq * 8];
        s[m] = __builtin_amdgcn_mfma_f32_16x16x32_bf16(a, qf[c][ks], s[m], 0, 0, 0);
      }
      constexpr float THR = 8.f;
      float tnew, psum = 0.f;
      if (general) {
        float tmax = -1e30f;
        _Pragma("unroll") for (int m = 0; m < 4; ++m) _Pragma("unroll") for (int j = 0; j < 4; ++j) {
          float v = s[m][j] * scale_log2 + bv[m][j];
          s[m][j] = v; tmax = fmaxf(tmax, v);
        }
        tnew = tmax;
      } else {
        float rmax = fmaxf(fmaxf(s[0][0], s[0][1]), fmaxf(s[0][2], s[0][3]));
        _Pragma("unroll") for (int m = 1; m < 4; ++m) rmax = fmaxf(rmax, fmaxf(fmaxf(s[m][0], s[m][1]), fmaxf(s[m][2], s[m][3])));
        tnew = rmax * scale_log2 + bb;
      }
      if (__builtin_amdgcn_ballot_w64(tnew - mrun[c] > THR) != 0ull) {
        tnew = fmaxf(tnew, sx<16>(tnew, lane)); tnew = fmaxf(tnew, sx<32>(tnew, lane));
        float mnew = fmaxf(mrun[c], tnew);
        float alpha = __builtin_amdgcn_exp2f(mrun[c] - mnew);
        mrun[c] = mnew; lsum[c] *= alpha;
        _Pragma("unroll") for (int v = 0; v < NVT; ++v) _Pragma("unroll") for (int j = 0; j < 4; ++j) O[c][v][j] *= alpha;
      }
      if (general) {
        float mm = mrun[c];
        _Pragma("unroll") for (int m = 0; m < 4; ++m) _Pragma("unroll") for (int j = 0; j < 4; ++j) { float pv = __builtin_amdgcn_exp2f(s[m][j] - mm); s[m][j] = pv; psum += pv; }
      } else {
        float cc = bb - mrun[c];
        _Pragma("unroll") for (int m = 0; m < 4; ++m) _Pragma("unroll") for (int j = 0; j < 4; ++j) { float pv = __builtin_amdgcn_exp2f(s[m][j] * scale_log2 + cc); s[m][j] = pv; psum += pv; }
      }
      lsum[c] += psum;
      _Pragma("unroll") for (int k2 = 0; k2 < 2; ++k2) {
        uint2 lo = pack4(s[2 * k2][0], s[2 * k2][1], s[2 * k2][2], s[2 * k2][3]);
        uint2 hi = pack4(s[2 * k2 + 1][0], s[2 * k2 + 1][1], s[2 * k2 + 1][2], s[2 * k2 + 1][3]);
        uint4 pk; pk.x = lo.x; pk.y = lo.y; pk.z = hi.x; pk.w = hi.y;
        pf[c][k2] = *(bf16x8*)&pk;
      }
    }
    _Pragma("unroll") for (int k2 = 0; k2 < 2; ++k2) _Pragma("unroll") for (int v = 0; v < NVT; ++v) {
      bf16x8 a = *(const bf16x8*)&Vb[(16 * v + fr) * VLD + 32 * k2 + fq * 8];
      _Pragma("unroll") for (int c = 0; c < NC; ++c) O[c][v] = __builtin_amdgcn_mfma_f32_16x16x32_bf16(a, pf[c][k2], O[c][v], 0, 0, 0);
      if ((v & 3) == 3) __builtin_amdgcn_sched_barrier(0);
    }
  }
  float inv[NC];
  _Pragma("unroll") for (int c = 0; c < NC; ++c) { float l = lsum[c]; l += sx<16>(l, lane); l += sx<32>(l, lane); inv[c] = 1.f / l; }
  u16* orow = Og + (long)(wid * 16 + fr) * o_stride;
  if (NC == 2) {
    float ss = 0.f;
    _Pragma("unroll") for (int v = 0; v < NVT; ++v) _Pragma("unroll") for (int j = 0; j < 4; ++j) { float o = O[0][v][j] * inv[0] - lam * O[NC - 1][v][j] * inv[NC - 1]; O[0][v][j] = o; ss += o * o; }
    ss += sx<16>(ss, lane); ss += sx<32>(ss, lane);
    float rs = rsqrtf(ss * (1.f / DV) + EPS) * outscale;
    _Pragma("unroll") for (int v = 0; v < NVT; ++v) {
      float4 g = *(const float4*)&subln_g[16 * v + fq * 4];
      *(uint2*)&orow[16 * v + fq * 4] = pack4(O[0][v][0] * rs * g.x, O[0][v][1] * rs * g.y, O[0][v][2] * rs * g.z, O[0][v][3] * rs * g.w);
    }
  } else {
    _Pragma("unroll") for (int v = 0; v < NVT; ++v)
      *(uint2*)&orow[16 * v + fq * 4] = pack4(O[0][v][0] * inv[0], O[0][v][1] * inv[0], O[0][v][2] * inv[0], O[0][v][3] * inv[0]);
  }
}

__device__ __forceinline__ void diff_attn_phase(const Params& p, int j, int layer_idx, char* shm, int wv) {
  int tid = opaque_tid(wv), lane = tid & 63;
  float* btab = (float*)(shm + LDS_BYTES - 1024);
  float sa = p.da_lq1[j * 64 + lane] * p.da_lk1[j * 64 + lane], sb = p.da_lq2[j * 64 + lane] * p.da_lk2[j * 64 + lane];
  sa = wave_sum(sa, lane); sb = wave_sum(sb, lane);
  float lam_init = 0.8f - 0.6f * expf(-0.3f * (float)layer_idx);
  float lam = expf(sa) - expf(sb) + lam_init;
  const u16 *qb = p.B0, *kb = p.B1, *vT = p.B2; u16* ao = p.B3;
  for (int i = blockIdx.x; i < 2048; i += gridDim.x) {
    int wgl = i & 255, step = i >> 8, xcd = wgl & 7, slot = wgl >> 3;
    int bh = xcd + 8 * (step >> 1), qblk = (step & 1) ? 63 - slot : slot;
    int b = bh >> 3, h = bh & 7, q0 = qblk * 128;
    __syncthreads();
    if (tid < 128) btab[tid] = p.biastab[h * 128 + tid];
    flash_item<2, 64, 128, true, true>(qb + ((long)(b * SEQ + q0)) * DM + h * 128, DM, kb + ((long)b * SEQ) * DM + h * 128, DM,
                                 vT + ((long)(b * DM + h * 128)) * SEQ, SEQ, q0 / 64 + 2, q0, 0.125f * LOG2E, btab, lam,
                                 p.da_subln + j * 128, 1.f - lam_init, ao + ((long)(b * SEQ + q0)) * DM + h * 128, DM, shm, wv);
  }
}

__device__ __forceinline__ void cross_attn_phase(const Params& p, int layer, char* shm, int wv) {
  const u16* caq = p.B0; u16* cao = p.B1;
  const u16* mK = p.memK + (long)layer * NB * MEML * DM; const u16* mVT = p.memVT + (long)layer * NB * DM * MEML;
  for (int i = blockIdx.x; i < 1024; i += gridDim.x) {
    int head = i & 3, blk = i >> 2, b = blk >> 6, qblk = blk & 63;
    __syncthreads();
    flash_item<1, 256, 256, false, true>(caq + ((long)(b * SEQ + qblk * 128)) * DM + head * 256, DM, mK + ((long)b * MEML) * DM + head * 256, DM,
                                   mVT + ((long)(b * DM + head * 256)) * MEML, MEML, 4, 0, 0.0625f * LOG2E, nullptr, 0.f, nullptr, 1.f,
                                   cao + ((long)(b * SEQ + qblk * 128)) * DM + head * 256, DM, shm, wv);
  }
}

constexpr int HLD = 132;
__device__ __forceinline__ long kdt_off(int tok0, int h, int k) {
  return ((long)(tok0 + (k >> 1)) * DM + h * 128) + (k & 1) * 64;
}

__device__ __forceinline__ void hg1_phase(const Params& p, char* shm, int wv) {
  float* L = (float*)shm; float* Gs = L + 64 * HLD; float* Qs = Gs + 64 * HLD; float* R = Qs + 64 * HLD;
  int tid = opaque_tid(wv), wid = tid >> 6, lane = tid & 63, fr = lane & 15, fq = lane >> 4;
  u16* qbuf = p.B0; u16* lfbuf = p.B1; u16* Abuf = p.B4;
  u32x4 plv[2], pqv[2];
#define HG1_PREFETCH(it_) do { int h_ = (it_) & 7, cn_ = ((it_) >> 3) & 127, b_ = (it_) >> 10, tk_ = b_ * SEQ + cn_ * 64; \
    _Pragma("unroll") for (int i = 0; i < 2; ++i) { int id = tid + i * 512, row = id >> 4, cc = id & 15; \
      plv[i] = *(const u32x4*)&lfbuf[(long)(tk_ + row) * DM + h_ * 128 + cc * 8]; pqv[i] = *(const u32x4*)&qbuf[(long)(tk_ + row) * DM + h_ * 128 + cc * 8]; } } while (0)
  if ((int)blockIdx.x < 4096) HG1_PREFETCH((int)blockIdx.x);
  for (int it = blockIdx.x; it < 4096; it += gridDim.x) {
    int h = it & 7, cn = (it >> 3) & 127, b = it >> 10, tok0 = b * SEQ + cn * 64;
    __syncthreads();
    _Pragma("unroll") for (int i = 0; i < 2; ++i) {
      int id = tid + i * 512, row = id >> 4, cc = id & 15;
      _Pragma("unroll") for (int e = 0; e < 4; ++e) {
        unsigned lw = plv[i][e], qw = pqv[i][e];
        L[row * HLD + cc * 8 + 2 * e] = __uint_as_float(lw << 16); L[row * HLD + cc * 8 + 2 * e + 1] = __uint_as_float(lw & 0xffff0000u);
        Qs[row * HLD + cc * 8 + 2 * e] = __uint_as_float(qw << 16); Qs[row * HLD + cc * 8 + 2 * e + 1] = __uint_as_float(qw & 0xffff0000u);
      }
    }
    __syncthreads();
    if (it + (int)gridDim.x < 4096) HG1_PREFETCH(it + (int)gridDim.x);
    {
      int k = tid & 127, qd = tid >> 7; float run = 0.f;
      _Pragma("unroll") for (int i = 0; i < 16; ++i) { run += L[(16 * qd + i) * HLD + k]; Gs[(16 * qd + i) * HLD + k] = run; }
      R[(qd + 1) * 128 + k] = run;
    }
    __syncthreads();
    {
      int k = tid & 127, qd = tid >> 7; float r = 0.f;
      for (int i = 0; i < qd; ++i) r += R[(i + 1) * 128 + k];
      float tot = R[(qd + 1) * 128 + k];
      __syncthreads();
      _Pragma("unroll") for (int i = 0; i < 16; ++i) Gs[(16 * qd + i) * HLD + k] += r;
      R[qd * 128 + k] = r;
      if (qd == 3) R[4 * 128 + k] = r + tot;
    }
    __syncthreads();
    _Pragma("unroll") for (int i = 0; i < 2; ++i) {
      int id = tid + i * 512, row = id >> 4, cc = id & 15; float v[8];
      _Pragma("unroll") for (int e = 0; e < 8; ++e) v[e] = Qs[row * HLD + cc * 8 + e] * __expf(Gs[row * HLD + cc * 8 + e]);
      uint2 lo = pack4(v[0], v[1], v[2], v[3]), hi = pack4(v[4], v[5], v[6], v[7]);
      uint4 o; o.x = lo.x; o.y = lo.y; o.z = hi.x; o.w = hi.y;
      *(uint4*)&qbuf[(long)(tok0 + row) * DM + h * 128 + cc * 8] = o;
    }
    _Pragma("unroll") for (int i = 0; i < 2; ++i) {
      int id = tid + i * 512, k = id & 127, sc = id >> 7; float gl = R[4 * 128 + k]; float v[8];
      _Pragma("unroll") for (int e = 0; e < 8; ++e) { int s = sc * 8 + e; v[e] = (1.f - __expf(L[s * HLD + k])) * __expf(gl - Gs[s * HLD + k]); }
      uint2 lo = pack4(v[0], v[1], v[2], v[3]), hi = pack4(v[4], v[5], v[6], v[7]);
      uint4 o; o.x = lo.x; o.y = lo.y; o.z = hi.x; o.w = hi.y;
      *(uint4*)&lfbuf[kdt_off(tok0, h, k) + sc * 8] = o;
    }
    if (tid < 128) p.dbuf[(long)it * 128 + tid] = __expf(R[4 * 128 + tid]);
    u16* Ait = Abuf + (long)it * 4096;
    for (int blk = wid; blk < 10; blk += 8) {
      int ti = blk < 1 ? 0 : (blk < 3 ? 1 : (blk < 6 ? 2 : 3));
      int sj = blk - (ti * (ti + 1)) / 2;
      f32x4 acc = {0.f, 0.f, 0.f, 0.f};
      _Pragma("unroll") for (int ks = 0; ks < 4; ++ks) {
        float av[8], bv[8];
        _Pragma("unroll") for (int e = 0; e < 8; ++e) {
          int kk = ks * 32 + fq * 8 + e; float rr = R[ti * 128 + kk];
          av[e] = Qs[(16 * ti + fr) * HLD + kk] * __expf(Gs[(16 * ti + fr) * HLD + kk] - rr);
          bv[e] = (1.f - __expf(L[(16 * sj + fr) * HLD + kk])) * __expf(fminf(rr - Gs[(16 * sj + fr) * HLD + kk], 80.f));
        }
        uint2 al = pack4(av[0], av[1], av[2], av[3]), ah = pack4(av[4], av[5], av[6], av[7]);
        uint2 bl = pack4(bv[0], bv[1], bv[2], bv[3]), bh = pack4(bv[4], bv[5], bv[6], bv[7]);
        uint4 a4, b4; a4.x = al.x; a4.y = al.y; a4.z = ah.x; a4.w = ah.y; b4.x = bl.x; b4.y = bl.y; b4.z = bh.x; b4.w = bh.y;
        acc = __builtin_amdgcn_mfma_f32_16x16x32_bf16(*(bf16x8*)&a4, *(bf16x8*)&b4, acc, 0, 0, 0);
      }
      _Pragma("unroll") for (int j = 0; j < 4; ++j) {
        int t = 16 * ti + fq * 4 + j, s = 16 * sj + fr;
        float v = (s <= t) ? acc[j] : 0.f;
        Ait[t * 64 + s] = f2bf(v);
      }
    }
    if (wid < 6) {
      int ti = wid < 3 ? 0 : (wid < 5 ? 1 : 2);
      int sj = wid < 3 ? wid + 1 : (wid < 5 ? wid - 1 : 3);
      _Pragma("unroll") for (int j = 0; j < 4; ++j) Ait[(16 * ti + fq * 4 + j) * 64 + 16 * sj + fr] = 0;
    }
  }
}

template <int MODE>
__device__ __forceinline__ void hg2_phase(const Params& p, char* shm, int wv) {
  constexpr int QLD = 136, KLD = 72;
  constexpr int QB = 64 * QLD, KB = 128 * KLD, AB = 64 * KLD, VB = 128 * KLD;
  constexpr int BUF_EL = QB + KB + AB + VB + 256;
  int tid = opaque_tid(wv), wid = tid >> 6, lane = tid & 63, fr = lane & 15, fq = lane >> 4;
  u16* qbuf = p.B0; const u16* kdbuf = p.B1; const u16* iT = p.B2; const u16* Abuf = p.B4;
  float* Send = p.out; float* Dseg = Send + 32L * 8 * 128 * 128;
  for (int it = blockIdx.x; it < 256; it += gridDim.x) {
    int bh = it >> 3, seg = it & 7, b = bh >> 3, h = bh & 7;
    if (MODE == 0 && seg == 7) continue;
    f32x4 S[8];
    _Pragma("unroll") for (int m = 0; m < 8; ++m) S[m] = f32x4{0.f, 0.f, 0.f, 0.f};
    if (MODE == 1) {
      for (int g = 0; g < seg; ++g) {
        const float* se = Send + ((long)(bh * 8 + g)) * 16384; const float* dg = Dseg + (bh * 8 + g) * 128;
        _Pragma("unroll") for (int m = 0; m < 8; ++m) {
          float4 dv = *(const float4*)&dg[16 * m + fq * 4];
          S[m][0] = S[m][0] * dv.x + se[(16 * m + fq * 4 + 0) * 128 + 16 * wid + fr];
          S[m][1] = S[m][1] * dv.y + se[(16 * m + fq * 4 + 1) * 128 + 16 * wid + fr];
          S[m][2] = S[m][2] * dv.z + se[(16 * m + fq * 4 + 2) * 128 + 16 * wid + fr];
          S[m][3] = S[m][3] * dv.w + se[(16 * m + fq * 4 + 3) * 128 + 16 * wid + fr];
        }
      }
    }
    float dacc = 1.f;
    u32x4 rq[2], rk[2], ra, rv[2]; f32x4 rd = {0.f, 0.f, 0.f, 0.f};
#define HG_PREFETCH(cn_) do { int tok0_ = b * SEQ + (cn_) * 64; long it_ = ((long)(b * 128 + (cn_))) * 8 + h; \
      if (MODE == 1) { _Pragma("unroll") for (int i = 0; i < 2; ++i) { int id = tid + i * 512, row = id >> 4, cc = id & 15; rq[i] = *(const u32x4*)&qbuf[(long)(tok0_ + row) * DM + h * 128 + cc * 8]; } } \
      _Pragma("unroll") for (int i = 0; i < 2; ++i) { int id = tid + i * 512, k = id >> 3, sc = id & 7; rk[i] = *(const u32x4*)&kdbuf[kdt_off(tok0_, h, k) + sc * 8]; } \
      if (MODE == 1) { int t = tid >> 3, sc = tid & 7; ra = *(const u32x4*)&Abuf[it_ * 4096 + t * 64 + sc * 8]; } \
      _Pragma("unroll") for (int i = 0; i < 2; ++i) { int id = tid + i * 512, v = id >> 3, sc = id & 7; rv[i] = *(const u32x4*)&iT[((long)(b * 128 + (cn_)) * DM + h * 128 + v) * 64 + sc * 8]; } \
      if (tid < 32) rd = *(const f32x4*)&p.dbuf[it_ * 128 + tid * 4]; } while (0)
#define HG_STASH(bi_) do { \
      u16* base_ = (u16*)shm + (bi_) * BUF_EL; u16* Qt_ = base_; u16* Kd_ = Qt_ + QB; u16* At_ = Kd_ + KB; u16* Vt_ = At_ + AB; float* dd_ = (float*)(Vt_ + VB); \
      if (MODE == 1) { _Pragma("unroll") for (int i = 0; i < 2; ++i) { int id = tid + i * 512, row = id >> 4, cc = id & 15; *(u32x4*)&Qt_[row * QLD + cc * 8] = rq[i]; } } \
      _Pragma("unroll") for (int i = 0; i < 2; ++i) { int id = tid + i * 512, k = id >> 3, sc = id & 7; *(u32x4*)&Kd_[k * KLD + sc * 8] = rk[i]; } \
      if (MODE == 1) { int t = tid >> 3, sc = tid & 7; *(u32x4*)&At_[t * KLD + sc * 8] = ra; } \
      _Pragma("unroll") for (int i = 0; i < 2; ++i) { int id = tid + i * 512, v = id >> 3, sc = id & 7; *(u32x4*)&Vt_[v * KLD + sc * 8] = rv[i]; } \
      if (tid < 32) *(f32x4*)&dd_[tid * 4] = rd; } while (0)
    __syncthreads();
    HG_PREFETCH(seg * 16); HG_STASH(0);
    for (int c = 0; c < 16; ++c) {
      int cn = seg * 16 + c;
      __syncthreads();
      if (c + 1 < 16) HG_PREFETCH(cn + 1);
      u16* base = (u16*)shm + (c & 1) * BUF_EL; u16* Qt = base; u16* Kd = Qt + QB; u16* At = Kd + KB; u16* Vt = At + AB; float* dd = (float*)(Vt + VB);
      bf16x8 vb[2];
      _Pragma("unroll") for (int k2 = 0; k2 < 2; ++k2) vb[k2] = *(const bf16x8*)&Vt[(16 * wid + fr) * KLD + k2 * 32 + fq * 8];
      if (MODE == 1) {
        bf16x8 Sb[4];
        _Pragma("unroll") for (int ks = 0; ks < 4; ++ks) {
          uint2 lo = pack4(S[2 * ks][0], S[2 * ks][1], S[2 * ks][2], S[2 * ks][3]);
          uint2 hi = pack4(S[2 * ks + 1][0], S[2 * ks + 1][1], S[2 * ks + 1][2], S[2 * ks + 1][3]);
          uint4 pk; pk.x = lo.x; pk.y = lo.y; pk.z = hi.x; pk.w = hi.y; Sb[ks] = *(bf16x8*)&pk;
        }
        int tok0 = b * SEQ + cn * 64;
        _Pragma("unroll") for (int rt = 0; rt < 4; ++rt) {
          f32x4 o = {0.f, 0.f, 0.f, 0.f};
          _Pragma("unroll") for (int ks = 0; ks < 4; ++ks) {
            uint2 lo = *(const uint2*)&Qt[(16 * rt + fr) * QLD + 32 * ks + fq * 4];
            uint2 hi = *(const uint2*)&Qt[(16 * rt + fr) * QLD + 32 * ks + 16 + fq * 4];
            uint4 pk; pk.x = lo.x; pk.y = lo.y; pk.z = hi.x; pk.w = hi.y;
            o = __builtin_amdgcn_mfma_f32_16x16x32_bf16(*(bf16x8*)&pk, Sb[ks], o, 0, 0, 0);
          }
          _Pragma("unroll") for (int k2 = 0; k2 < 2; ++k2) {
            bf16x8 a = *(const bf16x8*)&At[(16 * rt + fr) * KLD + k2 * 32 + fq * 8];
            o = __builtin_amdgcn_mfma_f32_16x16x32_bf16(a, vb[k2], o, 0, 0, 0);
          }
          _Pragma("unroll") for (int j = 0; j < 4; ++j) qbuf[(long)(tok0 + 16 * rt + fq * 4 + j) * DM + h * 128 + 16 * wid + fr] = f2bf(o[j]);
        }
      } else if (tid < 128) dacc *= dd[tid];
      _Pragma("unroll") for (int m = 0; m < 8; ++m) {
        float4 dv = *(const float4*)&dd[16 * m + fq * 4];
        S[m][0] *= dv.x; S[m][1] *= dv.y; S[m][2] *= dv.z; S[m][3] *= dv.w;
        _Pragma("unroll") for (int k2 = 0; k2 < 2; ++k2) {
          bf16x8 a = *(const bf16x8*)&Kd[(16 * m + fr) * KLD + k2 * 32 + fq * 8];
          S[m] = __builtin_amdgcn_mfma_f32_16x16x32_bf16(a, vb[k2], S[m], 0, 0, 0);
        }
      }
      if (c + 1 < 16) HG_STASH((c + 1) & 1);
    }
    if (MODE == 0) {
      float* se = Send + ((long)(bh * 8 + seg)) * 16384;
      _Pragma("unroll") for (int m = 0; m < 8; ++m) _Pragma("unroll") for (int j = 0; j < 4; ++j) se[(16 * m + fq * 4 + j) * 128 + 16 * wid + fr] = S[m][j];
      if (tid < 128) Dseg[(bh * 8 + seg) * 128 + tid] = dacc;
    }
  }
}

__device__ __forceinline__ void hg3_phase(const Params& p, int wv) {
  int tid = opaque_tid(wv); int wid = tid >> 6, lane = tid & 63;
  u16* ob = p.B0; const u16* gb = p.B3;
  for (int row = blockIdx.x * 8 + wid; row < T_TOK; row += gridDim.x * 8) {
    uint4 o0 = *(const uint4*)&ob[(long)row * DM + lane * 16], o1 = *(const uint4*)&ob[(long)row * DM + lane * 16 + 8];
    uint4 g0 = *(const uint4*)&gb[(long)row * DM + lane * 16], g1 = *(const uint4*)&gb[(long)row * DM + lane * 16 + 8];
    float o[16], g[16];
    const u16* po0 = (const u16*)&o0; const u16* po1 = (const u16*)&o1; const u16* pg0 = (const u16*)&g0; const u16* pg1 = (const u16*)&g1;
    _Pragma("unroll") for (int e = 0; e < 8; ++e) { o[e] = bf2f(po0[e]); o[8 + e] = bf2f(po1[e]); g[e] = bf2f(pg0[e]); g[8 + e] = bf2f(pg1[e]); }
    float ss = 0.f; _Pragma("unroll") for (int e = 0; e < 16; ++e) ss += o[e] * o[e];
    ss += sx<1>(ss, lane); ss += sx<2>(ss, lane); ss += sx<4>(ss, lane);
    float rs = rsqrtf(ss * (1.f / 128.f) + EPS);
    int c0 = (lane & 7) * 16; float r[16];
    _Pragma("unroll") for (int e = 0; e < 16; ++e) r[e] = o[e] * rs * p.hg_onorm[c0 + e] * silu_f(g[e]);
    uint2 a = pack4(r[0], r[1], r[2], r[3]), b2 = pack4(r[4], r[5], r[6], r[7]), c = pack4(r[8], r[9], r[10], r[11]), d = pack4(r[12], r[13], r[14], r[15]);
    uint4 w0, w1; w0.x = a.x; w0.y = a.y; w0.z = b2.x; w0.w = b2.y; w1.x = c.x; w1.y = c.y; w1.z = d.x; w1.w = d.y;
    *(uint4*)&ob[(long)row * DM + lane * 16] = w0; *(uint4*)&ob[(long)row * DM + lane * 16 + 8] = w1;
  }
}

__device__ __forceinline__ void sgu_phase(const Params& p, char* shm, int wv) {
  constexpr int WLD = 136;
  u16* Wp = (u16*)shm; float* rsv = (float*)(shm + 128 * WLD * 2);
  int tid = opaque_tid(wv), wid = tid >> 6, lane = tid & 63, fr = lane & 15, fq = lane >> 4;
  const u16* ub = p.B0; const u16* vT = p.B1; u16* ob = p.B2; const float* rowss_v = p.vpart;
  for (int it = blockIdx.x; it < 2048; it += gridDim.x) {
    int g = it & 7, c128 = it >> 3, tok0 = c128 * 128;
    __syncthreads();
    if (tid < 128) rsv[tid] = row_rs16(rowss_v, tok0 + tid);
    __syncthreads();
    _Pragma("unroll") for (int i = 0; i < 4; ++i) {
      int id = tid + i * 512, t = id >> 4, sc = id & 15;
      const float4* w4 = (const float4*)(p.sg_w_s + ((long)(g * 128 + t)) * 128 + sc * 8);
      float4 a = w4[0], b = w4[1]; float v[8] = {a.x, a.y, a.z, a.w, b.x, b.y, b.z, b.w};
      _Pragma("unroll") for (int e = 0; e < 8; ++e) { int s = sc * 8 + e; v[e] = (s <= t) ? v[e] * rsv[s] : 0.f; }
      uint2 lo = pack4(v[0], v[1], v[2], v[3]), hi = pack4(v[4], v[5], v[6], v[7]);
      uint4 o; o.x = lo.x; o.y = lo.y; o.z = hi.x; o.w = hi.y;
      *(uint4*)&Wp[t * WLD + sc * 8] = o;
    }
    bf16x8 vb[4];
    int cc = g * 128 + 16 * wid + fr;
    _Pragma("unroll") for (int ks = 0; ks < 4; ++ks) vb[ks] = *(const bf16x8*)&vT[((long)c128 * DM + cc) * 128 + ks * 32 + fq * 8];
    float4 gvn = *(const float4*)&p.sg_vnorm[g * 128 + 16 * wid + fq * 4];
    __syncthreads();
    _Pragma("unroll") for (int mt = 0; mt < 8; ++mt) {
      f32x4 acc = {0.f, 0.f, 0.f, 0.f};
      _Pragma("unroll") for (int ks = 0; ks <= (mt >> 1); ++ks) {
        bf16x8 a = *(const bf16x8*)&Wp[(16 * mt + fr) * WLD + ks * 32 + fq * 8];
        acc = __builtin_amdgcn_mfma_f32_16x16x32_bf16(vb[ks], a, acc, 0, 0, 0);
      }
      int t = 16 * mt + fr; float bs = p.sg_b_s[g * 128 + t];
      long idx = (long)(tok0 + t) * DM + g * 128 + 16 * wid + fq * 4;
      uint2 uv = *(const uint2*)&ub[idx];
      float u0 = __uint_as_float(uv.x << 16), u1 = __uint_as_float(uv.x & 0xffff0000u), u2 = __uint_as_float(uv.y << 16), u3 = __uint_as_float(uv.y & 0xffff0000u);
      *(uint2*)&ob[idx] = pack4(u0 * (acc[0] * gvn.x + bs), u1 * (acc[1] * gvn.y + bs), u2 * (acc[2] * gvn.z + bs), u3 * (acc[3] * gvn.w + bs));
    }
  }
}

__device__ __forceinline__ void final_phase(const Params& p, int wv) {
  int tid = opaque_tid(wv); int wid = tid >> 6, lane = tid & 63;
  for (int row = blockIdx.x * 8 + wid; row < T_TOK; row += gridDim.x * 8) {
    float rs = row_rs(p.rpart, row);
    float4* o4 = (float4*)(p.out + (long)row * DM);
    const uint2* x2 = (const uint2*)(p.xb + (long)row * DM);
    _Pragma("unroll") for (int i = 0; i < 4; ++i) {
      uint2 xv = x2[i * 64 + lane]; float4 g = ((const float4*)p.norm_final)[i * 64 + lane]; float4 v;
      v.x = __uint_as_float(xv.x << 16) * rs * g.x; v.y = __uint_as_float(xv.x & 0xffff0000u) * rs * g.y;
      v.z = __uint_as_float(xv.y << 16) * rs * g.z; v.w = __uint_as_float(xv.y & 0xffff0000u) * rs * g.w;
      o4[i * 64 + lane] = v;
    }
  }
}

#define XB_TMO      128
#define XB_XCNT(j)  (256  + 64 * (j))
#define XB_XSUB(j)  (1280 + 64 * (j))
#define XB_XGEN(j)  (2304 + 64 * (j))
#define XB_TOP      3328
#define XB_TOPGEN   3392
#define XCD_BAR_WORDS 3456
#define XB_SPIN_CAP (1u << 22)
#define LAS __attribute__((address_space(3)))

__device__ __forceinline__ unsigned xb_ld(unsigned* p)              { return __hip_atomic_load(p, __ATOMIC_RELAXED, __HIP_MEMORY_SCOPE_AGENT); }
__device__ __forceinline__ unsigned xb_add(unsigned* p, unsigned v) { return __hip_atomic_fetch_add(p, v, __ATOMIC_RELAXED, __HIP_MEMORY_SCOPE_AGENT); }
__device__ __forceinline__ unsigned xb_xcc_id() { return (unsigned)__builtin_amdgcn_s_getreg((3 << 11) | 20) & 0xFu; }
#define XB_SPIN(cond, bar) do { unsigned _sp = 0; while (cond) { __builtin_amdgcn_s_sleep(1); \
    if ((++_sp & 255u) == 0u) { if (xb_ld(&(bar)[XB_TMO])) break; if (_sp > XB_SPIN_CAP) { atomicAdd(&(bar)[XB_TMO], 1u); break; } } } } while (0)

struct XcdBarrier {
    unsigned* bar; unsigned x;
    volatile LAS unsigned* st;
};

__device__ __forceinline__ XcdBarrier xcd_barrier_post(unsigned* bar, volatile LAS unsigned* st, bool t0) {
    XcdBarrier b; b.bar = bar; b.x = xb_xcc_id(); b.st = st;
    if (t0) (void)xb_add(&bar[XB_XCNT(b.x)], 1u);
    return b;
}
__device__ __forceinline__ void xcd_barrier_complete(unsigned* bar, unsigned x, unsigned& nloc, unsigned& nx) {
    const unsigned G = gridDim.x * gridDim.y * gridDim.z;
    unsigned sum, cnt, mine, sp = 0u;
    for (;;) {
        sum = 0u; cnt = 0u; mine = 0u;
#pragma unroll
        for (unsigned j = 0; j < 16; ++j) { const unsigned c = xb_ld(&bar[XB_XCNT(j)]); sum += c; cnt += (c > 0u) ? 1u : 0u; mine = (j == x) ? c : mine; }
        if (sum == G) break;
        __builtin_amdgcn_s_sleep(1);
        if ((++sp & 255u) == 0u) { if (xb_ld(&bar[XB_TMO])) break; if (sp > XB_SPIN_CAP) { atomicAdd(&bar[XB_TMO], 1u); break; } }
    }
    nloc = mine > 0u ? mine : 1u; nx = cnt > 0u ? cnt : 1u;
}

__device__ __forceinline__ void xcd_barrier(const XcdBarrier& b, bool t0) {
    asm volatile("s_waitcnt vmcnt(0)" ::: "memory");
    __syncthreads();
    if (t0) {
        unsigned* bar = b.bar;
        __builtin_amdgcn_s_waitcnt(0);
        unsigned nloc = b.st[0], nx = b.st[1];
        if (nloc == 0u) { xcd_barrier_complete(bar, b.x, nloc, nx); b.st[0] = nloc; b.st[1] = nx; }
        const unsigned old = xb_add(&bar[XB_XSUB(b.x)], 1u);
        const unsigned gen = old / nloc;
        if (old + 1u == (gen + 1u) * nloc) {
            __builtin_amdgcn_fence(__ATOMIC_RELEASE, "agent");
            asm volatile("s_waitcnt vmcnt(0)" ::: "memory");
            const unsigned og = xb_add(&bar[XB_TOP], 1u);
            const unsigned tg = og / nx;
            if (og + 1u == (tg + 1u) * nx) xb_add(&bar[XB_TOPGEN], 1u);
            else XB_SPIN(xb_ld(&bar[XB_TOPGEN]) == tg, bar);
            __builtin_amdgcn_fence(__ATOMIC_ACQUIRE, "agent");
            xb_add(&bar[XB_XGEN(b.x)], 1u);
            asm volatile("s_waitcnt vmcnt(0)" ::: "memory");
        } else {
            XB_SPIN(xb_ld(&bar[XB_XGEN(b.x)]) == gen, bar);
            __builtin_amdgcn_fence(__ATOMIC_ACQUIRE, "agent");
            asm volatile("s_waitcnt vmcnt(0)" ::: "memory");
        }
    }
    __syncthreads();
}


#define SEL4(arr, i) ((i) == 0 ? (arr)[0] : ((i) == 1 ? (arr)[1] : ((i) == 2 ? (arr)[2] : (arr)[3])))
__global__ void __launch_bounds__(512, 2) fwd_megakernel(KArgs ka_unused) {
  extern __shared__ __attribute__((aligned(16))) char shm[];
  const int wv = __builtin_amdgcn_readfirstlane((int)(threadIdx.x >> 6));
  int ph = 0;
#define BARRIER_WS ((unsigned*)(kargs_ptr()->ws + OFF_BAR))
#if MULTI_LAUNCH
#define PHASE_BEGIN if (ph >= kargs_ptr()->phase_lo && ph < kargs_ptr()->phase_hi) { const Params p = make_params(*kargs_ptr());
#define PHASE_END } ++ph;
#else
  cg::grid_group grid = cg::this_grid();
#define PHASE_BEGIN { const Params p = make_params(*kargs_ptr());
#define PHASE_END } ++ph; { XcdBarrier xb_; xb_.bar = BARRIER_WS; xb_.x = xb_xcc_id(); xb_.st = (volatile LAS unsigned*)(shm + LDS_BYTES - 16); xcd_barrier(xb_, opaque_tid(wv) == 0); }
#endif
#define LAYER_VARS \
    const float* xin = (i == 0) ? p.x : p.out; float* rs_mix = p.rpart; float* rs_cross = p.rpart; float* rs_ffn = p.rpart; float* rs_next = p.rpart; \
    const u16* w_mix_in = p.wbase + layer_woff(i); const u16* w_mix_out = w_mix_in + mixin_elems(i); const u16* w_caq = w_mix_out + 1048576L; \
    const u16* w_cao = w_caq + 3145728L; const u16* w_gu = w_cao + 1048576L; const u16* w_down = w_gu + 5767168L; \
    const u16* mix_out_A = kind == 0 ? p.B3 : (kind == 1 ? p.B0 : p.B2); \
    (void)xin; (void)rs_mix; (void)rs_cross; (void)rs_ffn; (void)rs_next; (void)w_mix_in; (void)w_mix_out; (void)w_caq; (void)w_cao; (void)w_gu; (void)w_down; (void)mix_out_A;
#if MULTI_LAUNCH
  PHASE_BEGIN prep_phase(p, kargs_ptr(), shm, wv); PHASE_END
#else
  { const Params p = make_params(*kargs_ptr()); prep_phase(p, kargs_ptr(), shm, wv); } ++ph;
  grid.sync();
  {
    volatile LAS unsigned* xb_st = (volatile LAS unsigned*)(shm + LDS_BYTES - 16);
    if (opaque_tid(wv) == 0) { xb_st[0] = 0u; xb_st[1] = 0u; }
    __syncthreads();
    (void)xcd_barrier_post(BARRIER_WS, xb_st, opaque_tid(wv) == 0);
  }
#endif
  _Pragma("nounroll") for (int i = 0; i < 4; ++i) {
    int kind = i % 3, j = i / 3;
    if (kind == 0) {
      PHASE_BEGIN LAYER_VARS
        if (i == 0) {
          for (int t = blockIdx.x; t < 128; t += gridDim.x) {
            int l = t >> 5, tt = t & 31, tr0 = (tt & 3) * BM, fc0 = (tt >> 2) * BM;
            EpiMemKV em{p.memK + (long)l * NB * MEML * DM, p.memVT + (long)l * NB * DM * MEML};
            const u16* mA = p.memn; const u16* mB = p.wbase + layer_woff(l) + mixin_elems(l) + 2097152L;
            bool sw = em.swap(fc0);
            gemm_tile(sw ? mB : mA, sw ? mA : mB, DM, sw ? fc0 : tr0, sw ? tr0 : fc0, shm, em, tr0, fc0, sw, false, false, mA, mB, 0, 0, wv);
          }
        }
        EpiDaIn e{rs_mix, p.B0, p.B1, p.B2}; gemm_phase(p.xb, w_mix_in, T_TOK, 3 * DM, DM, shm, e, wv);
      PHASE_END
      PHASE_BEGIN diff_attn_phase(p, j, i, shm, wv); PHASE_END
    } else if (kind == 1) {
      PHASE_BEGIN LAYER_VARS EpiHgIn e{rs_mix, p.lbv, p.B0, p.B1, p.B2, p.B3}; gemm_phase(p.xb, w_mix_in, T_TOK, 4 * DM, DM, shm, e, wv); PHASE_END
      PHASE_BEGIN hg1_phase(p, shm, wv); PHASE_END
      PHASE_BEGIN hg2_phase<0>(p, shm, wv); PHASE_END
      PHASE_BEGIN hg2_phase<1>(p, shm, wv); PHASE_END
      PHASE_BEGIN hg3_phase(p, wv); PHASE_END
    } else {
      PHASE_BEGIN LAYER_VARS EpiSgIn e{rs_mix, p.B0, p.B1, p.vpart}; gemm_phase(p.xb, w_mix_in, T_TOK, 2 * DM, DM, shm, e, wv); PHASE_END
      PHASE_BEGIN sgu_phase(p, shm, wv); PHASE_END
    }
    PHASE_BEGIN LAYER_VARS EpiRes e{p.xb, rs_cross}; gemm_phase(mix_out_A, w_mix_out, T_TOK, DM, DM, shm, e, wv); PHASE_END
    PHASE_BEGIN LAYER_VARS EpiStore e{rs_cross, p.B0, DM}; gemm_phase(p.xb, w_caq, T_TOK, DM, DM, shm, e, wv); PHASE_END
    PHASE_BEGIN cross_attn_phase(p, i, shm, wv); PHASE_END
    PHASE_BEGIN LAYER_VARS EpiRes e{p.xb, rs_ffn}; gemm_phase(p.B1, w_cao, T_TOK, DM, DM, shm, e, wv); PHASE_END
    PHASE_BEGIN LAYER_VARS EpiFfn e{rs_ffn, p.B0}; gemm_phase(p.xb, w_gu, T_TOK, 2 * DFF, DM, shm, e, wv); PHASE_END
    PHASE_BEGIN LAYER_VARS EpiRes e{p.xb, rs_next}; gemm_phase(p.B0, w_down, T_TOK, DM, DFF, shm, e, wv); PHASE_END
  }
#if MULTI_LAUNCH
  PHASE_BEGIN final_phase(p, wv); PHASE_END
#else
  { const Params p = make_params(*kargs_ptr()); final_phase(p, wv); }
#endif
}

extern "C" void kernel_launch(void* const* d_in, const int* in_sizes, int n_in, void* d_out, int out_size, void* d_ws, size_t ws_size,
                              hipStream_t stream) {
  static int grid_blocks = 0;
  if (!grid_blocks) {
    int dev = 0, cus = 0, per_cu = 0;
    hipGetDevice(&dev);
    hipDeviceGetAttribute(&cus, hipDeviceAttributeMultiprocessorCount, dev);
    if (hipFuncSetAttribute((const void*)fwd_megakernel, hipFuncAttributeMaxDynamicSharedMemorySize, LDS_BYTES) != hipSuccess)
      fprintf(stderr, "hipFuncSetAttribute failed\n");
    hipOccupancyMaxActiveBlocksPerMultiprocessor(&per_cu, (const void*)fwd_megakernel, 512, LDS_BYTES);
    if (per_cu < 1) { fprintf(stderr, "occupancy query returned %d\n", per_cu); per_cu = 1; }
    grid_blocks = cus * per_cu;
    (void)hipGetLastError();
  }
  KArgs p;
  memset(&p, 0, sizeof(p));
  const float* const* in = (const float* const*)d_in;
  p.x = in[0]; p.mem = in[1]; p.rel_bias = in[2];
  const float *norm_mix = in[3], *norm_cross = in[4], *norm_ffn = in[5];
  p.norm_mem = in[6]; p.norm_final = in[7];
  const float *da_w_in = in[8], *da_w_out = in[9];
  p.da_lq1 = in[10]; p.da_lk1 = in[11]; p.da_lq2 = in[12]; p.da_lk2 = in[13]; p.da_subln = in[14];
  const float *hg_w_in = in[15], *hg_w_out = in[16];
  p.hg_lb = in[17]; p.hg_onorm = in[18];
  const float *sg_w_in = in[19], *sg_w_out = in[20];
  p.sg_vnorm = in[21]; p.sg_w_s = in[22]; p.sg_b_s = in[23];
  const float *ca_w_q = in[24], *ca_w_kv = in[25], *ca_w_o = in[26], *ffn_w_gu = in[27], *ffn_w_down = in[28];
  p.out = (float*)d_out; p.ws = (char*)d_ws;
  if (WS_END > ws_size) { fprintf(stderr, "workspace too small: need %zu have %zu\n", (size_t)WS_END, ws_size); return; }
  int nwd = 0, tiles = 0;
  u16* wcur = (u16*)((char*)d_ws + OFF_W);
  auto addw = [&](const float* src, int K, int N, const float* gain, int perm) {
    WDesc& w = p.wd[nwd++]; w.src = src; w.dst = wcur; w.gain = gain; w.K = K; w.N = N; w.perm = perm; w.tile0 = tiles;
    tiles += (K / 64) * (N / 64); wcur += (size_t)K * N;
  };
  for (int i = 0; i < 4; ++i) {
    int kind = i % 3, j = i / 3;
    if (wcur != (u16*)((char*)d_ws + OFF_W) + layer_woff(i)) fprintf(stderr, "weight layout mismatch at layer %d\n", i);
    if (kind == 0) { addw(da_w_in + (size_t)j * DM * 3 * DM, DM, 3 * DM, norm_mix + i * DM, 0); addw(da_w_out + (size_t)j * DM * DM, DM, DM, nullptr, 0); }
    else if (kind == 1) { addw(hg_w_in + (size_t)j * DM * 4 * DM, DM, 4 * DM, norm_mix + i * DM, 0); addw(hg_w_out + (size_t)j * DM * DM, DM, DM, nullptr, 0); }
    else { addw(sg_w_in + (size_t)j * DM * 2 * DM, DM, 2 * DM, norm_mix + i * DM, 0); addw(sg_w_out + (size_t)j * DM * DM, DM, DM, nullptr, 0); }
    addw(ca_w_q + (size_t)i * DM * DM, DM, DM, norm_cross + i * DM, 0);
    addw(ca_w_kv + (size_t)i * DM * 2 * DM, DM, 2 * DM, nullptr, 0);
    addw(ca_w_o + (size_t)i * DM * DM, DM, DM, nullptr, 0);
    addw(ffn_w_gu + (size_t)i * DM * 2 * DFF, DM, 2 * DFF, norm_ffn + i * DM, 1);
    addw(ffn_w_down + (size_t)i * DFF * DM, DFF, DM, nullptr, 0);
  }
  p.nwd = nwd; p.total_wtiles = tiles;
#if MULTI_LAUNCH
  _Pragma("unroll") for (int ph = 0; ph < 64; ++ph) {
    p.phase_lo = ph; p.phase_hi = ph + 1;
    hipLaunchKernelGGL(fwd_megakernel, dim3(grid_blocks), dim3(512), LDS_BYTES, stream, p);
  }
#else
  p.phase_lo = 0; p.phase_hi = 1 << 30;
  void* args[] = {&p};
  hipError_t e = hipLaunchCooperativeKernel((void*)fwd_megakernel, dim3(grid_blocks), dim3(512), args, LDS_BYTES, stream);
  if (e != hipSuccess) fprintf(stderr, "cooperative launch failed: %s (grid %d)\n", hipGetErrorString(e), grid_blocks);
#endif
}
```
